# Optimizing an MI355X kernel written in HIP

```python
import math
import jax, jax.numpy as jnp
from jax import lax
import numpy as np

D_MODEL = 1024
BATCH = 8
SEQ = 4096
DEPTH = 2

CTX_LEN = 256
GRID_W = 64
HEAD_DIM = 64
HY_WIDTH = 256
GA_HEADS = 6
GA_KV_HEADS = 2
WA_HEADS = 6
WA_KV_HEADS = 2
MIX_WIDTH = HY_WIDTH + (GA_HEADS + WA_HEADS) * HEAD_DIM
Q_BLOCK = 128
WINDOW = 128
ROPE_THETA = 10000.0
ATTN_SCALE = HEAD_DIM ** -0.5
HY_SHORT = 3
HY_EMB = 33
HY_BANDS = (HY_EMB - 1) // 2
HY_FILTER_WIDTH = 64
HY_FAST_DECAY = 0.3
HY_SLOW_DECAY = 1.5
HY_TARGET = 1e-2
N_EXPERTS = 32
TOP_K = 4
D_EXPERT = D_MODEL
SWIGLU_ALPHA = 1.702
SWIGLU_LIMIT = 7.0
MOE_BLOCK = 256
EPS = 1e-6
NEG_INF = -1e30
IN_SEGMENTS = (('hy', 3 * HY_WIDTH), ('ga_q', GA_HEADS * HEAD_DIM), ('ga_k', GA_KV_HEADS * HEAD_DIM), ('ga_v', GA_KV_HEADS * HEAD_DIM), ('wa_q', WA_HEADS * HEAD_DIM), ('wa_k', WA_KV_HEADS * HEAD_DIM), ('wa_v', WA_KV_HEADS * HEAD_DIM))
IN_WIDTH = 3 * HY_WIDTH + (GA_HEADS + 2 * GA_KV_HEADS + WA_HEADS + 2 * WA_KV_HEADS) * HEAD_DIM

kernel_name = 'hybrid_hyena_gqa_swa_moe_dit'


def _col_range(name):
    lo = 0
    for seg, width in IN_SEGMENTS:
        if seg == name:
            return lo, lo + width
        lo += width
    raise KeyError(name)


def rms_norm(x, w):
    xf = x.astype(jnp.float32)
    y = xf * lax.rsqrt(jnp.mean(xf * xf, axis=-1, keepdims=True) + EPS)
    return (y * w.astype(jnp.float32)).astype(x.dtype)


def modulate(x, shift, scale):
    return x * (1 + scale) + shift


def _heads(t, n_heads):
    return t.reshape(t.shape[:-1] + (n_heads, HEAD_DIM))


def _groups(t, n_kv):
    return t.reshape(t.shape[:-2] + (n_kv, t.shape[-2] // n_kv, HEAD_DIM))


def axial_rope_tables(n):
    rows = n // GRID_W
    row = jnp.repeat(jnp.arange(rows, dtype=jnp.float32), GRID_W)
    col = jnp.tile(jnp.arange(GRID_W, dtype=jnp.float32), rows)
    pos = jnp.stack([row, col], axis=-1)
    n_freq = HEAD_DIM // 4
    inv_freq = ROPE_THETA ** (-jnp.arange(n_freq, dtype=jnp.float32) / n_freq)
    ang = pos[:, :, None] * inv_freq
    return jnp.cos(ang), jnp.sin(ang)


def apply_axial_rope(x, cos, sin):
    shp = x.shape
    xr = x.reshape(shp[:-1] + (2, 2, HEAD_DIM // 4))
    x1, x2 = xr[..., 0, :], xr[..., 1, :]
    c = cos[:, None].astype(x.dtype)
    s = sin[:, None].astype(x.dtype)
    out = jnp.stack([x1 * c - x2 * s, x2 * c + x1 * s], axis=-2)
    return out.reshape(shp)


def short_conv(u, w, b):
    ch = u.shape[-1]
    pad = HY_SHORT // 2
    y = lax.conv_general_dilated(u, w[:, None, :].astype(u.dtype), window_strides=(1,), padding=((pad, pad),), dimension_numbers=('NWC', 'WIO', 'NWC'), feature_group_count=ch)
    return y + b


def hyena_filters(n, filt):
    w1, b1, w2, b2, w3, b3, freq, w_out = filt
    f32 = jnp.float32
    t = jnp.linspace(0.0, 1.0, n, dtype=f32)[:, None]
    wpos = (2.0 * math.pi / n) * jnp.arange(n, dtype=f32)[:, None]
    bands = jnp.linspace(1e-4, HY_BANDS - 1, HY_BANDS, dtype=f32)
    z = jnp.concatenate([t, jnp.cos(wpos * bands), -jnp.sin(wpos * bands)], axis=-1)
    fr = freq.astype(f32)
    hdn = jnp.sin(fr * (z @ w1.astype(f32) + b1.astype(f32)))
    hdn = jnp.sin(fr * (hdn @ w2.astype(f32) + b2.astype(f32)))
    hdn = jnp.sin(fr * (hdn @ w3.astype(f32) + b3.astype(f32)))
    k = (hdn @ w_out.astype(f32)).reshape(n, 2, HY_WIDTH)
    max_decay = math.log(HY_TARGET) / HY_FAST_DECAY
    min_decay = math.log(HY_TARGET) / HY_SLOW_DECAY
    deltas = jnp.linspace(min_decay, max_decay, HY_WIDTH, dtype=f32)
    decay = jnp.exp(-t * jnp.abs(deltas))
    k = k * decay[:, None, :]
    return k[:, 0], k[:, 1]


def hyena_mix(u, conv_w, conv_b, filt, skip):
    n = u.shape[1]
    uc = short_conv(u, conv_w, conv_b)
    x0, x1, v = jnp.split(uc, 3, axis=-1)
    k_fwd, k_bwd = hyena_filters(n, filt)
    k_full = jnp.concatenate([k_fwd, k_bwd[::-1]], axis=0)
    z = (v * x1).astype(jnp.float32)
    y = jnp.fft.irfft(jnp.fft.rfft(z, n=2 * n, axis=1) * jnp.fft.rfft(k_full, axis=0)[None], n=2 * n, axis=1)[:, :n]
    y = y + z * skip.astype(jnp.float32)
    return x0 * y.astype(u.dtype)


def dense_gqa(q, k, v, sink=None):
    s = jnp.einsum('bqkgd,bskd->bkgqs', q, k).astype(jnp.float32) * ATTN_SCALE
    if sink is not None:
        sk = jnp.broadcast_to(sink.astype(jnp.float32)[None, :, :, None, None], s.shape[:-1] + (1,))
        s = jnp.concatenate([s, sk], axis=-1)
    p = jax.nn.softmax(s, axis=-1)
    if sink is not None:
        p = p[..., :-1]
    return jnp.einsum('bkgqs,bskd->bqkgd', p.astype(v.dtype), v)


def global_attention(q, k, v, k_ctx, v_ctx):
    bsz, n = q.shape[:2]
    k_all = jnp.concatenate([k, k_ctx], axis=1)
    v_all = jnp.concatenate([v, v_ctx], axis=1)
    qb = jnp.moveaxis(q.reshape((bsz, n // Q_BLOCK, Q_BLOCK) + q.shape[2:]), 1, 0)
    ob = lax.map(lambda qblk: dense_gqa(qblk, k_all, v_all), qb)
    return jnp.moveaxis(ob, 0, 1).reshape(bsz, n, -1)


def window_attention(q, k, v, k_ctx, v_ctx, sink):
    bsz, n, kv, g, dh = q.shape
    nb = n // Q_BLOCK
    band_len = 3 * Q_BLOCK

    def band(t):
        tp = jnp.pad(t, ((0, 0), (Q_BLOCK, Q_BLOCK), (0, 0), (0, 0))).reshape(bsz, nb + 2, Q_BLOCK, kv, dh)
        return jnp.concatenate([tp[:, :-2], tp[:, 1:-1], tp[:, 2:]], axis=2)

    kb, vb = band(k), band(v)
    qb = q.reshape(bsz, nb, Q_BLOCK, kv, g, dh)
    s_loc = jnp.einsum('bnqkgd,bnskd->bnkgqs', qb, kb).astype(jnp.float32) * ATTN_SCALE
    blk = jnp.arange(nb, dtype=jnp.int32)[:, None, None] * Q_BLOCK
    qpos = blk + jnp.arange(Q_BLOCK, dtype=jnp.int32)[None, :, None]
    kpos = blk - Q_BLOCK + jnp.arange(band_len, dtype=jnp.int32)[None, None, :]
    valid = (jnp.abs(kpos - qpos) <= WINDOW) & (kpos >= 0) & (kpos < n)
    s_loc = jnp.where(valid[None, :, None, None], s_loc, NEG_INF)
    s_ctx = jnp.einsum('bnqkgd,bckd->bnkgqc', qb, k_ctx).astype(jnp.float32) * ATTN_SCALE
    s_sink = jnp.broadcast_to(sink.astype(jnp.float32)[None, None, :, :, None, None], s_ctx.shape[:-1] + (1,))
    p = jax.nn.softmax(jnp.concatenate([s_loc, s_ctx, s_sink], axis=-1), axis=-1).astype(v.dtype)
    n_ctx = k_ctx.shape[1]
    o = jnp.einsum('bnkgqs,bnskd->bnqkgd', p[..., :band_len], vb) + jnp.einsum('bnkgqc,bckd->bnqkgd', p[..., band_len:band_len + n_ctx], v_ctx)
    return o.reshape(bsz, n, kv * g * dh)


def token_mixer(h, hc, rope_cos, rope_sin, w_in, b_in, conv_w, conv_b, filt, skip, q_norm, k_norm, sink, branch_norm, w_out, b_out, with_ctx_out):
    p = h @ w_in + b_in

    def lat(name):
        lo, hi = _col_range(name)
        return p[..., lo:hi]

    def cproj(name):
        lo, hi = _col_range(name)
        return hc @ w_in[:, lo:hi] + b_in[lo:hi]

    def rope(t):
        return apply_axial_rope(t, rope_cos, rope_sin)

    def merge(y_hy, y_ga, y_wa):
        g0 = HY_WIDTH
        g1 = HY_WIDTH + GA_HEADS * HEAD_DIM
        y = jnp.concatenate([rms_norm(y_hy, branch_norm[:g0]), rms_norm(y_ga, branch_norm[g0:g1]), rms_norm(y_wa, branch_norm[g1:])], axis=-1)
        return y @ w_out + b_out

    wa_sink = sink.reshape(WA_KV_HEADS, WA_HEADS // WA_KV_HEADS)
    y_hy = hyena_mix(lat('hy'), conv_w, conv_b, filt, skip)
    gq = rope(rms_norm(_heads(lat('ga_q'), GA_HEADS), q_norm))
    gk = rope(rms_norm(_heads(lat('ga_k'), GA_KV_HEADS), k_norm))
    gv = _heads(lat('ga_v'), GA_KV_HEADS)
    gkc = rms_norm(_heads(cproj('ga_k'), GA_KV_HEADS), k_norm)
    gvc = _heads(cproj('ga_v'), GA_KV_HEADS)
    y_ga = global_attention(_groups(gq, GA_KV_HEADS), gk, gv, gkc, gvc)
    wq = rope(_heads(lat('wa_q'), WA_HEADS))
    wk = rope(_heads(lat('wa_k'), WA_KV_HEADS))
    wv = _heads(lat('wa_v'), WA_KV_HEADS)
    wkc = _heads(cproj('wa_k'), WA_KV_HEADS)
    wvc = _heads(cproj('wa_v'), WA_KV_HEADS)
    y_wa = window_attention(_groups(wq, WA_KV_HEADS), wk, wv, wkc, wvc, wa_sink)
    y = merge(y_hy, y_ga, y_wa)
    if not with_ctx_out:
        return y, None
    yc_hy = hyena_mix(cproj('hy'), conv_w, conv_b, filt, skip)
    gqc = rms_norm(_heads(cproj('ga_q'), GA_HEADS), q_norm)
    yc_ga = dense_gqa(_groups(gqc, GA_KV_HEADS), gkc, gvc)
    yc_ga = yc_ga.reshape(yc_ga.shape[:2] + (-1,))
    wqc = _heads(cproj('wa_q'), WA_HEADS)
    yc_wa = dense_gqa(_groups(wqc, WA_KV_HEADS), wkc, wvc, wa_sink)
    yc_wa = yc_wa.reshape(yc_wa.shape[:2] + (-1,))
    return y, merge(yc_hy, yc_ga, yc_wa)


def moe_ffn(h, w_router, b_router, w1, b1, w2, b2):
    n_tok, d = h.shape
    f = w2.shape[1]
    logits = (h @ w_router + b_router).astype(jnp.float32)
    top_val, top_idx = lax.top_k(logits, TOP_K)
    gates = jax.nn.softmax(top_val, axis=-1)
    n_assign = n_tok * TOP_K
    n_blocks = -(-n_assign // MOE_BLOCK) + N_EXPERTS
    e_flat = top_idx.reshape(n_assign)
    order = jnp.argsort(e_flat)
    e_sorted = e_flat[order]
    tok_sorted = (order // TOP_K).astype(jnp.int32)
    g_sorted = gates.reshape(n_assign)[order]
    counts = jnp.bincount(e_flat, length=N_EXPERTS)
    starts = jnp.cumsum(counts) - counts
    padded = (counts + MOE_BLOCK - 1) // MOE_BLOCK * MOE_BLOCK
    ends = jnp.cumsum(padded)
    slot = (ends - padded)[e_sorted] + jnp.arange(n_assign, dtype=jnp.int32) - starts[e_sorted]
    slot_tok = jnp.full((n_blocks * MOE_BLOCK,), n_tok, jnp.int32).at[slot].set(tok_sorted)
    slot_gate = jnp.zeros((n_blocks * MOE_BLOCK,), jnp.float32).at[slot].set(g_sorted)
    block_expert = jnp.minimum(jnp.searchsorted(ends, jnp.arange(n_blocks, dtype=jnp.int32) * MOE_BLOCK, side='right'), N_EXPERTS - 1)
    h_pad = jnp.concatenate([h, jnp.zeros((1, d), h.dtype)], axis=0)

    def expert_block(acc, blk):
        tok, gate, e = blk
        a = h_pad[tok] @ w1[e] + b1[e]
        glu = jnp.minimum(a[:, :f], SWIGLU_LIMIT)
        lin = jnp.clip(a[:, f:], -SWIGLU_LIMIT, SWIGLU_LIMIT)
        out = (glu * jax.nn.sigmoid(SWIGLU_ALPHA * glu) * (lin + 1)) @ w2[e] + b2[e]
        return acc.at[tok].add(out.astype(jnp.float32) * gate[:, None]), None

    acc, _ = lax.scan(expert_block, jnp.zeros((n_tok + 1, d), jnp.float32), (slot_tok.reshape(n_blocks, MOE_BLOCK), slot_gate.reshape(n_blocks, MOE_BLOCK), block_expert))
    return acc[:n_tok].astype(h.dtype)


def setup_inputs(seed: int = 0) -> dict:
    key = jax.random.key(seed)
    keys = list(jax.random.split(key, 40))
    counter = [0]

    def nk():
        counter[0] += 1
        return keys[counter[0] - 1]

    def nrm(shape, std):
        return std * jax.random.normal(nk(), shape, jnp.float32)

    def gain(shape):
        return 1.0 + 0.05 * jax.random.normal(nk(), shape, jnp.float32)

    L, D, E, F = DEPTH, D_MODEL, N_EXPERTS, D_EXPERT
    return {
        'x': nrm((BATCH, SEQ, D), 1.0),
        'c': nrm((BATCH, D), 1.0),
        'ctx': nrm((BATCH, CTX_LEN, D), 1.0),
        'c_ctx': nrm((D,), 1.0),
        'w_ada': nrm((L, D, 6 * D), 0.02),
        'b_ada': nrm((L, 6 * D), 0.01),
        'norm_mix': gain((L, D)),
        'norm_ffn': gain((L, D)),
        'w_in': nrm((L, D, IN_WIDTH), D ** -0.5),
        'b_in': nrm((L, IN_WIDTH), 0.01),
        'hy_conv_w': nrm((L, HY_SHORT, 3 * HY_WIDTH), HY_SHORT ** -0.5),
        'hy_conv_b': nrm((L, 3 * HY_WIDTH), 0.01),
        'hy_filt_w1': nrm((L, HY_EMB, HY_FILTER_WIDTH), HY_EMB ** -0.5),
        'hy_filt_b1': nrm((L, HY_FILTER_WIDTH), 0.1),
        'hy_filt_w2': nrm((L, HY_FILTER_WIDTH, HY_FILTER_WIDTH), HY_FILTER_WIDTH ** -0.5),
        'hy_filt_b2': nrm((L, HY_FILTER_WIDTH), 0.1),
        'hy_filt_w3': nrm((L, HY_FILTER_WIDTH, HY_FILTER_WIDTH), HY_FILTER_WIDTH ** -0.5),
        'hy_filt_b3': nrm((L, HY_FILTER_WIDTH), 0.1),
        'hy_filt_freq': gain((L, HY_FILTER_WIDTH)),
        'hy_filt_out': nrm((L, HY_FILTER_WIDTH, 2 * HY_WIDTH), 0.005),
        'hy_skip': nrm((L, HY_WIDTH), 1.0),
        'ga_q_norm': gain((L, HEAD_DIM)),
        'ga_k_norm': gain((L, HEAD_DIM)),
        'wa_sink': nrm((L, WA_HEADS), 0.5),
        'branch_norm': gain((L, MIX_WIDTH)),
        'w_out': nrm((L, MIX_WIDTH, D), MIX_WIDTH ** -0.5),
        'b_out': nrm((L, D), 0.01),
        'w_router': nrm((L, D, E), D ** -0.5),
        'b_router': nrm((L, E), 0.01),
        'w_mlp1': nrm((L, E, D, 2 * F), D ** -0.5),
        'b_mlp1': nrm((L, E, 2 * F), 0.01),
        'w_mlp2': nrm((L, E, F, D), F ** -0.5),
        'b_mlp2': nrm((L, E, D), 0.01),
        'norm_final': gain((D,)),
    }


def reference(x, c, ctx, c_ctx, w_ada, b_ada, norm_mix, norm_ffn, w_in, b_in, hy_conv_w, hy_conv_b, hy_filt_w1, hy_filt_b1, hy_filt_w2, hy_filt_b2, hy_filt_w3, hy_filt_b3, hy_filt_freq, hy_filt_out, hy_skip, ga_q_norm, ga_k_norm, wa_sink, branch_norm, w_out, b_out, w_router, b_router, w_mlp1, b_mlp1, w_mlp2, b_mlp2, norm_final):
    bsz, n, d = x.shape
    rope_cos, rope_sin = axial_rope_tables(n)
    s_c = jax.nn.silu(c)
    s_cc = jax.nn.silu(c_ctx)
    xc = ctx
    for l in range(DEPTH):
        last = l == DEPTH - 1
        mod = (s_c @ w_ada[l] + b_ada[l])[:, None, :]
        mod_c = s_cc @ w_ada[l] + b_ada[l]
        sh1, sc1, g1, sh2, sc2, g2 = jnp.split(mod, 6, axis=-1)
        csh1, csc1, cg1, csh2, csc2, cg2 = jnp.split(mod_c, 6, axis=-1)
        h = modulate(rms_norm(x, norm_mix[l]), sh1, sc1)
        hc = modulate(rms_norm(xc, norm_mix[l]), csh1, csc1)
        filt = (hy_filt_w1[l], hy_filt_b1[l], hy_filt_w2[l], hy_filt_b2[l], hy_filt_w3[l], hy_filt_b3[l], hy_filt_freq[l], hy_filt_out[l])
        o, oc = token_mixer(h, hc, rope_cos, rope_sin, w_in[l], b_in[l], hy_conv_w[l], hy_conv_b[l], filt, hy_skip[l], ga_q_norm[l], ga_k_norm[l], wa_sink[l], branch_norm[l], w_out[l], b_out[l], not last)
        x = x + g1 * o
        h = modulate(rms_norm(x, norm_ffn[l]), sh2, sc2).reshape(bsz * n, d)
        moe_w = (w_router[l], b_router[l], w_mlp1[l], b_mlp1[l], w_mlp2[l], b_mlp2[l])
        if last:
            x = x + g2 * moe_ffn(h, *moe_w).reshape(bsz, n, d)
        else:
            xc = xc + cg1 * oc
            hc = modulate(rms_norm(xc, norm_ffn[l]), csh2, csc2).reshape(-1, d)
            y = moe_ffn(jnp.concatenate([h, hc], axis=0), *moe_w)
            x = x + g2 * y[:bsz * n].reshape(bsz, n, d)
            xc = xc + cg2 * y[bsz * n:].reshape(xc.shape)
    return rms_norm(x, norm_final)
```

```cpp
#include <hip/hip_runtime.h>
#include <cstdio>
#include <cstdint>
#include <cmath>

#define GAS __attribute__((address_space(1)))
#define LAS __attribute__((address_space(3)))
typedef unsigned short bf16;
typedef unsigned v4u __attribute__((ext_vector_type(4)));
typedef unsigned v2u __attribute__((ext_vector_type(2)));
typedef float f32x4 __attribute__((ext_vector_type(4)));
typedef float f32x2 __attribute__((ext_vector_type(2)));
typedef short bf16x8 __attribute__((ext_vector_type(8)));
typedef GAS unsigned gu32;
#define RLX_AGENT __ATOMIC_RELAXED, __HIP_MEMORY_SCOPE_AGENT
#define LDS_WAIT() asm volatile("s_waitcnt lgkmcnt(0)" ::: "memory")
#define VM_WAIT() asm volatile("s_waitcnt vmcnt(0)" ::: "memory")

constexpr int NB = 8, SEQ = 4096, CTXL = 256, TPB = SEQ + CTXL  , MROWS = NB * TPB  , DM = 1024;
constexpr int INW = 2048, NEXP = 32, TOPK = 4, NLAYER = 2;
constexpr int NSLOT_MAX = ((MROWS * TOPK + 255) / 256 + NEXP) * 256;
constexpr int NBLK_MAX = NSLOT_MAX / 256;
constexpr float EPSN = 1e-6f;
constexpr float LOG2E = 1.4426950408889634f;
constexpr float C2Q = 0.125f * LOG2E;
constexpr int COL_HY = 0, COL_GAQ = 768, COL_GAK = 1152, COL_GAV = 1280, COL_WAQ = 1408, COL_WAK = 1792, COL_WAV = 1920;

constexpr size_t MiB = 1u << 20;
constexpr size_t WS_CTL = 0, CTL_ZERO_BYTES = 1 * MiB;
constexpr size_t WS_MOD = 5 * MiB;
constexpr size_t WS_ROPE = 6 * MiB;
constexpr size_t WS_WRT = 6 * MiB + 512 * 1024;
constexpr size_t WS_GC = 7 * MiB;
constexpr size_t WS_HIST = 8 * MiB;
constexpr size_t WS_EXPST = 8 * MiB + 256 * 1024;
constexpr size_t WS_TOPI = 9 * MiB;
constexpr size_t WS_TOPG = 10 * MiB;
constexpr size_t WS_TOKSLOT = 11 * MiB;
constexpr size_t WS_SLOTTOK = 12 * MiB;
constexpr size_t WS_GB = 16 * MiB;
constexpr size_t WS_WINT = 24 * MiB;
constexpr size_t WS_WOUTT = 32 * MiB;
constexpr size_t WS_W1T = 40 * MiB;
constexpr size_t WS_W2T = 296 * MiB;
constexpr size_t WS_X = 424 * MiB;
constexpr size_t WS_H = 560 * MiB;
constexpr size_t WS_P = 632 * MiB;
constexpr size_t WS_Y = 768 * MiB;
constexpr size_t WS_ZT = 836 * MiB;
constexpr size_t WS_X0T = 852 * MiB;
constexpr size_t WS_ZTC = 868 * MiB;
constexpr size_t WS_X0TC = 869 * MiB;
constexpr size_t WS_ACT = 872 * MiB;
constexpr size_t WS_OUTS = 1160 * MiB;
constexpr size_t WS_KC = 1448 * MiB;
constexpr size_t WS_VC = 1484 * MiB;
constexpr size_t WS_H8 = 1520 * MiB;
constexpr size_t WS_END = 1556 * MiB;
static_assert(WS_H + (size_t)(MROWS + 1) * DM * 2 <= WS_P && WS_ACT + (size_t)NSLOT_MAX * DM * 2 <= WS_OUTS && WS_OUTS + (size_t)NSLOT_MAX * DM * 2 <= WS_KC && WS_KC + (size_t)2 * 8 * 2 * TPB * 64 * 2 <= WS_VC && WS_VC + (size_t)2 * 8 * 2 * TPB * 64 * 2 <= WS_END, "ws map");
constexpr int CW_BAR = 4096;

constexpr int RING_BYTES = 131072;
constexpr int LDSX_OFF = RING_BYTES;
constexpr int ROWS_OFF = LDSX_OFF + 2048, BIAS_OFF = LDSX_OFF + 20480;
constexpr int MISC_OFF = RING_BYTES + 28672;
constexpr int WTAB_OFF = MISC_OFF + 256;
constexpr int LDS_BYTES = MISC_OFF + 512;

__device__ __forceinline__ unsigned f2bf(float f) { unsigned u = __builtin_bit_cast(unsigned, f); return (u + 0x7fffu + ((u >> 16) & 1u)) >> 16; }
__device__ __forceinline__ unsigned pk2(float lo, float hi) { return f2bf(lo) | (f2bf(hi) << 16); }
__device__ __forceinline__ float bf2f(unsigned short h) { return __builtin_bit_cast(float, (unsigned)h << 16); }
__device__ __forceinline__ float bflo(unsigned w) { return __builtin_bit_cast(float, w << 16); }
__device__ __forceinline__ float bfhi(unsigned w) { return __builtin_bit_cast(float, w & 0xffff0000u); }
__device__ __forceinline__ int lane_now() { int l; asm volatile("v_mbcnt_lo_u32_b32 %0, -1, 0\n\tv_mbcnt_hi_u32_b32 %0, -1, %0" : "=v"(l)); return l; }
__device__ __forceinline__ float shflx(float v, int mask) { return __builtin_bit_cast(float, __builtin_amdgcn_ds_bpermute((lane_now() ^ mask) << 2, __builtin_bit_cast(int, v))); }
__device__ __forceinline__ float wave_sum(float v) {
    const int ln = lane_now();
#pragma unroll
    for (int o = 1; o < 64; o <<= 1) v += __builtin_bit_cast(float, __builtin_amdgcn_ds_bpermute((ln ^ o) << 2, __builtin_bit_cast(int, v)));
    return v;
}

__device__ __forceinline__ int hw_slot() { return (int)__builtin_amdgcn_s_getreg((5 << 11) | 4) & 63; }
__device__ __forceinline__ int otid() {
    int l; asm volatile("v_mbcnt_lo_u32_b32 %0, -1, 0\n\tv_mbcnt_hi_u32_b32 %0, -1, %0" : "=v"(l));
    const int w = __builtin_amdgcn_readfirstlane(*(const volatile LAS int*)(WTAB_OFF + 4 * hw_slot()));
    return (w << 6) | l;
}

__device__ __forceinline__ unsigned cvt4_fp8(float a, float b, float c, float d) { int p = 0; p = __builtin_amdgcn_cvt_pk_fp8_f32(a, b, p, false); p = __builtin_amdgcn_cvt_pk_fp8_f32(c, d, p, true); return (unsigned)p; }

#define XB_TMO      128
#define XB_XCNT(j)  (256  + 64 * (j))
#define XB_XSUB(j)  (1280 + 64 * (j))
#define XB_XGEN(j)  (2304 + 64 * (j))
#define XB_TOP      3328
#define XB_TOPGEN   3392
#define XCD_BAR_WORDS 3456
#define XB_SPIN_CAP (1u << 18)

__device__ __forceinline__ unsigned xb_ld(unsigned* p)              { return __hip_atomic_load(p, __ATOMIC_RELAXED, __HIP_MEMORY_SCOPE_AGENT); }
__device__ __forceinline__ unsigned xb_add(unsigned* p, unsigned v) { return __hip_atomic_fetch_add(p, v, __ATOMIC_RELAXED, __HIP_MEMORY_SCOPE_AGENT); }
__device__ __forceinline__ unsigned xb_xcc_id() { return (unsigned)__builtin_amdgcn_s_getreg((3 << 11) | 20) & 0xFu; }
#define XB_SPIN(cond, bar) do { unsigned _sp = 0; while (cond) { __builtin_amdgcn_s_sleep(1); \
    if ((++_sp & 255u) == 0u) { if (xb_ld(&(bar)[XB_TMO])) break; if (_sp > XB_SPIN_CAP) { atomicAdd(&(bar)[XB_TMO], 1u); break; } } } } while (0)

struct XcdBarrier {
    unsigned* bar; unsigned x;
    volatile LAS unsigned* st;
};

__device__ __forceinline__ XcdBarrier xcd_barrier_post(unsigned* bar, volatile LAS unsigned* st) {
    XcdBarrier b; b.bar = bar; b.x = xb_xcc_id(); b.st = st;
    if (threadIdx.x == 0) (void)xb_add(&bar[XB_XCNT(b.x)], 1u);
    return b;
}
__device__ __forceinline__ void xcd_barrier_complete(unsigned* bar, unsigned x, unsigned& nloc, unsigned& nx) {
    const unsigned G = gridDim.x * gridDim.y * gridDim.z;
    unsigned sum, cnt, mine, sp = 0u;
    for (;;) {
        sum = 0u; cnt = 0u; mine = 0u;
#pragma unroll
        for (unsigned j = 0; j < 16; ++j) { const unsigned c = xb_ld(&bar[XB_XCNT(j)]); sum += c; cnt += (c > 0u) ? 1u : 0u; mine = (j == x) ? c : mine; }
        if (sum == G) break;
        __builtin_amdgcn_s_sleep(1);
        if ((++sp & 255u) == 0u) { if (xb_ld(&bar[XB_TMO])) break; if (sp > XB_SPIN_CAP) { atomicAdd(&bar[XB_TMO], 1u); break; } }
    }
    nloc = mine > 0u ? mine : 1u; nx = cnt > 0u ? cnt : 1u;
}

__device__ __forceinline__ void xcd_barrier(const XcdBarrier& b) {
    asm volatile("s_waitcnt vmcnt(0)" ::: "memory");
    __syncthreads();
    if (threadIdx.x == 0) {
        unsigned* bar = b.bar;
        __builtin_amdgcn_s_waitcnt(0);
        unsigned nloc = b.st[0], nx = b.st[1];
        if (nloc == 0u) { xcd_barrier_complete(bar, b.x, nloc, nx); b.st[0] = nloc; b.st[1] = nx; }
        const unsigned old = xb_add(&bar[XB_XSUB(b.x)], 1u);
        const unsigned gen = old / nloc;
        if (old + 1u == (gen + 1u) * nloc) {
            __builtin_amdgcn_fence(__ATOMIC_RELEASE, "agent");
            asm volatile("s_waitcnt vmcnt(0)" ::: "memory");
            const unsigned og = xb_add(&bar[XB_TOP], 1u);
            const unsigned tg = og / nx;
            if (og + 1u == (tg + 1u) * nx) xb_add(&bar[XB_TOPGEN], 1u);
            else XB_SPIN(xb_ld(&bar[XB_TOPGEN]) == tg, bar);
            __builtin_amdgcn_fence(__ATOMIC_ACQUIRE, "agent");
            xb_add(&bar[XB_XGEN(b.x)], 1u);
            asm volatile("s_waitcnt vmcnt(0)" ::: "memory");
        } else {
            XB_SPIN(xb_ld(&bar[XB_XGEN(b.x)]) == gen, bar);
            __builtin_amdgcn_fence(__ATOMIC_ACQUIRE, "agent");
            asm volatile("s_waitcnt vmcnt(0)" ::: "memory");
        }
    }
    __syncthreads();
}

namespace pg8 {
constexpr int BM = 256, BK = 64, HALF = 128, HTB = HALF * BK * 2, KK = 1024, NT = KK / BK, WSL = 6  ;
__device__ __forceinline__ int lds_byte(int r, int c) { const int st = (r >> 4) * 2 + (c >> 5), rr = r & 15, cc = c & 31, ob = rr * 64 + cc * 2; return st * 1024 + (ob ^ (((ob >> 9) & 1) << 5)); }
__device__ __forceinline__ void stage_rc(int b, int& R, int& C) { const int st = b / 1024, sb = b % 1024, swz = sb ^ (((sb >> 9) & 1) << 5); R = (st >> 1) * 16 + swz / 64; C = (st & 1) * 32 + (swz % 64) / 2; }
__device__ __forceinline__ int g8(int r) { return ((r >> 1) & 1) | (((r >> 3) & 1) << 2); }
__device__ __forceinline__ void stage_rc8(int b, int& R, int& Cb) { const int sb = b >> 11, q = (b & 2047) >> 4, r = q >> 3, cpos = q & 7; R = sb * 16 + r; Cb = (cpos ^ g8(r)) * 16; }
typedef int v8i __attribute__((ext_vector_type(8)));
using ::lane_now;
typedef int v4i __attribute__((ext_vector_type(4)));
__device__ __forceinline__ v8i ld8(const LAS unsigned char* lds, int off) { const v4i lo = *(const LAS v4i*)(lds + off), hi = *(const LAS v4i*)(lds + (off ^ 16)); return __builtin_shufflevector(lo, hi, 0, 1, 2, 3, 4, 5, 6, 7); }
__device__ __forceinline__ int perm32(int rho) { const int n = rho >> 4, i = rho & 15; return 8 * (i >> 2) + 4 * n + (i & 3); }
__device__ __forceinline__ unsigned cvt_pk_bf16(float lo, float hi) { unsigned r; asm volatile("v_cvt_pk_bf16_f32 %0, %1, %2" : "=v"(r) : "v"(lo), "v"(hi)); return r; }

struct Unit { int pm, pn, idx; };

template <class Epi, class Sched, bool GATHER, bool ALIGN_EPI, bool FP8 = false>
__device__ __forceinline__ void gemm_phase(LAS unsigned char* lds, const Sched& S, const Epi& E) {
    const int tid = otid(), wid = __builtin_amdgcn_readfirstlane(tid >> 6), lane = tid & 63, wr = wid >> 2, wc = wid & 3, fr = lane & 15, fq = lane >> 4;
    constexpr int K = KK, KB = FP8 ? KK : KK * 2  , nt = FP8 ? 8 : NT;
    unsigned voffB[2];
#pragma unroll
    for (int i = 0; i < 2; ++i) { int R, C; if constexpr (FP8) stage_rc8(tid * 16 + i * 8192, R, C); else { stage_rc(tid * 16 + i * 8192, R, C); C *= 2; }
        const int Rb = Epi::PERM ? ((R & ~31) + perm32(R & 31)) : R; voffB[i] = (unsigned)(Rb * KB + C); }
    int rA[2], cA2[2];
#pragma unroll
    for (int i = 0; i < 2; ++i) { int R, C; if constexpr (FP8) stage_rc8(tid * 16 + i * 8192, R, C); else { stage_rc(tid * 16 + i * 8192, R, C); C *= 2; } rA[i] = R; cA2[i] = C; }
#define PG8_AOF(dst, h, uidx) do { _Pragma("unroll") for (int _i = 0; _i < 2; ++_i) { \
        if constexpr (GATHER) dst[_i] = (unsigned)S.arow_idx((uidx), (h) * HALF + rA[_i]) * (unsigned)KB + (unsigned)cA2[_i]; \
        else dst[_i] = (unsigned)(rA[_i] * KB + cA2[_i]); } } while (0)
#define PG8_AH(h) (GATHER ? (size_t)0 : (size_t)(h) * hstep)
    constexpr size_t kstep = (size_t)(BK * 2);
    constexpr size_t hstep = (size_t)HALF * KB;
    const unsigned ldsw = (unsigned)wid * 1024u;
    const int l8 = (fr * 8 + ((2 * fq) ^ g8(fr))) * 16;
    const int aoff = FP8 ? wr * 8192 + l8 : lds_byte(wr * 64 + fr, fq * 8), boff = FP8 ? wc * 4096 + l8 : lds_byte(wc * 32 + fr, fq * 8);
#define PG8_SA(b, h) (((b) * 2 + (h)) * HTB)
#define PG8_SB(b, h) ((4 + (b) * 2 + (h)) * HTB)
#define PG8_STAGE(bufoff, gbase, voff) do { _Pragma("unroll") for (int _i = 0; _i < 2; ++_i) \
        __builtin_amdgcn_global_load_lds((const unsigned*)((const char*)(gbase) + (voff)[_i]), (LAS unsigned*)(lds + (bufoff) + ldsw + _i * 8192), 16, 0, 0); } while (0)
#define PG8_LD8(base) ld8(lds, (base))
#define PG8_LDA(dst, b, h) do { _Pragma("unroll") for (int m = 0; m < 4; ++m) { if constexpr (FP8) dst##8[m] = PG8_LD8(PG8_SA(b, h) + aoff + m * 2048); \
        else { _Pragma("unroll") for (int k = 0; k < 2; ++k) dst[m][k] = *(const LAS bf16x8*)(lds + PG8_SA(b, h) + aoff + m * 2048 + k * 1024); } } } while (0)
#define PG8_LDB(dst, b, h) do { _Pragma("unroll") for (int n = 0; n < 2; ++n) { if constexpr (FP8) dst##8[n] = PG8_LD8(PG8_SB(b, h) + boff + n * 2048); \
        else { _Pragma("unroll") for (int k = 0; k < 2; ++k) dst[n][k] = *(const LAS bf16x8*)(lds + PG8_SB(b, h) + boff + n * 2048 + k * 1024); } } } while (0)
#define PG8_MMA(ai, bj, At, Bt) do { __builtin_amdgcn_s_setprio(1); _Pragma("unroll") for (int m = 0; m < 4; ++m) _Pragma("unroll") for (int n = 0; n < 2; ++n) { \
        if constexpr (FP8) asm volatile("v_mfma_scale_f32_16x16x128_f8f6f4 %0, %1, %2, %0, %3, %3 op_sel_hi:[0,0,0]" : "+v"(acc[ai][bj][m][n]) : "v"(Bt##8[n]), "v"(At##8[m]), "v"(scw)); \
        else { _Pragma("unroll") for (int k = 0; k < 2; ++k) acc[ai][bj][m][n] = __builtin_amdgcn_mfma_f32_16x16x32_bf16(Bt[n][k], At[m][k], acc[ai][bj][m][n], 0, 0, 0); } } \
        __builtin_amdgcn_s_setprio(0); } while (0)
#define PG8_WAIT_V(n) asm volatile("s_waitcnt vmcnt(" #n ")" ::: "memory")
#define PG8_WAIT_L(n) asm volatile("s_waitcnt lgkmcnt(" #n ")" ::: "memory")
#define PG8_BAR __builtin_amdgcn_s_barrier()
#define PG8_SCHED __builtin_amdgcn_sched_barrier(0)
    LAS unsigned char* biasl = lds + BIAS_OFF;
#define PG8_BIAS(u, slot) do { _Pragma("unroll") for (int _j = 0; _j < Epi::NDMA; ++_j) \
        __builtin_amdgcn_global_load_lds((const unsigned*)E.bias_src((u), lane_now(), _j), (LAS unsigned*)(biasl + (slot) + _j * 1024), 16, 0, 0); } while (0)
    Unit cur, nxt; int ui = 0;
    if (!S.next(0, cur)) return;
    int bs_cur = 0, bs_nxt = 2048;
    PG8_BIAS(cur, 0);
    unsigned va[2];
    f32x4 acc[2][2][4][2];
#pragma unroll
    for (int a = 0; a < 2; ++a)
#pragma unroll
        for (int b = 0; b < 2; ++b)
#pragma unroll
            for (int m = 0; m < 4; ++m)
#pragma unroll
                for (int n = 0; n < 2; ++n) acc[a][b][m][n] = (f32x4){0.f, 0.f, 0.f, 0.f};
    int scw = (127 - WSL / 2) * 0x01010101;
    asm volatile("" : "+v"(scw));
    bf16x8 At[4][2], B0[2][2], B1[2][2]; v8i At8[4], B08[2], B18[2];
    const char* cA = S.abase(cur); const char* cB = S.bbase(cur);
    PG8_STAGE(PG8_SB(0, 0), cB, voffB); PG8_STAGE(PG8_SB(0, 1), cB + hstep, voffB); PG8_AOF(va, 0, cur.idx); PG8_STAGE(PG8_SA(0, 0), cA, va); PG8_AOF(va, 1, cur.idx); PG8_STAGE(PG8_SA(0, 1), cA + PG8_AH(1), va);
    if (wr == 1) PG8_BAR;
    PG8_WAIT_V(2); PG8_BAR;
    PG8_STAGE(PG8_SB(1, 0), cB + kstep, voffB); PG8_AOF(va, 0, cur.idx); PG8_STAGE(PG8_SA(1, 0), cA + kstep, va); PG8_STAGE(PG8_SB(1, 1), cB + hstep + kstep, voffB);
    PG8_WAIT_V(6); PG8_BAR;
    for (;;) {
        const bool has_next = S.next(ui + 1, nxt);
        if (has_next) PG8_BIAS(nxt, bs_nxt);
        const char* nA = has_next ? S.abase(nxt) : cA; const char* nB = has_next ? S.bbase(nxt) : cB;
#pragma unroll 1
        for (int t = 0; t < nt; t += 2) {
            const bool last = (t == nt - 2);
            const char* a1 = cA + (size_t)(t + 1) * kstep;
            const char* a2 = last ? nA : cA + (size_t)(t + 2) * kstep; const char* b2 = last ? nB : cB + (size_t)(t + 2) * kstep;
            const char* a3 = a2 + kstep; const char* b3 = b2 + kstep;
            const int idx2 = (last && has_next) ? nxt.idx : cur.idx;
            PG8_AOF(va, 1, cur.idx); PG8_LDB(B0, 0, 0); PG8_LDB(B1, 0, 1); PG8_SCHED; PG8_LDA(At, 0, 0); PG8_STAGE(PG8_SA(1, 1), a1 + PG8_AH(1), va);
            PG8_WAIT_V(8); PG8_WAIT_L(0); PG8_BAR; PG8_MMA(0, 0, At, B0); PG8_MMA(0, 1, At, B1); PG8_BAR; PG8_SCHED;
            PG8_AOF(va, 0, idx2); PG8_LDA(At, 0, 1); PG8_STAGE(PG8_SB(0, 0), b2, voffB); PG8_STAGE(PG8_SB(0, 1), b2 + hstep, voffB); PG8_STAGE(PG8_SA(0, 0), a2, va);
            PG8_WAIT_V(8); PG8_WAIT_L(0); PG8_BAR; PG8_MMA(1, 0, At, B0); PG8_MMA(1, 1, At, B1); PG8_BAR; PG8_SCHED;
            PG8_AOF(va, 1, idx2); PG8_LDB(B0, 1, 0); PG8_LDB(B1, 1, 1); PG8_SCHED; PG8_LDA(At, 1, 0); PG8_STAGE(PG8_SA(0, 1), a2 + PG8_AH(1), va);
            PG8_WAIT_V(8); PG8_WAIT_L(0); PG8_BAR; PG8_MMA(0, 0, At, B0); PG8_MMA(0, 1, At, B1); PG8_BAR; PG8_SCHED;
            PG8_AOF(va, 0, idx2); PG8_LDA(At, 1, 1); PG8_STAGE(PG8_SB(1, 0), b3, voffB); PG8_STAGE(PG8_SB(1, 1), b3 + hstep, voffB); PG8_STAGE(PG8_SA(1, 0), a3, va);
            PG8_WAIT_V(8); PG8_WAIT_L(0); PG8_BAR; PG8_MMA(1, 0, At, B0); PG8_MMA(1, 1, At, B1); PG8_BAR; PG8_SCHED;
        }
        if constexpr (FP8) asm volatile("s_nop 15\n\ts_nop 7" ::: "memory");
        if constexpr (ALIGN_EPI) { if (wr == 0) PG8_BAR; }
        E(acc, cur, wr, wc, fr, fq, biasl + bs_cur);
        if (!has_next) break;
#pragma unroll
        for (int a = 0; a < 2; ++a)
#pragma unroll
            for (int b = 0; b < 2; ++b)
#pragma unroll
                for (int m = 0; m < 4; ++m)
#pragma unroll
                    for (int n = 0; n < 2; ++n) acc[a][b][m][n] = (f32x4){0.f, 0.f, 0.f, 0.f};
        cur = nxt; cA = nA; cB = nB; ++ui; bs_cur = bs_nxt; bs_nxt = (bs_nxt == 4096) ? 0 : bs_nxt + 2048;
        if constexpr (ALIGN_EPI) { if (wr == 1) PG8_BAR; }
    }
    PG8_WAIT_V(0);
    if constexpr (!ALIGN_EPI) { if (wr == 0) PG8_BAR; }
    PG8_BAR;
#undef PG8_BIAS
#undef PG8_LD8
#undef PG8_AOF
#undef PG8_AH
#undef PG8_SA
#undef PG8_SB
#undef PG8_STAGE
#undef PG8_LDA
#undef PG8_LDB
#undef PG8_MMA
#undef PG8_WAIT_V
#undef PG8_WAIT_L
#undef PG8_BAR
#undef PG8_SCHED
}
}

#include <hip/hip_bf16.h>
namespace attn_body {
using bf16=__hip_bfloat16;
struct AttnJob { const bf16* Q; const bf16* K; const bf16* V; bf16* O; int q0, NT, nA, rA, rB, masked; float sink_l2, mfix; };
using bf16x8=__attribute__((ext_vector_type(8)))short;
using s16x4=__attribute__((ext_vector_type(4)))short;
using f32x16=__attribute__((ext_vector_type(16)))float;
using u32x4=__attribute__((ext_vector_type(4)))unsigned;
constexpr int D=64,PQ=2048,PKV=64,PO=1024;
constexpr int NW=8,QBLK=32,QB=QBLK*NW,KVBLK=64;
__device__ __forceinline__ int crow(int r,int hi){return (r&3)+8*(r>>2)+4*hi;}
#define SBAR() __builtin_amdgcn_sched_barrier(0)
__device__ __forceinline__ void wmask(f32x16&p0,f32x16&p1,int dk){
  const float NEG=-INFINITY; asm volatile("":"+v"(dk));
  #pragma unroll
  for(int r=0;r<16;++r){const int d=dk+(r&3)+8*(r>>2); if((unsigned)(d+128)>256u)p0[r]=NEG; if((unsigned)(d+160)>256u)p1[r]=NEG;}
}

constexpr int NSLOT=3, SLOTB=8192;
constexpr int LDS_K=0, LDS_V=NSLOT*SLOTB, LDS_WS=2*NSLOT*SLOTB, LDS_OST=LDS_WS+NW*64*4, LDS_BYTES=LDS_OST+NW*4096;
constexpr float C2=0.125f*1.4426950408889634f;
__device__ __forceinline__ void glds16(const void*gsrc,unsigned lds_dst){unsigned keep;
  asm volatile("s_mov_b32 %0, m0\n\ts_mov_b32 m0, %2\n\ts_nop 0\n\tglobal_load_lds_dwordx4 %1, off\n\ts_mov_b32 m0, %0":"=&s"(keep):"v"(gsrc),"s"(lds_dst):"memory");}
__device__ __forceinline__ float max3f(float a,float b,float c){float r;asm("v_max3_f32 %0, %1, %2, %3":"=v"(r):"v"(a),"v"(b),"v"(c));return r;}
__device__ __forceinline__ float max2f(float a,float b){float r;asm("v_max_f32_e32 %0, %1, %2":"=v"(r):"v"(a),"v"(b));return r;}
__device__ __forceinline__ float fadd_s(float a,float b){float r;asm("v_add_f32_e32 %0, %1, %2":"=v"(r):"v"(a),"v"(b));return r;}
__device__ __forceinline__ float fsub_s(float a,float b){float r;asm("v_sub_f32_e32 %0, %1, %2":"=v"(r):"v"(a),"v"(b));return r;}
typedef float f32x2_t __attribute__((ext_vector_type(2))); typedef __bf16 bf16x2_t __attribute__((ext_vector_type(2)));
__device__ __forceinline__ unsigned cvtpk_s(float lo,float hi){f32x2_t v={lo,hi};bf16x2_t b=__builtin_convertvector(v,bf16x2_t);return __builtin_bit_cast(unsigned,b);}
#define WAIT_BAR(N) asm volatile("s_waitcnt vmcnt(" #N ") lgkmcnt(0)\n\ts_barrier":::"memory")

__device__ __forceinline__ void qkt(f32x16&p0,f32x16&p1,const char*Kslot,const bf16x8*qr,const f32x16&negm,int r32,int hi){
  const char*kb=Kslot+hi*1024+r32*16;
  #pragma unroll
  for(int d0=0;d0<4;++d0){
    const bf16x8 b0=*reinterpret_cast<const bf16x8*>(kb+d0*2048);
    const bf16x8 b1=*reinterpret_cast<const bf16x8*>(kb+d0*2048+512);
    if(d0==0){p0=__builtin_amdgcn_mfma_f32_32x32x16_bf16(b0,qr[0],negm,0,0,0);p1=__builtin_amdgcn_mfma_f32_32x32x16_bf16(b1,qr[0],negm,0,0,0);}
    else{p0=__builtin_amdgcn_mfma_f32_32x32x16_bf16(b0,qr[d0],p0,0,0,0);p1=__builtin_amdgcn_mfma_f32_32x32x16_bf16(b1,qr[d0],p1,0,0,0);}}
}
typedef __attribute__((address_space(3))) const char* lds_cptr;
typedef short v4i16_t __attribute__((ext_vector_type(4)));
__device__ __forceinline__ void kload8(bf16x8*kf,lds_cptr kp){
  kf[0]=*(const __attribute__((address_space(3))) bf16x8*)(kp);      kf[1]=*(const __attribute__((address_space(3))) bf16x8*)(kp+512);
  kf[2]=*(const __attribute__((address_space(3))) bf16x8*)(kp+2048); kf[3]=*(const __attribute__((address_space(3))) bf16x8*)(kp+2560);
  kf[4]=*(const __attribute__((address_space(3))) bf16x8*)(kp+4096); kf[5]=*(const __attribute__((address_space(3))) bf16x8*)(kp+4608);
  kf[6]=*(const __attribute__((address_space(3))) bf16x8*)(kp+6144); kf[7]=*(const __attribute__((address_space(3))) bf16x8*)(kp+6656);
}
__device__ __forceinline__ void kload2(bf16x8*kf,lds_cptr kp,int j){ kf[2*j]=*(const __attribute__((address_space(3))) bf16x8*)(kp+j*2048); kf[2*j+1]=*(const __attribute__((address_space(3))) bf16x8*)(kp+j*2048+512); }
__device__ __forceinline__ s16x4 vtr(lds_cptr p){ return __builtin_bit_cast(s16x4,__builtin_amdgcn_ds_read_tr16_b64_v4i16((__attribute__((address_space(3))) v4i16_t*)p)); }
__device__ __forceinline__ float rowmax(const f32x16&p0,const f32x16&p1){
  float a=max3f(p0[0],p0[1],p1[0]),b=max3f(p0[2],p0[3],p1[1]);a=max3f(a,p1[2],p1[3]);
  #pragma unroll
  for(int r=4;r<16;r+=4){a=max3f(a,p0[r],p0[r+1]);b=max3f(b,p0[r+2],p0[r+3]);a=max3f(a,p1[r],p1[r+1]);b=max3f(b,p1[r+2],p1[r+3]);}
  const float m=max2f(a,b);
  auto rr=__builtin_amdgcn_permlane32_swap(__float_as_uint(m),__float_as_uint(m),false,false);
  return max2f(__uint_as_float(rr[0]),__uint_as_float(rr[1]));
}
__device__ __forceinline__ void pv(f32x16*o,int vb,bf16x8 pa0,bf16x8 pa1,bf16x8 pa2,bf16x8 pa3){
  #pragma unroll
  for(int d0=0;d0<2;++d0){s16x4 lo[4],hi[4];
    #pragma unroll
    for(int ks=0;ks<4;++ks){
      asm volatile("ds_read_b64_tr_b16 %0,%1 offset:%c2":"=&v"(lo[ks]):"v"(vb),"i"(d0*4096+ks*1024):"memory");
      asm volatile("ds_read_b64_tr_b16 %0,%1 offset:%c2":"=&v"(hi[ks]):"v"(vb),"i"(d0*4096+ks*1024+512):"memory");}
    asm volatile("s_waitcnt lgkmcnt(0)":::"memory");SBAR();
    #define PK(k) (bf16x8){lo[k][0],lo[k][1],lo[k][2],lo[k][3],hi[k][0],hi[k][1],hi[k][2],hi[k][3]}
    o[d0]=__builtin_amdgcn_mfma_f32_32x32x16_bf16(pa0,PK(0),o[d0],0,0,0);
    o[d0]=__builtin_amdgcn_mfma_f32_32x32x16_bf16(pa1,PK(1),o[d0],0,0,0);
    o[d0]=__builtin_amdgcn_mfma_f32_32x32x16_bf16(pa2,PK(2),o[d0],0,0,0);
    o[d0]=__builtin_amdgcn_mfma_f32_32x32x16_bf16(pa3,PK(3),o[d0],0,0,0);
    #undef PK
  }
}

#ifndef ATTN_STORE16
#define ATTN_STORE16(p,v) (*(u32x4*)(p)=(v))
#endif
template<int THRL> __device__ __forceinline__ void attn_unit(const AttnJob&J,char*shm){
  const int tid=otid(),lane=tid&63,r32=lane&31,hi=lane>>5; const int wid=__builtin_amdgcn_readfirstlane(tid>>6);
  const int q0=J.q0;
  const bf16*Qw=J.Q+(long)(q0+wid*QBLK)*PQ;
  const bf16*Kh=J.K,*Vh=J.V;
  const unsigned lds0=(unsigned)(uintptr_t)shm;
  float*wsf=(float*)(shm+LDS_WS)+wid*64;
  const bf16*ksrc=Kh+(long)lane*PKV+wid*8;
  const bf16*vsrc=Vh+(long)(16*(wid&3)+(lane>>2))*PKV+(wid>>2)*32+(lane&3)*8;
  const unsigned kdst=lds0+LDS_K+wid*1024, vdst=lds0+LDS_V+wid*1024;
  #define TROW(t) (((t)<nA)?(rA+64*(t)):(rB+64*((t)-nA)))
  #define DMA_K(t,slot) glds16(ksrc+(long)TROW(t)*PKV,(unsigned)__builtin_amdgcn_readfirstlane(kdst+(slot)))
  #define DMA_V(t,slot) glds16(vsrc+(long)TROW(t)*PKV,(unsigned)__builtin_amdgcn_readfirstlane(vdst+(slot)))
  const int vb0=(int)(lds0+LDS_V)+((lane>>4)&1)*32+(lane&3)*8+(4*hi+((lane&15)>>2))*64;
  const char*Kbase=shm+LDS_K; bf16x8 kf[8];
  const lds_cptr shm3=(lds_cptr)shm; const lds_cptr kp0=shm3+LDS_K+hi*1024+r32*16; const lds_cptr vp0=shm3+LDS_V+((lane>>4)&1)*32+(lane&3)*8+(4*hi+((lane&15)>>2))*64;
  const int NT=J.NT,nA=J.nA,rA=J.rA,rB=J.rB; const bool msk=(J.masked!=0);
  DMA_K(0,0);DMA_V(0,0);DMA_K(1,SLOTB);
  bf16x8 qr[4];
  #pragma unroll
  for(int d0=0;d0<4;++d0)qr[d0]=*reinterpret_cast<const bf16x8*>(&Qw[(long)r32*PQ+d0*16+hi*8]);
  float mhat=0.f,l_reg=0.f;f32x16 o[2];o[0]=f32x16{};o[1]=f32x16{};f32x16 negm=f32x16{};asm volatile("":"+v"(negm));
  const int qpos=q0+wid*QBLK+r32;
  #define CMASK(P0,P1,t) do{ if(msk&&(t)>=nA)wmask(P0,P1,TROW(t)+4*hi-qpos); }while(0)
  bool resc=false;
  const bool nomax=(J.mfix>0.f);
  #define START(P0,P1) do{ const float rm=nomax?J.mfix:rowmax(P0,P1); resc=false; \
    { const float dl=rm; mhat=fadd_s(mhat,dl); \
      _Pragma("unroll") for(int r=0;r<16;++r){P0[r]=fsub_s(P0[r],dl);P1[r]=fsub_s(P1[r],dl);} \
      _Pragma("unroll") for(int r=0;r<16;++r)negm[r]=-mhat; asm volatile("":"+v"(negm)); } \
    _Pragma("unroll") for(int r=0;r<16;++r)P0[r]=__builtin_amdgcn_exp2f(P0[r]); }while(0)
  #define RESC() do{ if(resc){ asm volatile("s_waitcnt lgkmcnt(0)":::"memory"); \
      _Pragma("unroll") for(int d_=0;d_<2;++d_) _Pragma("unroll") for(int r=0;r<16;++r)o[d_][r]*=wsf[crow(r,hi)]; } }while(0)
  f32x16 pA0,pA1,pB0,pB1;
  int sl_prev=0,sl_cur=0,sl_next=SLOTB;
  #define ROT() do{sl_prev=sl_cur;sl_cur=sl_next;sl_next=(sl_next==(NSLOT-1)*SLOTB)?0:sl_next+SLOTB;}while(0)
  DMA_K(2,2*SLOTB);
  WAIT_BAR(3);
  qkt(pA0,pA1,Kbase,qr,negm,r32,hi);asm volatile("s_nop 15\n\ts_nop 7":"+v"(pA0),"+v"(pA1));CMASK(pA0,pA1,0);
  START(pA0,pA1);
  _Pragma("unroll") for(int r=0;r<16;++r)pA1[r]=__builtin_amdgcn_exp2f(pA1[r]);
  WAIT_BAR(0);
  DMA_K(3,0);DMA_V(1,SLOTB);
  ROT();
  kload8(kf,kp0+sl_cur);
  WAIT_BAR(2);
  s16x4 vlo[8],vhi[8]; u32x4 pw0,pw1,pw2,pw3;
  #define PKW(P,B) cvtpk_s(P[B],P[B+1])
  #define PAF(k) __builtin_bit_cast(bf16x8,pw##k)
  #define VFR(i) (bf16x8){vlo[i][0],vlo[i][1],vlo[i][2],vlo[i][3],vhi[i][0],vhi[i][1],vhi[i][2],vhi[i][3]}
  #define PIN(x) asm volatile("":"+v"(x))
  #define MX3(a,b,c) __builtin_fmaxf(__builtin_fmaxf((a),(b)),(c))
  #define GAPA(MF,A0,A1,A2,A3,W0,W1,PW) do{ MF; sacc+=A0; sacc+=A1; sacc+=A2; sacc+=A3; PIN(sacc); W0; W1; PIN(PW); SBAR(); }while(0)
  #define EX(v) __builtin_amdgcn_exp2f(v)
  #define GAPB(MF,X,B) do{ MF; X[B]=EX(X[B]); X[B+1]=EX(X[B+1]); X[B+2]=EX(X[B+2]); X[B+3]=EX(X[B+3]); PIN(X); SBAR(); }while(0)
  #define VRD(i) do{ vlo[i]=vtr(vp_+(((i)>>2)*4096+((i)&3)*1024)); vhi[i]=vtr(vp_+(((i)>>2)*4096+((i)&3)*1024+512)); }while(0)
  #define KRD(G,j) do{ if(G){ kload2(kf,kp0+sl_next,j); SBAR(); } }while(0)
  #define STEP(C0,C1,P0,P1,t,GK,GV,GL) do{ SBAR(); \
    const lds_cptr vp_=vp0+sl_prev; \
    VRD(0); SBAR(); float sacc=(P0[0]+P0[1]); \
    GAPA(C0=__builtin_amdgcn_mfma_f32_32x32x16_bf16(kf[0],qr[0],negm,0,0,0), P0[2],P0[3],P0[4],P0[5],     pw0[0]=PKW(P0,0), pw0[1]=PKW(P0,2), pw0); \
    VRD(4); SBAR(); GAPA(C1=__builtin_amdgcn_mfma_f32_32x32x16_bf16(kf[1],qr[0],negm,0,0,0), P0[6],P0[7],P0[8],P0[9],     pw0[2]=PKW(P0,4), pw0[3]=PKW(P0,6), pw0); \
    VRD(1); SBAR(); GAPA(C0=__builtin_amdgcn_mfma_f32_32x32x16_bf16(kf[2],qr[1],C0,0,0,0),   P0[10],P0[11],P0[12],P0[13], pw1[0]=PKW(P0,8), pw1[1]=PKW(P0,10), pw1); \
    VRD(5); SBAR(); GAPA(C1=__builtin_amdgcn_mfma_f32_32x32x16_bf16(kf[3],qr[1],C1,0,0,0),   P0[14],P0[15],P1[0],P1[1],   pw1[2]=PKW(P0,12),pw1[3]=PKW(P0,14), pw1); \
    VRD(2); SBAR(); GAPA(C0=__builtin_amdgcn_mfma_f32_32x32x16_bf16(kf[4],qr[2],C0,0,0,0),   P1[2],P1[3],P1[4],P1[5],     pw2[0]=PKW(P1,0), pw2[1]=PKW(P1,2), pw2); \
    VRD(6); SBAR(); GAPA(C1=__builtin_amdgcn_mfma_f32_32x32x16_bf16(kf[5],qr[2],C1,0,0,0),   P1[6],P1[7],P1[8],P1[9],     pw2[2]=PKW(P1,4), pw2[3]=PKW(P1,6), pw2); \
    VRD(3); SBAR(); GAPA(C0=__builtin_amdgcn_mfma_f32_32x32x16_bf16(kf[6],qr[3],C0,0,0,0),   P1[10],P1[11],P1[12],P1[13], pw3[0]=PKW(P1,8), pw3[1]=PKW(P1,10), pw3); \
    VRD(7); SBAR(); GAPA(C1=__builtin_amdgcn_mfma_f32_32x32x16_bf16(kf[7],qr[3],C1,0,0,0),   P1[14],P1[15],0.f,0.f,       pw3[2]=PKW(P1,12),pw3[3]=PKW(P1,14), pw3); \
    l_reg+=sacc; \
    if(GK){DMA_K((t)+3,sl_cur);} if(GV){DMA_V((t)+1,sl_next);} \
    CMASK(C0,C1,t); \
    resc=false; if(!nomax){ float a=MX3(C0[0],C0[1],C1[0]),b=MX3(C0[2],C0[3],C1[1]); a=MX3(a,C1[2],C1[3]); \
      _Pragma("unroll") for(int r=4;r<16;r+=4){a=MX3(a,C0[r],C0[r+1]);b=MX3(b,C0[r+2],C0[r+3]);a=MX3(a,C1[r],C1[r+1]);b=MX3(b,C1[r+2],C1[r+3]);} \
      float rm=__builtin_fmaxf(a,b); { auto rr=__builtin_amdgcn_permlane32_swap(__float_as_uint(rm),__float_as_uint(rm),false,false); rm=__builtin_fmaxf(__uint_as_float(rr[0]),__uint_as_float(rr[1])); } \
      resc=false; \
      if(__builtin_expect(__any(rm>(float)THRL),0)){ const float dl=__builtin_fmaxf(rm,0.f); mhat+=dl; \
        _Pragma("unroll") for(int r=0;r<16;++r){C0[r]-=dl;C1[r]-=dl;} \
        _Pragma("unroll") for(int r=0;r<16;++r)negm[r]=-mhat; asm volatile("":"+v"(negm)); \
        const float f=__builtin_amdgcn_exp2f(-dl); l_reg*=f; if(hi==0)wsf[r32]=f; resc=true; } } \
    SBAR(); \
    GAPB(o[0]=__builtin_amdgcn_mfma_f32_32x32x16_bf16(PAF(0),VFR(0),o[0],0,0,0), C0,0); \
    GAPB(o[1]=__builtin_amdgcn_mfma_f32_32x32x16_bf16(PAF(0),VFR(4),o[1],0,0,0), C0,4); \
    KRD(GL,0); GAPB(o[0]=__builtin_amdgcn_mfma_f32_32x32x16_bf16(PAF(1),VFR(1),o[0],0,0,0), C0,8); \
    KRD(GL,1); GAPB(o[1]=__builtin_amdgcn_mfma_f32_32x32x16_bf16(PAF(1),VFR(5),o[1],0,0,0), C0,12); \
    KRD(GL,2); GAPB(o[0]=__builtin_amdgcn_mfma_f32_32x32x16_bf16(PAF(2),VFR(2),o[0],0,0,0), C1,0); \
    KRD(GL,3); GAPB(o[1]=__builtin_amdgcn_mfma_f32_32x32x16_bf16(PAF(2),VFR(6),o[1],0,0,0), C1,4); \
    GAPB(o[0]=__builtin_amdgcn_mfma_f32_32x32x16_bf16(PAF(3),VFR(3),o[0],0,0,0), C1,8); \
    GAPB(o[1]=__builtin_amdgcn_mfma_f32_32x32x16_bf16(PAF(3),VFR(7),o[1],0,0,0), C1,12); \
    }while(0)
  int t=1;
  #undef CMASK
  #define CMASK(P0,P1,t) do{}while(0)
  for(;(!msk)&&t+5<NT;t+=2){
    STEP(pB0,pB1,pA0,pA1,t,true,true,true);     WAIT_BAR(2); RESC(); ROT();
    STEP(pA0,pA1,pB0,pB1,t+1,true,true,true);   WAIT_BAR(2); RESC(); ROT();
  }
  #undef CMASK
  #define CMASK(P0,P1,t) do{ if(msk&&(t)>=nA)wmask(P0,P1,TROW(t)+4*hi-qpos); }while(0)
  #define ENDW(tt) do{ if((tt)+3<NT){WAIT_BAR(2);} else if((tt)+2<NT){WAIT_BAR(1);} else {WAIT_BAR(0);} }while(0)
  for(;t+1<NT;t+=2){
    STEP(pB0,pB1,pA0,pA1,t,(t+3<NT),(t+1<NT),(t+1<NT));       ENDW(t);   RESC(); ROT();
    STEP(pA0,pA1,pB0,pB1,t+1,(t+4<NT),(t+2<NT),(t+2<NT));     ENDW(t+1); RESC(); ROT();
  }
  STEP(pB0,pB1,pA0,pA1,NT-1,false,false,false); RESC();
  { float sacc=pB0[0]+pB0[1]; _Pragma("unroll") for(int r=2;r<16;++r)sacc+=pB0[r]; _Pragma("unroll") for(int r=0;r<16;++r)sacc+=pB1[r]; l_reg+=sacc;
    pw0=(u32x4){PKW(pB0,0),PKW(pB0,2),PKW(pB0,4),PKW(pB0,6)};pw1=(u32x4){PKW(pB0,8),PKW(pB0,10),PKW(pB0,12),PKW(pB0,14)};pw2=(u32x4){PKW(pB1,0),PKW(pB1,2),PKW(pB1,4),PKW(pB1,6)};pw3=(u32x4){PKW(pB1,8),PKW(pB1,10),PKW(pB1,12),PKW(pB1,14)};
    SBAR(); pv(o,vb0+sl_cur,PAF(0),PAF(1),PAF(2),PAF(3)); }
  #undef PKW
  #undef PAF
  #undef VFR
  #undef PIN
  #undef MX3
  #undef GAPA
  #undef GAPB
  #undef EX
  #undef VRD
  #undef KRD
  #undef STEP
  #undef ENDW
  if(hi==0)l_reg+=__builtin_amdgcn_exp2f(J.sink_l2-mhat);
  {auto rr=__builtin_amdgcn_permlane32_swap(__float_as_uint(l_reg),__float_as_uint(l_reg),false,false);l_reg=__uint_as_float(rr[0])+__uint_as_float(rr[1]);}
  if(hi==0)wsf[32+r32]=l_reg;asm volatile("s_waitcnt lgkmcnt(0)":::"memory");
  float rli[16];
  #pragma unroll
  for(int r=0;r<16;++r)rli[r]=__builtin_amdgcn_rcpf(wsf[32+crow(r,hi)]);
  bf16*Ow=J.O+(long)(q0+wid*QBLK)*PO;
  { bf16*stg=(bf16*)(shm+LDS_OST)+wid*2048;
    #pragma unroll
    for(int r=0;r<16;++r){const int orow=crow(r,hi);
      #pragma unroll
      for(int d0=0;d0<2;++d0)stg[orow*64+d0*32+r32]=__float2bfloat16(o[d0][r]*rli[r]);}
    asm volatile("s_waitcnt lgkmcnt(0)":::"memory");
    #pragma unroll
    for(int i=0;i<4;++i){const int row=i*8+(lane>>3),ch=lane&7; const u32x4 v=*(const u32x4*)(stg+row*64+ch*8); ATTN_STORE16(Ow+(long)row*PO+ch*8,v);} }
  asm volatile("s_waitcnt lgkmcnt(0)\n\ts_barrier":::"memory");
  #undef DMA_K
  #undef TROW
  #undef DMA_V
  #undef CMASK
  #undef START
  #undef RESC
  #undef ROT
}
constexpr int ATTN_LDS_BYTES=LDS_BYTES;
#undef SBAR
#undef WAIT_BAR
}

#define DPPF(v, ctrl) __builtin_bit_cast(float, __builtin_amdgcn_update_dpp(0, __builtin_bit_cast(int, (v)), (ctrl), 0xF, 0xF, false))
struct Args { const float* in[34]; float* out; unsigned char* ws; int ph_lo, ph_hi; };
enum { I_X = 0, I_C, I_CTX, I_CCTX, I_WADA, I_BADA, I_NMIX, I_NFFN, I_WIN, I_BIN, I_CONVW, I_CONVB, I_FW1, I_FB1, I_FW2, I_FB2, I_FW3, I_FB3, I_FFREQ, I_FOUT, I_SKIP,
       I_QNORM, I_KNORM, I_SINK, I_BNORM, I_WOUT, I_BOUT, I_WR, I_BR, I_W1, I_B1, I_W2, I_B2, I_NFINAL };

#define KARG_PTRS ((const void* const __attribute__((address_space(4)))*)__builtin_amdgcn_kernarg_segment_ptr())
__device__ __forceinline__ unsigned char* ws_ptr(const Args&) { int i = 35; asm volatile("" : "+s"(i)); return (unsigned char*)KARG_PTRS[i]; }
__device__ __forceinline__ bool in_range(const Args&, int k) { int i = 72; asm volatile("" : "+s"(i)); const int __attribute__((address_space(4)))* p = (const int __attribute__((address_space(4)))*)__builtin_amdgcn_kernarg_segment_ptr(); const int lo = p[i], hi = p[i + 1]; return lo <= k && k < hi; }
#define WSP(T, off) ((T*)(ws_ptr(A) + (off)))
__device__ __forceinline__ const float* inp_ptr(const Args&, int i) { asm volatile("" : "+s"(i)); return (const float*)KARG_PTRS[i]; }
#define INP(i) inp_ptr(A, (i))
__device__ __forceinline__ int lat_row(int i) { return (i >> 12) * TPB + (i & 4095); }
__device__ __forceinline__ int lat_tile(int i) { return (i >> 4) * 17 + (i & 15); }

struct SchedProj {
    const char* Ab; const char* Bb; int l, G, c;
    __device__ __forceinline__ bool next(int i, pg8::Unit& u) const {
        const int L = i * G + c;
        u.idx = i; if (l == 0) { if (L >= 136 * 8) return false; u.pm = L >> 3; u.pn = L & 7; return true; }
        if (L < 1024) { u.pm = lat_tile(L >> 3); u.pn = L & 7; return true; }
        const int j = L - 1024; if (j >= 24) return false;
        const int b = j / 3, q = j - 3 * b; u.pm = b * 17 + 16; u.pn = q == 0 ? 4 : (q == 1 ? 5 : 7); return true;
    }
    __device__ __forceinline__ const char* abase(const pg8::Unit& u) const { return Ab + (size_t)u.pm * (256 * 1024 * 2); }
    __device__ __forceinline__ const char* bbase(const pg8::Unit& u) const { return Bb + (size_t)u.pn * (256 * 1024 * 2); }
    __device__ __forceinline__ int arow_idx(int, int) const { return 0; }
};
struct EpiProj {
    static constexpr bool PERM = true; static constexpr int NDMA = 1;
    bf16* P; const float* bias;
    __device__ __forceinline__ const float* bias_src(const pg8::Unit& u, int lane, int) const { return bias + u.pn * 256 + 4 * lane; }
    __device__ __forceinline__ void operator()(const f32x4 (&acc)[2][2][4][2], const pg8::Unit& u, int wr, int wc, int fr, int fq, const LAS unsigned char* bl) const {
        const int row0 = u.pm * 256 + wr * 64 + fr, col0 = u.pn * 256 + wc * 32 + 8 * fq;
        f32x4 bv[2][2];
#pragma unroll
        for (int bj = 0; bj < 2; ++bj)
#pragma unroll
            for (int n = 0; n < 2; ++n) bv[bj][n] = *(const LAS f32x4*)(bl + (wc * 32 + 8 * fq + bj * 128 + 4 * n) * 4);
#pragma unroll
        for (int ai = 0; ai < 2; ++ai)
#pragma unroll
            for (int m = 0; m < 4; ++m) { bf16* rowp = P + (size_t)(row0 + ai * 128 + m * 16) * INW + col0;
#pragma unroll
                for (int bj = 0; bj < 2; ++bj) { const f32x4 v0 = acc[ai][bj][m][0] + bv[bj][0], v1 = acc[ai][bj][m][1] + bv[bj][1];
                    v4u w; w.x = pg8::cvt_pk_bf16(v0[0], v0[1]); w.y = pg8::cvt_pk_bf16(v0[2], v0[3]); w.z = pg8::cvt_pk_bf16(v1[0], v1[1]); w.w = pg8::cvt_pk_bf16(v1[2], v1[3]);
                    *(v4u*)(rowp + bj * 128) = w; } }
    }
};
struct SchedOut {
    const char* Ab; const char* Bb; int l, G, c;
    __device__ __forceinline__ bool next(int i, pg8::Unit& u) const {
        const int L = i * G + c;
        u.idx = i; if (l == 0) { if (L >= 136 * 4) return false; u.pm = L >> 2; u.pn = L & 3; return true; }
        if (L >= 128 * 4) return false; u.pm = lat_tile(L >> 2); u.pn = L & 3; return true;
    }
    __device__ __forceinline__ const char* abase(const pg8::Unit& u) const { return Ab + (size_t)u.pm * (256 * 1024 * 2); }
    __device__ __forceinline__ const char* bbase(const pg8::Unit& u) const { return Bb + (size_t)u.pn * (256 * 1024 * 2); }
    __device__ __forceinline__ int arow_idx(int, int) const { return 0; }
};
struct EpiOut {
    static constexpr bool PERM = true; static constexpr int NDMA = 2;
    bf16* X; const float* bias; const float* g1;
    const float* xin; const float* cin;
    __device__ __forceinline__ const float* bias_src(const pg8::Unit& u, int lane, int j) const {
        const int tb = u.pm / 17, tt = u.pm - 17 * tb, mi = (tt == 16) ? 8 : tb;
        return (j == 0 ? bias : g1 + mi * 6144) + u.pn * 256 + 4 * lane; }
    __device__ __forceinline__ void operator()(const f32x4 (&acc)[2][2][4][2], const pg8::Unit& u, int wr, int wc, int fr, int fq, const LAS unsigned char* bl) const {
        const int col0 = u.pn * 256 + wc * 32 + 8 * fq;
        const int tb = u.pm / 17, tt = u.pm - 17 * tb;
        bf16* db = X + (size_t)u.pm * 256 * DM;
        const float* sb = (tt == 16) ? cin + (size_t)tb * CTXL * DM : xin + ((size_t)tb * SEQ + tt * 256) * DM;
        f32x4 bv[2][2], gv[2][2];
#pragma unroll
        for (int bj = 0; bj < 2; ++bj)
#pragma unroll
            for (int n = 0; n < 2; ++n) { bv[bj][n] = *(const LAS f32x4*)(bl + (wc * 32 + 8 * fq + bj * 128 + 4 * n) * 4); gv[bj][n] = *(const LAS f32x4*)(bl + 1024 + (wc * 32 + 8 * fq + bj * 128 + 4 * n) * 4); }
#pragma unroll
        for (int ai = 0; ai < 2; ++ai)
#pragma unroll
          for (int mp = 0; mp < 2; ++mp) {
            f32x4 x0[2][2], x1[2][2];
            if (xin) {
#pragma unroll
                for (int mm = 0; mm < 2; ++mm)
#pragma unroll
                    for (int bj = 0; bj < 2; ++bj) { const int off = (wr * 64 + fr + ai * 128 + (2 * mp + mm) * 16) * DM + col0 + bj * 128; x0[mm][bj] = *(const f32x4*)(sb + off); x1[mm][bj] = *(const f32x4*)(sb + off + 4); }
            } else { v4u w_[2][2];
#pragma unroll
                for (int mm = 0; mm < 2; ++mm)
#pragma unroll
                    for (int bj = 0; bj < 2; ++bj) w_[mm][bj] = *(const v4u*)(db + (wr * 64 + fr + ai * 128 + (2 * mp + mm) * 16) * DM + col0 + bj * 128);
#pragma unroll
                for (int mm = 0; mm < 2; ++mm)
#pragma unroll
                    for (int bj = 0; bj < 2; ++bj) { const v4u w = w_[mm][bj]; x0[mm][bj] = (f32x4){bflo(w.x), bfhi(w.x), bflo(w.y), bfhi(w.y)}; x1[mm][bj] = (f32x4){bflo(w.z), bfhi(w.z), bflo(w.w), bfhi(w.w)}; }
            }
#pragma unroll
            for (int mm = 0; mm < 2; ++mm)
#pragma unroll
                for (int bj = 0; bj < 2; ++bj) { const int m = 2 * mp + mm; const int off = (wr * 64 + fr + ai * 128 + m * 16) * DM + col0 + bj * 128;
                    const f32x4 y0 = x0[mm][bj] + gv[bj][0] * (acc[ai][bj][m][0] + bv[bj][0]), y1 = x1[mm][bj] + gv[bj][1] * (acc[ai][bj][m][1] + bv[bj][1]);
                    v4u o; o.x = pg8::cvt_pk_bf16(y0[0], y0[1]); o.y = pg8::cvt_pk_bf16(y0[2], y0[3]); o.z = pg8::cvt_pk_bf16(y1[0], y1[1]); o.w = pg8::cvt_pk_bf16(y1[2], y1[3]);
                    *(v4u*)(db + off) = o; }
          }
    }
};
struct SchedMoe {
    const char* Ab; const char* Bb; const LAS int* rows; const LAS unsigned char* blkexp; int nblk, npn_shift, G, c; size_t bexp_stride;
    __device__ __forceinline__ bool next(int i, pg8::Unit& u) const {
        const int L = i * G + c; const int blk = L >> npn_shift; if (blk >= nblk) return false;
        u.pm = blk; u.pn = L & ((1 << npn_shift) - 1); u.idx = i; return true;
    }
    __device__ __forceinline__ int expert(const pg8::Unit& u) const { return __builtin_amdgcn_readfirstlane((int)blkexp[u.pm]); }
    __device__ __forceinline__ const char* abase(const pg8::Unit& u) const { return rows ? Ab : Ab + (size_t)u.pm * (256 * 1024); }
    __device__ __forceinline__ const char* bbase(const pg8::Unit& u) const { return Bb + (size_t)expert(u) * bexp_stride + (size_t)u.pn * (256 * 1024); }
    __device__ __forceinline__ int arow_idx(int idx, int r) const { return rows[idx * 256 + r]; }
};
__device__ __forceinline__ v4u pair16(v2u wm, v2u wn) {
    unsigned ax = wm.x, bx = wn.x, ay = wm.y, by = wn.y;
    asm volatile("s_nop 1\n\tv_permlane16_swap_b32 %0, %1" : "+v"(ax), "+v"(bx));
    asm volatile("s_nop 1\n\tv_permlane16_swap_b32 %0, %1" : "+v"(ay), "+v"(by));
    return (v4u){ax, ay, bx, by};
}
struct EpiGlu {
    static constexpr bool PERM = true; static constexpr int NDMA = 1;
    unsigned char* ACT; const float* b1; const SchedMoe* S; int dry;
    __device__ __forceinline__ const float* bias_src(const pg8::Unit& u, int lane, int) const {
        return b1 + S->expert(u) * 2048 + ((lane >> 5) << 10) + u.pn * 128 + 4 * (lane & 31); }
    __device__ __forceinline__ void operator()(const f32x4 (&acc)[2][2][4][2], const pg8::Unit& u, int wr, int wc, int fr, int fq, const LAS unsigned char* bls) const {
        if (dry) return;
        const int row0 = u.pm * 256 + wr * 64 + fr, j0 = u.pn * 128 + wc * 32 + 8 * fq;
        f32x4 bg[2], bl[2];
#pragma unroll
        for (int n = 0; n < 2; ++n) { bg[n] = *(const LAS f32x4*)(bls + (wc * 32 + 8 * fq + 4 * n) * 4); bl[n] = *(const LAS f32x4*)(bls + 512 + (wc * 32 + 8 * fq + 4 * n) * 4); }
#pragma unroll
        for (int ai = 0; ai < 2; ++ai)
#pragma unroll
            for (int mp = 0; mp < 2; ++mp) { v2u wv[2];
#pragma unroll
              for (int mm = 0; mm < 2; ++mm) { const int m = 2 * mp + mm;
                float o[8];
#pragma unroll
                for (int n = 0; n < 2; ++n) { const f32x4 g = acc[ai][0][m][n] + bg[n], li = acc[ai][1][m][n] + bl[n];
#pragma unroll
                    for (int q = 0; q < 4; q += 2) {
                        const f32x2 gl = (f32x2){fminf(g[q], 7.0f), fminf(g[q + 1], 7.0f)};
                        const f32x2 ln1 = (f32x2){__builtin_amdgcn_fmed3f(li[q], -7.0f, 7.0f), __builtin_amdgcn_fmed3f(li[q + 1], -7.0f, 7.0f)} + 1.0f;
                        const f32x2 ea = gl * (-1.702f * LOG2E);
                        const f32x2 den = (f32x2){__builtin_amdgcn_exp2f(ea.x), __builtin_amdgcn_exp2f(ea.y)} + 1.0f;
                        const f32x2 sg = (f32x2){__builtin_amdgcn_rcpf(den.x), __builtin_amdgcn_rcpf(den.y)};
                        const f32x2 r = (gl * sg) * ln1;
                        o[4 * n + q] = r.x; o[4 * n + q + 1] = r.y; } }
                wv[mm].x = cvt4_fp8(o[0], o[1], o[2], o[3]); wv[mm].y = cvt4_fp8(o[4], o[5], o[6], o[7]); }
              const v4u w16 = pair16(wv[0], wv[1]);
              const unsigned off = (unsigned)(row0 + ai * 128 + (2 * mp + (fq & 1)) * 16) * (unsigned)DM + (unsigned)(j0 - 8 * (fq & 1));
              *(v4u*)(ACT + off) = w16; }
    }
};
struct EpiOuts {
    static constexpr bool PERM = true; static constexpr int NDMA = 1;
    unsigned char* O; const float* b2; const SchedMoe* S; int dry;
    __device__ __forceinline__ const float* bias_src(const pg8::Unit& u, int lane, int) const { return b2 + S->expert(u) * 1024 + u.pn * 256 + 4 * lane; }
    __device__ __forceinline__ void operator()(const f32x4 (&acc)[2][2][4][2], const pg8::Unit& u, int wr, int wc, int fr, int fq, const LAS unsigned char* bl) const {
        if (dry) return;
        const int row0 = u.pm * 256 + wr * 64 + fr, col0 = u.pn * 256 + wc * 32 + 8 * fq;
        f32x4 bv[2][2];
#pragma unroll
        for (int bj = 0; bj < 2; ++bj)
#pragma unroll
            for (int n = 0; n < 2; ++n) bv[bj][n] = *(const LAS f32x4*)(bl + (wc * 32 + 8 * fq + bj * 128 + 4 * n) * 4);
#pragma unroll
        for (int ai = 0; ai < 2; ++ai)
#pragma unroll
            for (int mp = 0; mp < 2; ++mp)
#pragma unroll
                for (int bj = 0; bj < 2; ++bj) { v2u wv[2];
#pragma unroll
                    for (int mm = 0; mm < 2; ++mm) { const int m = 2 * mp + mm; const f32x4 v0 = acc[ai][bj][m][0] + bv[bj][0], v1 = acc[ai][bj][m][1] + bv[bj][1];
                        wv[mm].x = cvt4_fp8(v0[0], v0[1], v0[2], v0[3]); wv[mm].y = cvt4_fp8(v1[0], v1[1], v1[2], v1[3]); }
                    const v4u w16 = pair16(wv[0], wv[1]);
                    const unsigned off = (unsigned)(row0 + ai * 128 + (2 * mp + (fq & 1)) * 16) * (unsigned)DM + (unsigned)(col0 + bj * 128 - 8 * (fq & 1));
                    *(v4u*)(O + off) = w16; }
    }
};

constexpr int CV_SMALL = 1536, CV_MOE_L = 24576;
struct CvItem { const float* W; bf16* WT; int N, row0, k0, n0, f8; };
__device__ __forceinline__ CvItem cv_decode(const Args& A, int it) {
    CvItem c; int r = it;
    if (r < 1024) { const int l = r >> 9, q = r & 511, kb = q >> 5, nb = q & 31; c.f8 = 0; c.W = INP(I_WIN) + (size_t)l * 1024 * 2048; c.WT = WSP(bf16, WS_WINT) + (size_t)l * 2048 * 1024; c.N = 2048; c.row0 = 64 * nb; c.k0 = 64 * kb; c.n0 = 64 * nb; return c; }
    r -= 1024;
    if (r < 512) { const int l = r >> 8, q = r & 255, kb = q >> 4, nb = q & 15; c.f8 = 0; c.W = INP(I_WOUT) + (size_t)l * 1024 * 1024; c.WT = WSP(bf16, WS_WOUTT) + (size_t)l * 1024 * 1024; c.N = 1024; c.row0 = 64 * nb; c.k0 = 64 * kb; c.n0 = 64 * nb; return c; }
    r -= 512;
    const int l = r / CV_MOE_L; r -= l * CV_MOE_L;
    if (r < 16384) { const int le = l * 32 + (r >> 9), q = r & 511, kb = q >> 5, nb = q & 31, n0 = 64 * nb;
        c.f8 = 1; c.W = INP(I_W1) + (size_t)le * 1024 * 2048; c.WT = (bf16*)(WSP(unsigned char, WS_W1T) + (size_t)le * 2048 * 1024); c.N = 2048; c.k0 = 64 * kb; c.n0 = n0;
        c.row0 = (n0 < 1024) ? ((n0 >> 7) * 256 + (n0 & 127)) : ((((n0 - 1024) >> 7) * 256) + 128 + ((n0 - 1024) & 127)); return c; }
    r -= 16384;
    { const int le = l * 32 + (r >> 8), q = r & 255, kb = q >> 4, nb = q & 15; c.f8 = 1; c.W = INP(I_W2) + (size_t)le * 1024 * 1024; c.WT = (bf16*)(WSP(unsigned char, WS_W2T) + (size_t)le * 1024 * 1024); c.N = 1024; c.row0 = 64 * nb; c.k0 = 64 * kb; c.n0 = 64 * nb; return c; }
}
__device__ __forceinline__ void cv_load(const CvItem& c, float (&tv)[64], int lane) {
#pragma unroll
    for (int i = 0; i < 64; ++i) tv[i] = __builtin_nontemporal_load(c.W + (size_t)(c.k0 + i) * c.N + c.n0 + lane);
}
__device__ __forceinline__ void cv_store(const CvItem& c, const float (&tv)[64], LAS float*, int lane) {
    if (c.f8) { unsigned char* dst = (unsigned char*)c.WT + (size_t)(c.row0 + lane) * 1024 + c.k0;
#pragma unroll
        for (int j = 0; j < 4; ++j) { v4u o;
            o.x = cvt4_fp8(64.f * tv[16 * j + 0], 64.f * tv[16 * j + 1], 64.f * tv[16 * j + 2], 64.f * tv[16 * j + 3]);
            o.y = cvt4_fp8(64.f * tv[16 * j + 4], 64.f * tv[16 * j + 5], 64.f * tv[16 * j + 6], 64.f * tv[16 * j + 7]);
            o.z = cvt4_fp8(64.f * tv[16 * j + 8], 64.f * tv[16 * j + 9], 64.f * tv[16 * j + 10], 64.f * tv[16 * j + 11]);
            o.w = cvt4_fp8(64.f * tv[16 * j + 12], 64.f * tv[16 * j + 13], 64.f * tv[16 * j + 14], 64.f * tv[16 * j + 15]);
            *(v4u*)(dst + 16 * j) = o; }
    } else { bf16* dst = c.WT + (size_t)(c.row0 + lane) * 1024 + c.k0;
#pragma unroll
        for (int j = 0; j < 8; ++j) { v4u o; o.x = pk2(tv[8 * j + 0], tv[8 * j + 1]); o.y = pk2(tv[8 * j + 2], tv[8 * j + 3]); o.z = pk2(tv[8 * j + 4], tv[8 * j + 5]); o.w = pk2(tv[8 * j + 6], tv[8 * j + 7]);
            *(v4u*)(dst + 8 * j) = o; }
    }
}
__device__ __forceinline__ void cv_range(const Args& A, LAS unsigned char* lds, int lo, int hi, int wl, int nw) {
    const int tid = otid(), lane = tid & 63, wave = tid >> 6;
    LAS float* scr = (LAS float*)(lds + wave * 17408);
    int it = lo + wl;
    if (it >= hi) return;
    CvItem c0 = cv_decode(A, it), c1 = c0; float t0[64], t1[64];
    cv_load(c0, t0, lane);
    for (;;) {
        const int it1 = it + nw; const bool has1 = it1 < hi;
        if (has1) { c1 = cv_decode(A, it1); cv_load(c1, t1, lane); }
        cv_store(c0, t0, scr, lane);
        if (!has1) break;
        const int it2 = it1 + nw; const bool has2 = it2 < hi;
        if (has2) { c0 = cv_decode(A, it2); cv_load(c0, t0, lane); }
        cv_store(c1, t1, scr, lane);
        if (!has2) break;
        it = it2;
    }
}
constexpr int CVB_L = 3072;
struct CvBlk { const float* W; unsigned char* WT; int N, k0, n0, w1; };
__device__ __forceinline__ CvBlk cvb_decode(const Args& A, int b) {
    CvBlk c; const int l = b / CVB_L; int r = b - l * CVB_L;
    if (r < 2048) { const int le = l * 32 + (r >> 6), q = r & 63; c.w1 = 1; c.N = 2048; c.k0 = 128 * (q >> 3); c.n0 = 256 * (q & 7); c.W = INP(I_W1) + (size_t)le * 1024 * 2048; c.WT = WSP(unsigned char, WS_W1T) + (size_t)le * 2048 * 1024; }
    else { r -= 2048; const int le = l * 32 + (r >> 5), q = r & 31; c.w1 = 0; c.N = 1024; c.k0 = 128 * (q >> 2); c.n0 = 256 * (q & 3); c.W = INP(I_W2) + (size_t)le * 1024 * 1024; c.WT = WSP(unsigned char, WS_W2T) + (size_t)le * 1024 * 1024; }
    return c;
}
__device__ __forceinline__ void cvb_load(const CvBlk& c, f32x4 (&v)[16], int wave, int lane) {
    const float* p = c.W + (size_t)(c.k0 + 16 * wave) * c.N + c.n0 + 4 * lane;
#pragma unroll
    for (int i = 0; i < 16; ++i) v[i] = __builtin_nontemporal_load((const f32x4*)(p + (size_t)i * c.N));
}
__device__ __forceinline__ void cvb_stage(const f32x4 (&v)[16], LAS unsigned char* buf, int wave, int lane) {
#pragma unroll
    for (int j = 0; j < 4; ++j) { v4u o;
        o.x = cvt4_fp8(64.f * v[0][j], 64.f * v[1][j], 64.f * v[2][j], 64.f * v[3][j]); o.y = cvt4_fp8(64.f * v[4][j], 64.f * v[5][j], 64.f * v[6][j], 64.f * v[7][j]);
        o.z = cvt4_fp8(64.f * v[8][j], 64.f * v[9][j], 64.f * v[10][j], 64.f * v[11][j]); o.w = cvt4_fp8(64.f * v[12][j], 64.f * v[13][j], 64.f * v[14][j], 64.f * v[15][j]);
        *(LAS v4u*)(buf + (4 * lane + j) * 128 + ((wave ^ (lane & 7)) << 4)) = o; }
}
__device__ __forceinline__ void cvb_store(const CvBlk& c, const LAS unsigned char* buf, int tid) {
#pragma unroll
    for (int q = 0; q < 4; ++q) { const int p = tid + 512 * q, row = p >> 3, pc = p & 7; const v4u o = *(const LAS v4u*)(buf + row * 128 + ((pc ^ ((row >> 2) & 7)) << 4));
        const int n = c.n0 + row; const int orow = c.w1 ? ((n < 1024) ? ((n >> 7) * 256 + (n & 127)) : (((n - 1024) >> 7) * 256 + 128 + ((n - 1024) & 127))) : n;
        *(v4u*)(c.WT + (size_t)orow * 1024 + c.k0 + 16 * pc) = o; }
}
__device__ __forceinline__ void cv_blocks(const Args& A, LAS unsigned char* lds, int lo, int hi, int wgi, int nwg) {
    const int tid = otid(), lane = tid & 63, wave = tid >> 6;
    int b = lo + wgi;
    if (b >= hi) return;
    CvBlk c0 = cvb_decode(A, b), c1 = c0; f32x4 va[16], vb[16]; int par = 0;
    cvb_load(c0, va, wave, lane);
    for (;;) {
        const int b1 = b + nwg; const bool has1 = b1 < hi;
        if (has1) { c1 = cvb_decode(A, b1); cvb_load(c1, vb, wave, lane); }
        cvb_stage(va, lds + par * 32768, wave, lane); __syncthreads(); cvb_store(c0, lds + par * 32768, tid); par ^= 1;
        if (!has1) break;
        const int b2 = b1 + nwg; const bool has2 = b2 < hi;
        if (has2) { c0 = cvb_decode(A, b2); cvb_load(c0, va, wave, lane); }
        cvb_stage(vb, lds + par * 32768, wave, lane); __syncthreads(); cvb_store(c1, lds + par * 32768, tid); par ^= 1;
        if (!has2) break;
        b = b2;
    }
    __syncthreads();
}
__device__ __forceinline__ void ph_prologue(const Args& A, LAS unsigned char* lds, int G, int n_blocks) {
    const int tid = otid(), lane = tid & 63, wave = __builtin_amdgcn_readfirstlane(tid >> 6);
    for (int item = blockIdx.x; item < 192; item += G) {
        const int l = item / 96, jc = item % 96;
        LAS float* S = (LAS float*)lds;
        LAS float* R = S + 9 * 1024;
        for (int idx = tid; idx < 9 * 1024; idx += 512) { const int i = idx >> 10, k = idx & 1023; const float v = (i < 8) ? INP(I_C)[i * 1024 + k] : INP(I_CCTX)[k]; S[idx] = v / (1.0f + __expf(-v)); }
        __syncthreads();
        const int c4 = tid & 15, kg = tid >> 4;
        float acc[9][4];
#pragma unroll
        for (int i = 0; i < 9; ++i) { acc[i][0] = 0.f; acc[i][1] = 0.f; acc[i][2] = 0.f; acc[i][3] = 0.f; }
        const float* w = INP(I_WADA) + (size_t)l * 1024 * 6144 + jc * 64 + 4 * c4;
#pragma unroll 16
        for (int kk = 0; kk < 32; ++kk) { const int k = kg + 32 * kk; const f32x4 wv = *(const f32x4*)(w + (size_t)k * 6144);
#pragma unroll
            for (int i = 0; i < 9; ++i) { const float sv = S[i * 1024 + k]; acc[i][0] += sv * wv.x; acc[i][1] += sv * wv.y; acc[i][2] += sv * wv.z; acc[i][3] += sv * wv.w; } }
#pragma unroll
        for (int i = 0; i < 9; ++i) *(LAS f32x4*)(R + (kg * 9 + i) * 64 + 4 * c4) = (f32x4){acc[i][0], acc[i][1], acc[i][2], acc[i][3]};
        __syncthreads();
        for (int idx = tid; idx < 9 * 64; idx += 512) { const int i = idx >> 6, cc = idx & 63; float s = INP(I_BADA)[l * 6144 + jc * 64 + cc];
#pragma unroll
            for (int q = 0; q < 32; ++q) s += R[(q * 9 + i) * 64 + cc];
            WSP(float, WS_MOD)[(l * 9 + i) * 6144 + jc * 64 + cc] = s; }
        __syncthreads();
    }
    for (int gi = (int)blockIdx.x * 512 + tid; gi < 2 * 32768; gi += G * 512) { const int l = gi >> 15, r = gi & 32767, k = r >> 5, e = r & 31;
        WSP(float, WS_WRT)[l * 32768 + e * 1024 + k] = INP(I_WR)[(size_t)l * 32768 + r]; }
    if (blockIdx.x == G - 1) {
        for (int idx = tid; idx < 1024; idx += 512) { const int pos = idx >> 4, f = idx & 15; const float inv = powf(10000.0f, -(float)f / 16.0f); const float ang = (float)pos * inv;
            WSP(float, WS_ROPE)[idx * 2] = cosf(ang); WSP(float, WS_ROPE)[idx * 2 + 1] = sinf(ang); }
    }
    for (int item = G - 1 - (int)blockIdx.x; item < 264; item += G) {
        int l, n, chunk;
        if (item < 128) { l = 0; n = 4096; chunk = item; } else if (item < 256) { l = 1; n = 4096; chunk = item - 128; } else { l = 0; n = 256; chunk = item - 256; }
        const int i0 = chunk * 32;
        const float* w1 = INP(I_FW1) + l * 33 * 64; const float* b1 = INP(I_FB1) + l * 64; const float* w2 = INP(I_FW2) + l * 4096; const float* b2 = INP(I_FB2) + l * 64;
        const float* w3 = INP(I_FW3) + l * 4096; const float* b3 = INP(I_FB3) + l * 64; const float* fr = INP(I_FFREQ) + l * 64; const float* wo = INP(I_FOUT) + l * 64 * 512;
        LAS float* zf = (LAS float*)lds; LAS float* ha = zf + 1056; LAS float* hb = ha + 2048; LAS float* outs = hb + 2048;
        LAS float* w1s = outs + 32 * 512; LAS float* w2s = w1s + 33 * 64; LAS float* w3s = w2s + 4096; LAS float* bfs = w3s + 4096;
        { float a_[5], b_[8], c_[8];
#pragma unroll
          for (int q = 0; q < 5; ++q) a_[q] = (tid + 512 * q < 33 * 64) ? w1[tid + 512 * q] : 0.f;
#pragma unroll
          for (int q = 0; q < 8; ++q) { b_[q] = w2[tid + 512 * q]; c_[q] = w3[tid + 512 * q]; }
#pragma unroll
          for (int q = 0; q < 5; ++q) if (tid + 512 * q < 33 * 64) w1s[tid + 512 * q] = a_[q];
#pragma unroll
          for (int q = 0; q < 8; ++q) { w2s[tid + 512 * q] = b_[q]; w3s[tid + 512 * q] = c_[q]; } }
        if (tid < 64) { bfs[tid] = b1[tid]; bfs[64 + tid] = b2[tid]; bfs[128 + tid] = b3[tid]; bfs[192 + tid] = fr[tid]; }
        for (int idx = tid; idx < 32 * 33; idx += 512) { const int p = idx / 33, f = idx - 33 * p, i = i0 + p;
            const float tt = (float)i / (float)(n - 1), wpos = (6.283185307179586f / (float)n) * (float)i;
            float v;
            if (f == 0) v = tt; else { const int jb = (f - 1) & 15; const float band = 1e-4f + (float)jb * ((15.0f - 1e-4f) / 15.0f); const float a = wpos * band; v = (f <= 16) ? cosf(a) : -sinf(a); }
            zf[idx] = v; }
        __syncthreads();
        { const int j = tid & 63, pq = tid >> 6;
          { float wc[33];
#pragma unroll
            for (int f = 0; f < 33; ++f) wc[f] = w1s[f * 64 + j];
#pragma unroll
            for (int q = 0; q < 4; ++q) { const int p = pq + 8 * q; float s = bfs[j];
#pragma unroll
                for (int f = 0; f < 33; ++f) s += zf[p * 33 + f] * wc[f];
                ha[p * 64 + j] = sinf(bfs[192 + j] * s); } }
          __syncthreads();
#pragma unroll 1
          for (int ly = 0; ly < 2; ++ly) { const LAS float* ws_ = ly ? w3s : w2s; const LAS float* hi_ = ly ? hb : ha; LAS float* ho_ = ly ? ha : hb;
            float wc[64];
#pragma unroll
            for (int f = 0; f < 64; ++f) wc[f] = ws_[f * 64 + j];
#pragma unroll
            for (int q = 0; q < 4; ++q) { const int p = pq + 8 * q; float s0 = bfs[64 + 64 * ly + j], s1 = 0.f;
#pragma unroll
                for (int f = 0; f < 64; f += 4) { const f32x4 h4 = *(const LAS f32x4*)(hi_ + p * 64 + f); s0 += h4.x * wc[f]; s1 += h4.y * wc[f + 1]; s0 += h4.z * wc[f + 2]; s1 += h4.w * wc[f + 3]; }
                ho_[p * 64 + j] = sinf(bfs[192 + j] * (s0 + s1)); }
            __syncthreads(); }
        }
        {   const int o = tid, c = o & 255, kind = o >> 8;
            const float delta = 3.0701134573253945f + (float)c * ((15.350567286626973f - 3.0701134573253945f) / 255.0f);
            float wv[64];
#pragma unroll
            for (int j = 0; j < 64; ++j) wv[j] = wo[j * 512 + o];
            bf16* gb = WSP(bf16, WS_GB) + (size_t)(l * 256 + c) * 8192;
            float* gc = WSP(float, WS_GC) + c * 512;
#pragma unroll 1
            for (int k = 0; k < 4; ++k) {
                float ov[8];
#pragma unroll
                for (int m = 0; m < 8; ++m) { const int p = kind == 0 ? 8 * k + m : 31 - 8 * k - m; float a0 = 0.f, a1 = 0.f;
#pragma unroll
                    for (int j = 0; j < 64; j += 4) { const f32x4 h4 = *(const LAS f32x4*)(ha + p * 64 + j); a0 += h4.x * wv[j]; a1 += h4.y * wv[j + 1]; a0 += h4.z * wv[j + 2]; a1 += h4.w * wv[j + 3]; }
                    const float tt = (float)(i0 + p) / (float)(n - 1); ov[m] = (a0 + a1) * __expf(-tt * delta);
                    if (n != 4096) { const int i = i0 + p; gc[kind == 0 ? 256 + i : 255 - i] = ov[m]; }
                    __builtin_amdgcn_sched_barrier(0); }
                if (n == 4096) ((v4u*)(gb + (kind == 0 ? 4096 + i0 : 4064 - i0)))[k] = (v4u){pk2(ov[0], ov[1]), pk2(ov[2], ov[3]), pk2(ov[4], ov[5]), pk2(ov[6], ov[7])};
            }
            if (n == 4096) { if (chunk == 127 && kind == 1) gb[0] = 0; }
            else if (chunk == 7 && kind == 1) gc[0] = 0.f;
        }
        __syncthreads();
    }
    __syncthreads();
    cv_range(A, lds, 0, CV_SMALL, (int)blockIdx.x * 8 + wave, G * 8);
    __syncthreads();
    cv_blocks(A, lds, 0, n_blocks, (int)blockIdx.x, G);
}

struct RowV { f32x4 v[4]; };
__device__ __forceinline__ float row_ssq(const RowV& r) { float s = 0.f;
#pragma unroll
    for (int j = 0; j < 4; ++j) s += (r.v[j].x * r.v[j].x + r.v[j].y * r.v[j].y) + (r.v[j].z * r.v[j].z + r.v[j].w * r.v[j].w);
    return wave_sum(s); }
__device__ __forceinline__ void row_modulate(const RowV& x, float rs, const float* nw, const float* sh, const float* sc, int lane, RowV& h) {
#pragma unroll
    for (int j = 0; j < 4; ++j) { const f32x4 w = ((const f32x4*)nw)[lane + 64 * j], s = ((const f32x4*)sc)[lane + 64 * j], t = ((const f32x4*)sh)[lane + 64 * j];
        h.v[j] = (x.v[j] * rs * w) * (s + 1.0f) + t; }
}
__device__ __forceinline__ void row_load_bf16(RowV& x, const bf16* src, int lane) {
#pragma unroll
    for (int j = 0; j < 4; ++j) { const v2u w = ((const v2u*)src)[lane + 64 * j]; x.v[j] = (f32x4){bflo(w.x), bfhi(w.x), bflo(w.y), bfhi(w.y)}; }
}
__device__ __forceinline__ void row_store_bf16(const RowV& h, bf16* dst, int lane) {
#pragma unroll
    for (int j = 0; j < 4; ++j) { v2u o; o.x = pk2(h.v[j].x, h.v[j].y); o.y = pk2(h.v[j].z, h.v[j].w); ((v2u*)dst)[lane + 64 * j] = o; }
}
template <int NR>
__device__ __forceinline__ void row_combine(RowV (&x)[NR], const Args& A, int l, const int (&r)[NR], const int (&mi)[NR], int lane) {
    int slot[NR][4]; float g[NR][4];
#pragma unroll
    for (int q = 0; q < NR; ++q) { const int* ts = WSP(int, WS_TOKSLOT) + r[q] * 4; const float* tg = WSP(float, WS_TOPG) + r[q] * 4;
#pragma unroll
        for (int k = 0; k < 4; ++k) { slot[q][k] = ts[k]; g[q][k] = tg[k]; } }
    int w[NR][4][4];
#pragma unroll
    for (int q = 0; q < NR; ++q)
#pragma unroll
        for (int k = 0; k < 4; ++k) { const int* src = (const int*)(WSP(unsigned char, WS_OUTS) + (size_t)slot[q][k] * DM);
#pragma unroll
            for (int j = 0; j < 4; ++j) w[q][k][j] = src[lane + 64 * j]; }
#pragma unroll
    for (int q = 0; q < NR; ++q) { const float* g2 = WSP(float, WS_MOD) + (l * 9 + mi[q]) * 6144 + 5120;
#pragma unroll
        for (int j = 0; j < 4; ++j) { f32x4 y = (f32x4){0.f, 0.f, 0.f, 0.f};
#pragma unroll
            for (int k = 0; k < 4; ++k) { const int ww = w[q][k][j]; const float gg = g[q][k];
                y.x += gg * __builtin_amdgcn_cvt_f32_fp8(ww, 0); y.y += gg * __builtin_amdgcn_cvt_f32_fp8(ww, 1); y.z += gg * __builtin_amdgcn_cvt_f32_fp8(ww, 2); y.w += gg * __builtin_amdgcn_cvt_f32_fp8(ww, 3); }
            x[q].v[j] = x[q].v[j] + ((const f32x4*)g2)[lane + 64 * j] * y; } }
}
__device__ __forceinline__ void ph_rowpass_a(const Args& A, int l, int G) {
    const int tid = otid(), lane = tid & 63, wave = tid >> 6, gw = blockIdx.x * 8 + wave, NGW = G * 8;
    for (int i = blockIdx.x * 512 + tid; i < NSLOT_MAX; i += G * 512) WSP(int, WS_SLOTTOK)[i] = MROWS;
    if (blockIdx.x == 0) { for (int i = tid; i < 512; i += 512) ((unsigned*)(WSP(bf16, WS_H) + (size_t)MROWS * DM))[i] = 0u; }
    bf16* X = WSP(bf16, WS_X); bf16* H = WSP(bf16, WS_H);
    constexpr int NR = 2;
    for (int r0 = gw * NR; r0 < MROWS; r0 += NGW * NR) {
        int r[NR], mi[NR]; RowV x[NR];
#pragma unroll
        for (int q = 0; q < NR; ++q) { r[q] = r0 + q; const int b = r[q] / TPB, t = r[q] - b * TPB; mi[q] = (t < SEQ) ? b : 8;
            if (l == 0) { const float* src = (t < SEQ) ? INP(I_X) + ((size_t)b * SEQ + t) * DM : INP(I_CTX) + ((size_t)b * CTXL + (t - SEQ)) * DM;
#pragma unroll
                for (int j = 0; j < 4; ++j) x[q].v[j] = ((const f32x4*)src)[lane + 64 * j];
            } else row_load_bf16(x[q], X + (size_t)r[q] * DM, lane); }
        if (l != 0) { row_combine<NR>(x, A, 0, r, mi, lane);
#pragma unroll
            for (int q = 0; q < NR; ++q) row_store_bf16(x[q], X + (size_t)r[q] * DM, lane); }
#pragma unroll
        for (int q = 0; q < NR; ++q) {
            const float rs = rsqrtf(row_ssq(x[q]) * (1.0f / DM) + EPSN);
            const float* mod = WSP(float, WS_MOD) + (l * 9 + mi[q]) * 6144;
            RowV h; row_modulate(x[q], rs, INP(I_NMIX) + l * DM, mod, mod + 1024, lane, h);
            row_store_bf16(h, H + (size_t)r[q] * DM, lane); }
    }
}
__device__ __forceinline__ void ph_final(const Args& A, int G) {
    const int tid = otid(), lane = tid & 63, wave = tid >> 6, gw = blockIdx.x * 8 + wave, NGW = G * 8;
    const bf16* X = WSP(bf16, WS_X);
    constexpr int NR = 2;
    f32x4 nf[4];
#pragma unroll
    for (int j = 0; j < 4; ++j) nf[j] = ((const f32x4*)INP(I_NFINAL))[lane + 64 * j];
    for (int i0 = gw * NR; i0 < NB * SEQ; i0 += NGW * NR) {
        int r[NR], mi[NR]; RowV x[NR];
#pragma unroll
        for (int q = 0; q < NR; ++q) { r[q] = lat_row(i0 + q); mi[q] = (i0 + q) >> 12; row_load_bf16(x[q], X + (size_t)r[q] * DM, lane); }
        row_combine<NR>(x, A, 1, r, mi, lane);
#pragma unroll
        for (int q = 0; q < NR; ++q) {
            const float rs = rsqrtf(row_ssq(x[q]) * (1.0f / DM) + EPSN);
            float* dst = (float*)inp_ptr(A, 34) + (size_t)(i0 + q) * DM;
#pragma unroll
            for (int j = 0; j < 4; ++j) ((f32x4*)dst)[lane + 64 * j] = x[q].v[j] * rs * nf[j]; }
    }
}
__device__ __forceinline__ float swap32_sum(float a, float b) { asm volatile("s_nop 1\n\tv_permlane32_swap_b32 %0, %1" : "+v"(a), "+v"(b)); return a + b; }
__device__ __forceinline__ float swap32_max(float a, float b) { asm volatile("s_nop 1\n\tv_permlane32_swap_b32 %0, %1" : "+v"(a), "+v"(b)); return fmaxf(a, b); }
__device__ __forceinline__ float wave_max_all(float x) {
    x = fmaxf(x, DPPF(x, 0xB1)); x = fmaxf(x, DPPF(x, 0x4E)); x = fmaxf(x, DPPF(x, 0x141)); x = fmaxf(x, DPPF(x, 0x140));
    x = fmaxf(x, shflx(x, 16));
    return swap32_max(x, x);
}
__device__ __forceinline__ float wave_sum_all(float x) {
    x += DPPF(x, 0xB1); x += DPPF(x, 0x4E); x += DPPF(x, 0x141); x += DPPF(x, 0x140);
    x += shflx(x, 16);
    return swap32_sum(x, x);
}
constexpr int RG = 2, RGS = 1;
__device__ __forceinline__ void ph_rowpass_g(const Args& A, LAS unsigned char* lds, int l, int G) {
    const int tid = otid(), lane = tid & 63, wave = tid >> 6, gw = blockIdx.x * 8 + wave, NGW = G * 8;
    LAS float* WrT = (LAS float*)lds;
    LAS int* hist = (LAS int*)(lds + LDSX_OFF);
    const f32x4* wt = (const f32x4*)(WSP(float, WS_WRT) + l * 32768);
    __syncthreads();
    { f32x4 t_[16];
#pragma unroll
      for (int q = 0; q < 16; ++q) t_[q] = wt[tid + 512 * q];
#pragma unroll
      for (int q = 0; q < 16; ++q) ((LAS f32x4*)WrT)[tid + 512 * q] = t_[q]; }
    if (tid < 32) hist[tid] = 0;
    __syncthreads();
    const bf16* X = WSP(bf16, WS_X); unsigned char* H8 = WSP(unsigned char, WS_H8);
    if (blockIdx.x == 0 && tid < 256) ((unsigned*)(H8 + (size_t)MROWS * DM))[tid] = 0u;
    const float brl = INP(I_BR)[l * 32 + (lane >> 1)];
    const float* nffn = INP(I_NFFN) + l * DM;
    const int nrows = (l == 0) ? MROWS : NB * SEQ, ngroups = nrows >> RGS;
    for (int gi = gw; gi < ngroups; gi += NGW) {
        const int i0 = gi * RG;
        const int r0 = (l == 0) ? i0 : lat_row(i0);
        const int b = r0 / TPB, t = r0 - b * TPB, mi = (t < SEQ) ? b : 8;
        const float* mod = WSP(float, WS_MOD) + (l * 9 + mi) * 6144;
        RowV h[RG];
        { const v2u* xp = (const v2u*)(X + (size_t)r0 * DM) + lane; v2u w_[RG][4];
#pragma unroll
          for (int q = 0; q < RG; ++q)
#pragma unroll
              for (int j = 0; j < 4; ++j) w_[q][j] = xp[256 * q + 64 * j];
#pragma unroll
          for (int q = 0; q < RG; ++q)
#pragma unroll
              for (int j = 0; j < 4; ++j) h[q].v[j] = (f32x4){bflo(w_[q][j].x), bfhi(w_[q][j].x), bflo(w_[q][j].y), bfhi(w_[q][j].y)}; }
        float rs[RG];
#pragma unroll
        for (int q = 0; q < RG; ++q) { float s = 0.f;
#pragma unroll
            for (int j = 0; j < 4; ++j) s += (h[q].v[j].x * h[q].v[j].x + h[q].v[j].y * h[q].v[j].y) + (h[q].v[j].z * h[q].v[j].z + h[q].v[j].w * h[q].v[j].w);
            rs[q] = rsqrtf(wave_sum_all(s) * (1.0f / DM) + EPSN); }
#pragma unroll
        for (int j = 0; j < 4; ++j) { const f32x4 wv = ((const f32x4*)nffn)[lane + 64 * j], sc = ((const f32x4*)(mod + 4096))[lane + 64 * j], sh = ((const f32x4*)(mod + 3072))[lane + 64 * j];
#pragma unroll
            for (int q = 0; q < RG; ++q) h[q].v[j] = (h[q].v[j] * rs[q] * wv) * (sc + 1.0f) + sh; }
#pragma unroll
        for (int q = 0; q < RG; ++q) { unsigned* hp = (unsigned*)(H8 + (size_t)(r0 + q) * DM);
#pragma unroll
            for (int j = 0; j < 4; ++j) hp[lane + 64 * j] = cvt4_fp8(h[q].v[j].x, h[q].v[j].y, h[q].v[j].z, h[q].v[j].w); }
        const bool b4 = (lane & 16) != 0, b3 = (lane & 8) != 0, b2 = (lane & 4) != 0, b1 = (lane & 2) != 0;
        float lgq[RG];
        {
            float W2v[RG][2], W4v[RG][2], W8v[RG][2], W16v[RG][2], Vv[RG][2];
#pragma unroll
            for (int a = 0; a < 2; ++a) {
#pragma unroll
                for (int bb = 0; bb < 2; ++bb) {
#pragma unroll
                    for (int cc = 0; cc < 2; ++cc) {
#pragma unroll
                        for (int dd = 0; dd < 2; ++dd) {
#pragma unroll
                            for (int ff = 0; ff < 2; ++ff) { const int e = a + 2 * bb + 4 * cc + 8 * dd + 16 * ff;
                                f32x4 wv[4];
#pragma unroll
                                for (int j = 0; j < 4; ++j) wv[j] = ((const LAS f32x4*)(WrT + e * 1024))[lane + 64 * j];
#pragma unroll
                                for (int q = 0; q < RG; ++q) { f32x2 p2 = (f32x2){0.f, 0.f};
#pragma unroll
                                    for (int j = 0; j < 4; ++j) { p2 = __builtin_elementwise_fma((f32x2){h[q].v[j].x, h[q].v[j].y}, (f32x2){wv[j].x, wv[j].y}, p2); p2 = __builtin_elementwise_fma((f32x2){h[q].v[j].z, h[q].v[j].w}, (f32x2){wv[j].z, wv[j].w}, p2); }
                                    Vv[q][ff] = p2.x + p2.y; }
                            }
#pragma unroll
                            for (int q = 0; q < RG; ++q) W16v[q][dd] = swap32_sum(Vv[q][0], Vv[q][1]);
                            __builtin_amdgcn_sched_barrier(0);
                        }
#pragma unroll
                        for (int q = 0; q < RG; ++q) { const float mine = b4 ? W16v[q][1] : W16v[q][0], send = b4 ? W16v[q][0] : W16v[q][1]; W8v[q][cc] = mine + shflx(send, 16); }
                    }
#pragma unroll
                    for (int q = 0; q < RG; ++q) { const float mine = b3 ? W8v[q][1] : W8v[q][0], send = b3 ? W8v[q][0] : W8v[q][1]; W4v[q][bb] = mine + DPPF(send, 0x128); }
                }
#pragma unroll
                for (int q = 0; q < RG; ++q) { const float mine = b2 ? W4v[q][1] : W4v[q][0], send = b2 ? W4v[q][0] : W4v[q][1]; W2v[q][a] = mine + shflx(send, 4); }
            }
#pragma unroll
            for (int q = 0; q < RG; ++q) { const float mine = b1 ? W2v[q][1] : W2v[q][0], send = b1 ? W2v[q][0] : W2v[q][1]; float r = mine + DPPF(send, 0x4E); r += DPPF(r, 0xB1); lgq[q] = r + brl; }
        }
#pragma unroll
        for (int q = 0; q < RG; ++q) {
            float lg = lgq[q];
            int bi[4]; float bv[4];
#ifdef DBG_OLD_TOPK
            float la[32];
#pragma unroll
            for (int e = 0; e < 32; ++e) la[e] = __builtin_bit_cast(float, __builtin_amdgcn_ds_bpermute((2 * e) << 2, __builtin_bit_cast(int, lg)));
#pragma unroll
            for (int k = 0; k < 4; ++k) { float best = -INFINITY; int be = 0;
#pragma unroll
                for (int e = 0; e < 32; ++e) { if (la[e] > best) { best = la[e]; be = e; } }
#pragma unroll
                for (int e = 0; e < 32; ++e) la[e] = (e == be) ? -INFINITY : la[e];
                bi[k] = be; bv[k] = best; }
#else
#pragma unroll
            for (int k = 0; k < 4; ++k) { const float m = wave_max_all(lg); const unsigned long long bal = __ballot(lg == m); const int fl = (int)__builtin_ctzll(bal);
                bi[k] = fl >> 1; bv[k] = m; if ((lane >> 1) == (fl >> 1)) lg = -INFINITY; }
#endif
            const float e1 = __expf(bv[1] - bv[0]), e2 = __expf(bv[2] - bv[0]), e3 = __expf(bv[3] - bv[0]); const float inv = 1.0f / (1.0f + e1 + e2 + e3);
            if (lane == 0) { const int r = r0 + q;
                int* ti = WSP(int, WS_TOPI) + r * 4; float* tg = WSP(float, WS_TOPG) + r * 4;
                ti[0] = bi[0]; ti[1] = bi[1]; ti[2] = bi[2]; ti[3] = bi[3]; tg[0] = inv; tg[1] = e1 * inv; tg[2] = e2 * inv; tg[3] = e3 * inv;
#pragma unroll
                for (int k = 0; k < 4; ++k) atomicAdd((int*)&hist[bi[k]], 1); }
        }
    }
    __syncthreads();
    if (tid < 32) WSP(int, WS_HIST)[(l * 256 + blockIdx.x) * 32 + tid] = hist[tid];
    __syncthreads();
}
__device__ __forceinline__ void ph_route(const Args& A, LAS unsigned char* lds, int l, int G) {
    const int tid = otid(), lane = tid & 63, wave = tid >> 6, gw = blockIdx.x * 8 + wave, NGW = G * 8;
    LAS int* tot = (LAS int*)(lds + LDSX_OFF); LAS int* off = tot + 32; LAS int* pst = off + 32; LAS int* cur = pst + 40;
    {
        LAS int* hb = (LAS int*)lds; const int* hs = WSP(int, WS_HIST) + l * 256 * 32;
        __syncthreads();
        { int t_[16];
#pragma unroll
          for (int q = 0; q < 16; ++q) t_[q] = (tid + 512 * q < G * 32) ? hs[tid + 512 * q] : 0;
#pragma unroll
          for (int q = 0; q < 16; ++q) if (tid + 512 * q < G * 32) hb[tid + 512 * q] = t_[q]; }
        __syncthreads();
        if (tid < 32) { int s = 0, my = 0;
            for (int w = 0; w < G; ++w) { if (w == (int)blockIdx.x) my = s; s += hb[w * 32 + tid]; }
            tot[tid] = s; off[tid] = my; cur[tid] = 0; }
    }
    __syncthreads();
    if (tid == 0) { int p = 0; for (int e = 0; e < 32; ++e) { pst[e] = p; p += ((tot[e] + 255) >> 8) << 8; } pst[32] = p; }
    __syncthreads();
    if (blockIdx.x == 0 && tid < 34) WSP(int, WS_EXPST)[l * 64 + tid] = (tid < 33) ? pst[tid] : (pst[32] >> 8);
    const int nrows = (l == 0) ? MROWS : NB * SEQ, ngroups = nrows >> RGS;
    for (int g0 = gw; g0 < ngroups; g0 += 8 * NGW) {
        const int gi = g0 + (lane >> 3) * NGW;
        if (gi < ngroups) { const int i0 = gi * RG; const int r0 = (l == 0) ? i0 : lat_row(i0);
            const int r = r0 + ((lane >> 2) & (RG - 1)), k = lane & 3; const int e = WSP(int, WS_TOPI)[r * 4 + k]; const int pos = atomicAdd((int*)&cur[e], 1); const int slot = pst[e] + off[e] + pos;
            WSP(int, WS_SLOTTOK)[slot] = r; WSP(int, WS_TOKSLOT)[r * 4 + k] = slot; }
    }
    __syncthreads();
}
__device__ __forceinline__ int moe_table(const Args& A, LAS unsigned char* lds, int l) {
    const int tid = otid(); LAS int* pst = (LAS int*)(lds + LDSX_OFF); LAS unsigned char* be = (LAS unsigned char*)(lds + LDSX_OFF + 1024);
    if (tid < 34) pst[tid] = WSP(int, WS_EXPST)[l * 64 + tid];
    __syncthreads();
    const int nblk = pst[33];
    for (int bk = tid; bk < nblk; bk += 512) { int e = 0; for (int q = 1; q < 32; ++q) e += (pst[q] <= bk * 256) ? 1 : 0; be[bk] = (unsigned char)e; }
    __syncthreads();
    return __builtin_amdgcn_readfirstlane(nblk);
}

__device__ __forceinline__ void ph_post(const Args& A, LAS unsigned char* lds, int l, int G) {
    const int tid = otid(), lane = tid & 63, wave = tid >> 6, gw = blockIdx.x * 8 + wave, NGW = G * 8;
    bf16* P = WSP(bf16, WS_P);
    {
        const int hd = lane >> 2, part = lane & 3;
        const int cb = (hd < 6) ? COL_GAQ + 64 * hd : (hd < 8) ? COL_GAK + 64 * (hd - 6) : (hd < 14) ? COL_WAQ + 64 * (hd - 8) : COL_WAK + 64 * (hd - 14);
        const bool isq = (hd < 6) || (hd >= 8 && hd < 14), donorm = hd < 8;
        const float* nw = (hd < 6) ? INP(I_QNORM) + l * 64 : INP(I_KNORM) + l * 64;
        float nwv[16];
#pragma unroll
        for (int k = 0; k < 4; ++k) { const f32x4 t4 = ((const f32x4*)(nw + 16 * part))[k]; nwv[4 * k] = t4.x; nwv[4 * k + 1] = t4.y; nwv[4 * k + 2] = t4.z; nwv[4 * k + 3] = t4.w; }
        const float* rope = WSP(float, WS_ROPE);
        constexpr int NR = 2;
        for (int r0 = gw * NR; r0 < MROWS; r0 += NGW * NR) {
            v4u w0[NR], w1[NR]; v2u vv[NR]; bf16* p[NR]; int bq[NR], tq[NR];
            const int vc = 4 * lane, vsel = vc >> 7, vkvh = (vc >> 6) & 1, vd = vc & 63;
#pragma unroll
            for (int q = 0; q < NR; ++q) { const int r = r0 + q; bq[q] = r / TPB; tq[q] = r - bq[q] * TPB; p[q] = P + (size_t)r * INW + cb + 16 * part;
                w0[q] = ((const v4u*)p[q])[0]; w1[q] = ((const v4u*)p[q])[1]; vv[q] = *(const v2u*)(P + (size_t)r * INW + (vsel ? COL_WAV : COL_GAV) + 64 * vkvh + vd); }
#pragma unroll
            for (int q = 0; q < NR; ++q) { const int b = bq[q], t = tq[q];
                float v[16];
                v[0] = bflo(w0[q].x); v[1] = bfhi(w0[q].x); v[2] = bflo(w0[q].y); v[3] = bfhi(w0[q].y); v[4] = bflo(w0[q].z); v[5] = bfhi(w0[q].z); v[6] = bflo(w0[q].w); v[7] = bfhi(w0[q].w);
                v[8] = bflo(w1[q].x); v[9] = bfhi(w1[q].x); v[10] = bflo(w1[q].y); v[11] = bfhi(w1[q].y); v[12] = bflo(w1[q].z); v[13] = bfhi(w1[q].z); v[14] = bflo(w1[q].w); v[15] = bfhi(w1[q].w);
                if (donorm) { float ss = 0.f;
#pragma unroll
                    for (int i = 0; i < 16; ++i) ss += v[i] * v[i];
                    ss += DPPF(ss, 0xB1); ss += DPPF(ss, 0x4E);
                    const float rs = rsqrtf(ss * (1.0f / 64.0f) + EPSN);
#pragma unroll
                    for (int i = 0; i < 16; ++i) v[i] = v[i] * rs * nwv[i]; }
                if (t < SEQ) {
                    const int pos = (part < 2) ? (t >> 6) : (t & 63); const f32x4* cs4 = (const f32x4*)(rope + pos * 32);
#pragma unroll
                    for (int k = 0; k < 8; ++k) { const f32x4 cs = cs4[k];
                        const float o0_ = DPPF(v[2 * k], 0xB1), o1_ = DPPF(v[2 * k + 1], 0xB1);
                        v[2 * k] = (part & 1) ? (v[2 * k] * cs.x + o0_ * cs.y) : (v[2 * k] * cs.x - o0_ * cs.y);
                        v[2 * k + 1] = (part & 1) ? (v[2 * k + 1] * cs.z + o1_ * cs.w) : (v[2 * k + 1] * cs.z - o1_ * cs.w); }
                }
                if (isq) {
#pragma unroll
                    for (int i = 0; i < 16; ++i) v[i] *= C2Q; }
                v4u o0, o1;
                o0.x = pk2(v[0], v[1]); o0.y = pk2(v[2], v[3]); o0.z = pk2(v[4], v[5]); o0.w = pk2(v[6], v[7]);
                o1.x = pk2(v[8], v[9]); o1.y = pk2(v[10], v[11]); o1.z = pk2(v[12], v[13]); o1.w = pk2(v[14], v[15]);
                if (isq) { ((v4u*)p[q])[0] = o0; ((v4u*)p[q])[1] = o1; }
                else { const int wsel = (hd >= 14) ? 1 : 0, kvh = (hd - 6) & 1;
                    bf16* kc = WSP(bf16, WS_KC) + ((size_t)(((wsel * 8 + b) * 2 + kvh)) * TPB + t) * 64 + 16 * part;
                    ((v4u*)kc)[0] = o0; ((v4u*)kc)[1] = o1; }
                *(v2u*)(WSP(bf16, WS_VC) + ((size_t)(((vsel * 8 + b) * 2 + vkvh)) * TPB + t) * 64 + vd) = vv[q];
            }
        }
    }
    {
        constexpr int UST = 1536 + 16;
        const float* cw = INP(I_CONVW) + l * 3 * 768; const float* cbv = INP(I_CONVB) + l * 768;
        const int c = tid & 255, half = tid >> 8;
        float w0[3], w1[3], w2[3], wb[3];
#pragma unroll
        for (int g = 0; g < 3; ++g) { w0[g] = cw[g * 256 + c]; w1[g] = cw[768 + g * 256 + c]; w2[g] = cw[1536 + g * 256 + c]; wb[g] = cbv[g * 256 + c]; }
        const int nunits = (l == 0) ? NB * 68 : NB * 64;
        for (int u = blockIdx.x; u < nunits; u += G) {
            int b, n, t0, rowbase; bf16 *zt, *xt;
            if (u < NB * 64) { b = u >> 6; n = SEQ; t0 = (u & 63) * 64; rowbase = b * TPB; zt = WSP(bf16, WS_ZT) + (size_t)b * 256 * SEQ; xt = WSP(bf16, WS_X0T) + (size_t)b * 256 * SEQ; }
            else { const int q = u - NB * 64; b = q >> 2; n = CTXL; t0 = (q & 3) * 64; rowbase = b * TPB + SEQ; zt = WSP(bf16, WS_ZTC) + (size_t)b * 256 * CTXL; xt = WSP(bf16, WS_X0TC) + (size_t)b * 256 * CTXL; }
            __syncthreads();
            { v4u t_[13];
#pragma unroll
              for (int q = 0; q < 13; ++q) { const int idx = tid + 512 * q, rr = idx / 96, ch = idx - 96 * rr, t = t0 - 1 + rr;
                  t_[q] = (v4u){0u, 0u, 0u, 0u};
                  if (idx < 66 * 96 && t >= 0 && t < n) t_[q] = *(const v4u*)(P + (size_t)(rowbase + t) * INW + ch * 8); }
#pragma unroll
              for (int q = 0; q < 13; ++q) { const int idx = tid + 512 * q, rr = idx / 96, ch = idx - 96 * rr;
                  if (idx < 66 * 96) *(LAS v4u*)(lds + rr * UST + ch * 16) = t_[q]; } }
            __syncthreads();
            const LAS unsigned short* up = (const LAS unsigned short*)(lds + (32 * half) * UST) + c;
            float pm[3], pc[3];
#pragma unroll
            for (int g = 0; g < 3; ++g) { pm[g] = bf2f(up[g * 256]); pc[g] = bf2f(up[(UST / 2) + g * 256]); }
            unsigned zo[16], xo[16];
#pragma unroll
            for (int i = 0; i < 32; ++i) {
                float uc[3];
#pragma unroll
                for (int g = 0; g < 3; ++g) { const float pn = bf2f(up[(i + 2) * (UST / 2) + g * 256]); uc[g] = w0[g] * pm[g] + w1[g] * pc[g] + w2[g] * pn + wb[g]; pm[g] = pc[g]; pc[g] = pn; }
                const unsigned zb = f2bf(uc[2] * uc[1]), xb = f2bf(uc[0]);
                if (i & 1) { zo[i >> 1] |= zb << 16; xo[i >> 1] |= xb << 16; } else { zo[i >> 1] = zb; xo[i >> 1] = xb; }
            }
            bf16* zp = zt + (size_t)c * n + t0 + 32 * half; bf16* xp = xt + (size_t)c * n + t0 + 32 * half;
#pragma unroll
            for (int k = 0; k < 4; ++k) { v4u a, d; a.x = zo[4 * k]; a.y = zo[4 * k + 1]; a.z = zo[4 * k + 2]; a.w = zo[4 * k + 3]; d.x = xo[4 * k]; d.y = xo[4 * k + 1]; d.z = xo[4 * k + 2]; d.w = xo[4 * k + 3];
                ((v4u*)zp)[k] = a; ((v4u*)xp)[k] = d; }
        }
        __syncthreads();
    }
}

__device__ __forceinline__ void hyena_latent_unit(const Args& A, LAS unsigned char* lds, int l, int c) {
    const int tid = otid();
    LAS float* Gf = (LAS float*)lds; LAS float* Zf = Gf + 8192;
    const bf16* g = WSP(bf16, WS_GB) + (size_t)(l * 256 + c) * 8192;
    for (int i = tid; i < 8192; i += 512) Gf[i] = bf2f(g[i]);
    const float skip = INP(I_SKIP)[l * 256 + c];
    bf16* Y = WSP(bf16, WS_Y);
    for (int bg = 0; bg < 2; ++bg) {
        __syncthreads();
        for (int i = tid; i < 4 * 4096; i += 512) { const int bb = i >> 12, s = i & 4095; Zf[i] = bf2f(WSP(bf16, WS_ZT)[((size_t)((bg * 4 + bb) * 256 + c)) * SEQ + s]); }
        __syncthreads();
        float acc[4][8];
#pragma unroll
        for (int bb = 0; bb < 4; ++bb)
#pragma unroll
            for (int i = 0; i < 8; ++i) acc[bb][i] = 0.f;
        const LAS float* gp = Gf + tid + 4096;
#pragma unroll 2
        for (int s = 0; s < 4096; ++s) {
            const float z0 = Zf[s], z1 = Zf[4096 + s], z2 = Zf[8192 + s], z3 = Zf[12288 + s];
#pragma unroll
            for (int i = 0; i < 8; ++i) { const float gg = gp[512 * i - s]; acc[0][i] += gg * z0; acc[1][i] += gg * z1; acc[2][i] += gg * z2; acc[3][i] += gg * z3; }
        }
#pragma unroll
        for (int bb = 0; bb < 4; ++bb)
#pragma unroll
            for (int i = 0; i < 8; ++i) { const int t = tid + 512 * i, b = bg * 4 + bb;
                const float x0 = bf2f(WSP(bf16, WS_X0T)[((size_t)(b * 256 + c)) * SEQ + t]);
                Y[((size_t)(b * TPB + t)) * DM + c] = (bf16)f2bf(x0 * (acc[bb][i] + Zf[bb * 4096 + t] * skip)); }
    }
    __syncthreads();
}
__device__ __forceinline__ void hyena_mfma_unit(const Args& A, LAS unsigned char* lds, int l, int c) {
    const int tid = otid(), lane = tid & 63, w = __builtin_amdgcn_readfirstlane(tid >> 6);
    constexpr int RCOPY = 16384 + 64, ZOFF = 4 * RCOPY, ZS = 8192 + 32, ZERO_OFF = ZOFF + 8 * ZS;
    const bf16* gsrc = WSP(bf16, WS_GB) + (size_t)(l * 256 + c) * 8192;
    __syncthreads();
#pragma unroll
    for (int ch = tid; ch < 1024; ch += 512) {
        const v4u g4 = *(const v4u*)(gsrc + 8184 - 8 * ch);
        v4u o; o.x = __builtin_amdgcn_alignbit(g4.w, g4.w, 16); o.y = __builtin_amdgcn_alignbit(g4.z, g4.z, 16); o.z = __builtin_amdgcn_alignbit(g4.y, g4.y, 16); o.w = __builtin_amdgcn_alignbit(g4.x, g4.x, 16);
        *(LAS v4u*)(lds + ch * 16) = o; }
    __syncthreads();
    for (int idx = tid; idx < 3 * 4096; idx += 512) { const int k = 1 + (idx >> 12), wd = idx & 4095;
        const int e0 = 2 * wd + k; const unsigned d0 = *(const LAS unsigned*)(lds + (e0 >> 1) * 4), d1 = (e0 + 1 < 8192 && ((e0 + 1) >> 1) < 4096) ? *(const LAS unsigned*)(lds + ((e0 + 1) >> 1) * 4) : 0u;
        const unsigned v = (k & 1) ? __builtin_amdgcn_alignbit(d1, d0, 16) : d0;
        *(LAS unsigned*)(lds + k * RCOPY + wd * 4) = ((e0 >> 1) < 4096) ? v : 0u; }
    { v4u t_[8];
#pragma unroll
      for (int b = 0; b < 8; ++b) t_[b] = *(const v4u*)(WSP(bf16, WS_ZT) + ((size_t)(b * 256 + c)) * SEQ + tid * 8);
#pragma unroll
      for (int b = 0; b < 8; ++b) *(LAS v4u*)(lds + ZOFF + b * ZS + tid * 16) = t_[b]; }
    if (tid < 32) *(LAS unsigned*)(lds + ZERO_OFF + tid * 4) = 0u;
    __syncthreads();
    const int r = lane & 15, g = lane >> 4, bcol = r >> 1, hcol = r & 1;
    const int Q = 4095 - r + 8 * g, kq = Q & 3;
    const int abase = kq * RCOPY + (Q - kq) * 2;
    const int zlane = ZOFF + bcol * ZS + 16 * g;
    f32x4 acc[4][4];
#pragma unroll
    for (int i = 0; i < 4; ++i)
#pragma unroll
        for (int j = 0; j < 4; ++j) acc[i][j] = (f32x4){0.f, 0.f, 0.f, 0.f};
    const int dlo = 8 * w - 63, dhi = 8 * w + 7;
#define HY_LDA(e) ({ const int a_ = abase - 32 * (e); const v2u lo_ = *(const LAS v2u*)(lds + a_), hi_ = *(const LAS v2u*)(lds + a_ + 8); v4u t_; t_.x = lo_.x; t_.y = lo_.y; t_.z = hi_.x; t_.w = hi_.y; __builtin_bit_cast(bf16x8, t_); })
    bf16x8 F0 = HY_LDA(4 * dlo - 2), F1 = HY_LDA(4 * dlo - 1), F2 = HY_LDA(4 * dlo), F3 = HY_LDA(4 * dlo + 1), F4 = HY_LDA(4 * dlo + 2), F5 = HY_LDA(4 * dlo + 3);
    for (int d = dlo; d <= dhi; ++d) {
        const int dn = (d < dhi) ? d + 1 : d;
        const bf16x8 N2 = HY_LDA(4 * dn), N3 = HY_LDA(4 * dn + 1), N4 = HY_LDA(4 * dn + 2), N5 = HY_LDA(4 * dn + 3);
        bf16x8 Bv[4][2]; bool okc[4];
#pragma unroll
        for (int cb = 0; cb < 4; ++cb) {
            const int s1a = 8 * w + 2 * cb - d;
            okc[cb] = !(s1a > 63 || s1a + 1 < 0);
            if (okc[cb]) { const int s1 = s1a + hcol; const bool ok = (s1 >= 0) && (s1 < 64);
                const int za = ok ? zlane + s1 * 128 : ZERO_OFF;
                Bv[cb][0] = *(const LAS bf16x8*)(lds + za); Bv[cb][1] = *(const LAS bf16x8*)(lds + za + 64); }
        }
#pragma unroll
        for (int cb = 0; cb < 4; ++cb) {
            if (!okc[cb]) continue;
            const bf16x8 B0 = Bv[cb][0], B1 = Bv[cb][1];
            acc[0][cb] = __builtin_amdgcn_mfma_f32_16x16x32_bf16(F2, B0, acc[0][cb], 0, 0, 0);
            acc[1][cb] = __builtin_amdgcn_mfma_f32_16x16x32_bf16(F3, B0, acc[1][cb], 0, 0, 0);
            acc[2][cb] = __builtin_amdgcn_mfma_f32_16x16x32_bf16(F4, B0, acc[2][cb], 0, 0, 0);
            acc[3][cb] = __builtin_amdgcn_mfma_f32_16x16x32_bf16(F5, B0, acc[3][cb], 0, 0, 0);
            acc[0][cb] = __builtin_amdgcn_mfma_f32_16x16x32_bf16(F0, B1, acc[0][cb], 0, 0, 0);
            acc[1][cb] = __builtin_amdgcn_mfma_f32_16x16x32_bf16(F1, B1, acc[1][cb], 0, 0, 0);
            acc[2][cb] = __builtin_amdgcn_mfma_f32_16x16x32_bf16(F2, B1, acc[2][cb], 0, 0, 0);
            acc[3][cb] = __builtin_amdgcn_mfma_f32_16x16x32_bf16(F3, B1, acc[3][cb], 0, 0, 0);
        }
        F0 = F4; F1 = F5; F2 = N2; F3 = N3; F4 = N4; F5 = N5;
    }
#undef HY_LDA
    const float skip = INP(I_SKIP)[l * 256 + c];
    bf16* yt = WSP(bf16, WS_ZT) + ((size_t)(bcol * 256 + c)) * SEQ;
    const bf16* x0p = WSP(bf16, WS_X0T) + ((size_t)(bcol * 256 + c)) * SEQ;
    v2u xx[4][4];
#pragma unroll
    for (int cb = 0; cb < 4; ++cb)
#pragma unroll
        for (int rb = 0; rb < 4; ++rb) xx[cb][rb] = *(const v2u*)(x0p + 64 * (8 * w + 2 * cb + hcol) + 16 * rb + 4 * g);
#pragma unroll
    for (int cb = 0; cb < 4; ++cb)
#pragma unroll
        for (int rb = 0; rb < 4; ++rb) { const int t = 64 * (8 * w + 2 * cb + hcol) + 16 * rb + 4 * g;
            const v2u zz = *(const LAS v2u*)(lds + ZOFF + bcol * ZS + t * 2);
            const f32x4 a = acc[rb][cb]; const v2u x4 = xx[cb][rb];
            v2u o; o.x = pk2(bflo(x4.x) * (a[0] + bflo(zz.x) * skip), bfhi(x4.x) * (a[1] + bfhi(zz.x) * skip)); o.y = pk2(bflo(x4.y) * (a[2] + bflo(zz.y) * skip), bfhi(x4.y) * (a[3] + bfhi(zz.y) * skip));
            *(v2u*)(yt + t) = o; }
    __syncthreads();
}
__device__ __forceinline__ void hyena_ctx_unit(const Args& A, LAS unsigned char* lds, int l, int b, int cg) {
    const int tid = otid(), ch = tid >> 5, tg = tid & 31;
    LAS float* Gf = (LAS float*)lds; LAS float* Zf = Gf + 16 * 512;
    bf16* Y = WSP(bf16, WS_Y);
    __syncthreads();
    { float g_[16]; unsigned short z_[8];
#pragma unroll
      for (int q = 0; q < 16; ++q) g_[q] = WSP(float, WS_GC)[(cg * 16) * 512 + tid + 512 * q];
#pragma unroll
      for (int q = 0; q < 8; ++q) z_[q] = WSP(bf16, WS_ZTC)[((size_t)(b * 256 + cg * 16)) * CTXL + tid + 512 * q];
#pragma unroll
      for (int q = 0; q < 16; ++q) Gf[tid + 512 * q] = g_[q];
#pragma unroll
      for (int q = 0; q < 8; ++q) Zf[tid + 512 * q] = bf2f(z_[q]); }
    __syncthreads();
    float acc[8];
#pragma unroll
    for (int i = 0; i < 8; ++i) acc[i] = 0.f;
    const LAS float* gp = Gf + ch * 512 + 256 + tg; const LAS float* zp = Zf + ch * 256;
    for (int s = 0; s < 256; ++s) { const float z = zp[s];
#pragma unroll
        for (int i = 0; i < 8; ++i) acc[i] += gp[32 * i - s] * z; }
    const int c = cg * 16 + ch; const float skip = INP(I_SKIP)[l * 256 + c];
    unsigned short x0v[8];
#pragma unroll
    for (int i = 0; i < 8; ++i) x0v[i] = WSP(bf16, WS_X0TC)[((size_t)(b * 256 + c)) * CTXL + tg + 32 * i];
#pragma unroll
    for (int i = 0; i < 8; ++i) { const int t = tg + 32 * i;
        Y[((size_t)(b * TPB + SEQ + t)) * DM + c] = (bf16)f2bf(bf2f(x0v[i]) * (acc[i] + zp[t] * skip)); }
    __syncthreads();
}
__device__ __forceinline__ void ph_mixers(const Args& A, unsigned char* lds_generic, LAS unsigned char* lds, int l, int G, int vcu, int cv_lo, int cv_hi) {
#ifndef NO_HY
#ifdef HY_VALU
    for (int u = blockIdx.x; u < 256; u += G) hyena_latent_unit(A, lds, l, u);
#else
#ifndef HY_REPS
#define HY_REPS 1
#endif
    for (int hr = 0; hr < HY_REPS; ++hr)
    for (int u = blockIdx.x; u < 256; u += G) hyena_mfma_unit(A, lds, l, ((u & 7) << 5) | (u >> 3));
#endif
    if (l == 0) { for (int u = G - 1 - (int)blockIdx.x; u < 128; u += G) hyena_ctx_unit(A, lds, l, u >> 4, u & 15); }
#endif
    __syncthreads();
    const attn_body::bf16* P = (const attn_body::bf16*)WSP(bf16, WS_P); attn_body::bf16* Y = (attn_body::bf16*)WSP(bf16, WS_Y);
    const int nunits = (l == 0) ? 1632 : 1536;
    float mfix_ga; { float gq = 0.f, gk = 0.f; const float* qn = INP(I_QNORM) + l * 64; const float* kn = INP(I_KNORM) + l * 64;
        for (int i = 0; i < 64; ++i) { gq = fmaxf(gq, fabsf(qn[i])); gk = fmaxf(gk, fabsf(kn[i])); }
        mfix_ga = 8.0f * LOG2E * gq * gk * 1.02f; }
#ifndef NO_ATT
    int aj = 0;
    for (int u = vcu; u < nunits; u += G, ++aj) {
        if (cv_hi > cv_lo && aj == (vcu & 3)) { __syncthreads(); cv_blocks(A, lds, cv_lo, cv_hi, 0, 1); }
        attn_body::AttnJob J; int b, h, win;
        if (u < 1536) { win = (u >= 768) ? 1 : 0; const int q = win ? u - 768 : u; b = q / 96; const int r = q - 96 * b; h = r >> 4; const int qb = r & 15; J.q0 = 256 * qb;
            if (!win) { J.NT = 68; J.nA = 68; J.rA = 0; J.rB = 0; J.masked = 0; }
            else { const int klo = (J.q0 >= 128) ? J.q0 - 128 : 0, khi = (J.q0 + 384 <= SEQ) ? J.q0 + 384 : SEQ; J.nA = 4; J.rA = SEQ; J.rB = klo; J.NT = 4 + (khi - klo) / 64; J.masked = 1; } }
        else { const int q = u - 1536; win = q / 48; const int r = q - 48 * win; b = r / 6; h = r - 6 * b; J.q0 = SEQ; J.NT = 4; J.nA = 4; J.rA = SEQ; J.rB = 0; J.masked = 0; }
        const int kvh = h / 3;
        const size_t rb = (size_t)b * TPB;
        J.Q = P + rb * INW + (win ? COL_WAQ : COL_GAQ) + 64 * h;
        { const size_t kvo = (size_t)(((win * 8 + b) * 2 + kvh)) * TPB * 64; J.K = (const attn_body::bf16*)WSP(bf16, WS_KC) + kvo; J.V = (const attn_body::bf16*)WSP(bf16, WS_VC) + kvo; }
        J.O = Y + rb * DM + (win ? 640 : 256) + 64 * h;
        J.sink_l2 = win ? INP(I_SINK)[l * 6 + h] * LOG2E : -INFINITY;
        J.mfix = (!win && mfix_ga <= 60.f) ? mfix_ga : 0.f;
        attn_body::attn_unit<8>(J, (char*)lds_generic);
    }
#endif
    __syncthreads();
}
__device__ __forceinline__ void bn_row(v4u w0, v4u w1, bf16* p, int lane, const float (&bw)[16]) {
    float v[16];
    v[0] = bflo(w0.x); v[1] = bfhi(w0.x); v[2] = bflo(w0.y); v[3] = bfhi(w0.y); v[4] = bflo(w0.z); v[5] = bfhi(w0.z); v[6] = bflo(w0.w); v[7] = bfhi(w0.w);
    v[8] = bflo(w1.x); v[9] = bfhi(w1.x); v[10] = bflo(w1.y); v[11] = bfhi(w1.y); v[12] = bflo(w1.z); v[13] = bfhi(w1.z); v[14] = bflo(w1.w); v[15] = bfhi(w1.w);
    float ss = 0.f;
#pragma unroll
    for (int k = 0; k < 16; ++k) ss += v[k] * v[k];
    ss += DPPF(ss, 0xB1); ss += DPPF(ss, 0x4E); ss += DPPF(ss, 0x141);
    float gs[8];
#pragma unroll
    for (int k = 0; k < 8; ++k) gs[k] = __builtin_bit_cast(float, __builtin_amdgcn_readlane(__builtin_bit_cast(int, ss), 8 * k));
    const float s0 = gs[0] + gs[1], s1 = (gs[2] + gs[3]) + gs[4], s2 = (gs[5] + gs[6]) + gs[7];
    const float rs = (lane < 16) ? rsqrtf(s0 * (1.0f / 256.0f) + EPSN) : (lane < 40) ? rsqrtf(s1 * (1.0f / 384.0f) + EPSN) : rsqrtf(s2 * (1.0f / 384.0f) + EPSN);
#pragma unroll
    for (int k = 0; k < 16; ++k) v[k] = v[k] * rs * bw[k];
    v4u o0, o1;
    o0.x = pk2(v[0], v[1]); o0.y = pk2(v[2], v[3]); o0.z = pk2(v[4], v[5]); o0.w = pk2(v[6], v[7]);
    o1.x = pk2(v[8], v[9]); o1.y = pk2(v[10], v[11]); o1.z = pk2(v[12], v[13]); o1.w = pk2(v[14], v[15]);
    ((v4u*)p)[0] = o0; ((v4u*)p)[1] = o1;
}
__device__ __forceinline__ void ph_branchnorm(const Args& A, LAS unsigned char* lds, int l, int G) {
    const int tid = otid(), lane = tid & 63, wave = tid >> 6, gw = blockIdx.x * 8 + wave, NGW = G * 8;
    bf16* Y = WSP(bf16, WS_Y); const float* bn = INP(I_BNORM) + l * DM; const bf16* YT = WSP(bf16, WS_ZT);
    constexpr int NR = 4, TP = 144  , TBUF = 256 * TP;
    float bw[16];
#pragma unroll
    for (int k = 0; k < 4; ++k) { const f32x4 t = ((const f32x4*)(bn + 16 * lane))[k]; bw[4 * k] = t.x; bw[4 * k + 1] = t.y; bw[4 * k + 2] = t.z; bw[4 * k + 3] = t.w; }
    v4u st[4];
    __syncthreads();
    int tx = blockIdx.x, par = 0;
    if (tx < 512) {
#pragma unroll
        for (int j = 0; j < 4; ++j) { const int pz = tid + 512 * j; st[j] = *(const v4u*)(YT + ((size_t)((tx >> 6) * 256 + (pz >> 3))) * SEQ + 64 * (tx & 63) + 8 * (pz & 7)); } }
    for (; tx < 512; tx += G, par ^= 1) {
        LAS unsigned char* buf = lds + par * TBUF;
#pragma unroll
        for (int j = 0; j < 4; ++j) { const int pz = tid + 512 * j; *(LAS v4u*)(buf + (pz >> 3) * TP + (pz & 7) * 16) = st[j]; }
        __syncthreads();
        if (tx + G < 512) { const int tn = tx + G;
#pragma unroll
            for (int j = 0; j < 4; ++j) { const int pz = tid + 512 * j; st[j] = *(const v4u*)(YT + ((size_t)((tn >> 6) * 256 + (pz >> 3))) * SEQ + 64 * (tn & 63) + 8 * (pz & 7)); } }
        const int r0 = (tx >> 6) * TPB + 64 * (tx & 63) + 8 * wave;
#pragma unroll 1
        for (int it = 0; it < 2; ++it) {
            v4u w0[NR], w1[NR]; bf16* p[NR];
#pragma unroll
            for (int q = 0; q < NR; ++q) { p[q] = Y + (size_t)(r0 + 4 * it + q) * DM + 16 * lane;
                if (lane >= 16) { w0[q] = ((const v4u*)p[q])[0]; w1[q] = ((const v4u*)p[q])[1]; }
                else { const LAS unsigned char* cp = buf + (16 * lane) * TP + 2 * (8 * wave + 4 * it + q); unsigned h[16];
#pragma unroll
                    for (int k = 0; k < 16; ++k) h[k] = *(const LAS unsigned short*)(cp + k * TP);
                    w0[q].x = h[0] | (h[1] << 16); w0[q].y = h[2] | (h[3] << 16); w0[q].z = h[4] | (h[5] << 16); w0[q].w = h[6] | (h[7] << 16);
                    w1[q].x = h[8] | (h[9] << 16); w1[q].y = h[10] | (h[11] << 16); w1[q].z = h[12] | (h[13] << 16); w1[q].w = h[14] | (h[15] << 16); } }
#pragma unroll
            for (int q = 0; q < NR; ++q) bn_row(w0[q], w1[q], p[q], lane, bw);
        }
    }
    if (l == 0) {
        for (int i0 = gw * NR; i0 < NB * CTXL; i0 += NGW * NR) {
            v4u w0[NR], w1[NR]; bf16* p[NR];
#pragma unroll
            for (int q = 0; q < NR; ++q) { const int i = i0 + q, r = (i >> 8) * TPB + SEQ + (i & 255); p[q] = Y + (size_t)r * DM + 16 * lane; w0[q] = ((const v4u*)p[q])[0]; w1[q] = ((const v4u*)p[q])[1]; }
#pragma unroll
            for (int q = 0; q < NR; ++q) bn_row(w0[q], w1[q], p[q], lane, bw);
        }
    }
    __syncthreads();
}

constexpr int NPHASE = 22;
__global__ void __launch_bounds__(512, 2) hh_fwd(Args A) {
    extern __shared__ __attribute__((aligned(16))) unsigned char lds_raw[];
    LAS unsigned char* lds = (LAS unsigned char*)lds_raw;
    const int G = gridDim.x;
    volatile LAS unsigned* MISC = (volatile LAS unsigned*)(lds + MISC_OFF);
    if (threadIdx.x < 64) MISC[threadIdx.x] = 0u;
    if ((threadIdx.x & 63) == 0) *(volatile LAS int*)(lds + WTAB_OFF + 4 * hw_slot()) = (int)(threadIdx.x >> 6);
    __syncthreads();
    const bool OVL = (G == 256);
#define SPARE_SPLIT(k_) const int kk_ = OVL ? (k_) : 0, xl_ = vcu & 31, xc_ = vcu >> 5; const bool is_cv = OVL && xl_ >= 32 - kk_; \
    const int Gg = OVL ? 8 * (32 - kk_) : G, cg = OVL ? xc_ * (32 - kk_) + xl_ : vcu, cvw = xc_ * kk_ + (xl_ - (32 - kk_)), cvn = 8 * kk_
    constexpr int CV_A = 800, CV_B = 1722, CV_C = 900, CV_D = 1000, CV_E = 2 * CVB_L - CV_A - CV_B - CV_C - CV_D;
    static_assert(CV_A + CV_B + CV_C >= CVB_L && CV_E >= 0, "layer 0's blocks must be done before its MoE GEMMs");
    const int vcu = (G % 8 == 0) ? ((int)blockIdx.x % 8) * (G / 8) + (int)blockIdx.x / 8 : (int)blockIdx.x;
    { const int __attribute__((address_space(4)))* kp = (const int __attribute__((address_space(4)))*)__builtin_amdgcn_kernarg_segment_ptr();
      if (kp[73] - kp[72] > 1) (void)xcd_barrier_post((unsigned*)ws_ptr(A) + CW_BAR, MISC + 8); }
#define IN(k) in_range(A, (k))
#define SEAM(k) do { if (IN(k) && IN((k) + 1)) { XcdBarrier b_; b_.bar = (unsigned*)ws_ptr(A) + CW_BAR; b_.x = xb_xcc_id(); b_.st = (volatile LAS unsigned*)(lds + MISC_OFF) + 8; xcd_barrier(b_); } } while (0)

#ifndef PH_MASK
#define PH_MASK 0xFFF
#endif
#define PHON(k) ((PH_MASK >> (k)) & 1)
#ifndef HH_REPEAT
#define HH_REPEAT -1
#endif
#ifndef HH_DRY
#define HH_DRY 0
#endif
#define REPS(k) ((HH_REPEAT == (k)) ? 2 : 1)
#define REPBAR(k) do { if (HH_REPEAT == (k)) { XcdBarrier b_; b_.bar = (unsigned*)ws_ptr(A) + CW_BAR; b_.x = xb_xcc_id(); b_.st = (volatile LAS unsigned*)(lds + MISC_OFF) + 8; xcd_barrier(b_); } } while (0)
    if (PHON(0) && IN(0)) { for (int rep_ = 0; rep_ < REPS(0); ++rep_) { if (rep_) REPBAR(0); ph_prologue(A, lds, G, OVL ? 0 : 2 * CVB_L);   } SEAM(0); }
    #pragma unroll 1
    for (int l = 0; l < NLAYER; ++l) {
        const int pb = 1 + 10 * l;
        if (PHON(1) && IN(pb + 0)) { ph_rowpass_a(A, l, G); SEAM(pb + 0); }
        if (PHON(2) && IN(pb + 1)) {
            SPARE_SPLIT(l == 0 ? 4 : 5);
            SchedProj S{(const char*)WSP(bf16, WS_H), (const char*)(WSP(bf16, WS_WINT) + (size_t)l * 2048 * 1024), l, Gg, cg};
            EpiProj E{WSP(bf16, WS_P), INP(I_BIN) + l * INW};
            if (is_cv) { if (l == 0) cv_blocks(A, lds, 0, CV_A, cvw, cvn); else cv_blocks(A, lds, CV_A + CV_B + CV_C, CV_A + CV_B + CV_C + CV_D, cvw, cvn); }
            else for (int rep_ = 0; rep_ < REPS(2); ++rep_) { if (rep_) REPBAR(2); pg8::gemm_phase<EpiProj, SchedProj, false, true>(lds, S, E); }
            SEAM(pb + 1);
        }
        if (PHON(3) && IN(pb + 2)) { ph_post(A, lds, l, G); SEAM(pb + 2); }
        const int cvm_0 = (l == 0) ? CV_A : CV_A + CV_B + CV_C + CV_D, cvm_n = (l == 0) ? CV_B : CV_E, cvm_q = cvm_n / G, cvm_r = cvm_n - cvm_q * G;
        const int cvm_lo = OVL ? cvm_0 + vcu * cvm_q + (vcu < cvm_r ? vcu : cvm_r) : 0, cvm_hi = OVL ? cvm_lo + cvm_q + (vcu < cvm_r ? 1 : 0) : 0;
        if (PHON(4) && IN(pb + 3)) { for (int rep_ = 0; rep_ < REPS(4); ++rep_) { if (rep_) REPBAR(4); ph_mixers(A, lds_raw, lds, l, G, vcu, cvm_lo, cvm_hi); } SEAM(pb + 3); }
        if (PHON(5) && IN(pb + 4)) { ph_branchnorm(A, lds, l, G); SEAM(pb + 4); }
        if (PHON(6) && IN(pb + 5)) {
            SPARE_SPLIT(l == 0 ? 9 : 0);
            SchedOut S{(const char*)WSP(bf16, WS_Y), (const char*)(WSP(bf16, WS_WOUTT) + (size_t)l * 1024 * 1024), l, Gg, cg};
            EpiOut E{WSP(bf16, WS_X), INP(I_BOUT) + l * DM, WSP(float, WS_MOD) + l * 9 * 6144 + 2048, (l == 0) ? INP(I_X) : nullptr, (l == 0) ? INP(I_CTX) : nullptr};
            if (is_cv) cv_blocks(A, lds, CV_A + CV_B, CV_A + CV_B + CV_C, cvw, cvn);
            else pg8::gemm_phase<EpiOut, SchedOut, false, true>(lds, S, E);
            SEAM(pb + 5);
        }
        if (PHON(7) && IN(pb + 6)) { for (int rep_ = 0; rep_ < REPS(7); ++rep_) { if (rep_) REPBAR(7); ph_rowpass_g(A, lds, l, G); } SEAM(pb + 6); }
        if (PHON(8) && IN(pb + 7)) { ph_route(A, lds, l, G); SEAM(pb + 7); }
        if (PHON(9) && IN(pb + 8)) {
            const int nblk = moe_table(A, lds, l);
            SchedMoe S{(const char*)WSP(unsigned char, WS_H8), (const char*)(WSP(unsigned char, WS_W1T) + (size_t)l * 32 * 2048 * 1024), (const LAS int*)(lds + ROWS_OFF), (const LAS unsigned char*)(lds + LDSX_OFF + 1024), nblk, 3, G, vcu, (size_t)2048 * 1024};
            {
                pg8::Unit uu; const int* st = WSP(int, WS_SLOTTOK);
                const int t_ = otid(), th_ = t_ >> 8, tl_ = t_ & 255;
                int rv_[9];
#pragma unroll
                for (int j = 0; j < 9; ++j) { const int i = 2 * j + th_; rv_[j] = S.next(i, uu) ? st[uu.pm * 256 + tl_] : MROWS; }
#pragma unroll
                for (int j = 0; j < 9; ++j) ((LAS int*)(lds + ROWS_OFF))[(2 * j + th_) * 256 + tl_] = rv_[j];
                __syncthreads();
            }
            EpiGlu E{WSP(unsigned char, WS_ACT), INP(I_B1) + (size_t)l * 32 * 2048, &S, 0};
            #ifndef G1_REPS
#define G1_REPS 1
#endif
#pragma unroll 1
            for (int rep_ = 0; rep_ < G1_REPS; ++rep_) { if (rep_) E.dry = HH_DRY; pg8::gemm_phase<EpiGlu, SchedMoe, true, true, true>(lds, S, E); }
            SEAM(pb + 8);
        }
        if (PHON(10) && IN(pb + 9)) {
            const int nblk = moe_table(A, lds, l);
            SchedMoe S{(const char*)WSP(unsigned char, WS_ACT), (const char*)(WSP(unsigned char, WS_W2T) + (size_t)l * 32 * 1024 * 1024), nullptr, (const LAS unsigned char*)(lds + LDSX_OFF + 1024), nblk, 2, G, vcu, (size_t)1024 * 1024};
            EpiOuts E{WSP(unsigned char, WS_OUTS), INP(I_B2) + (size_t)l * 32 * 1024, &S, 0};
            for (int rep_ = 0; rep_ < REPS(10); ++rep_) { if (rep_) { REPBAR(10); E.dry = HH_DRY; } pg8::gemm_phase<EpiOuts, SchedMoe, false, true, true>(lds, S, E); }
            SEAM(pb + 9);
        }
    }
    if (PHON(11) && IN(21)) { for (int rep_ = 0; rep_ < REPS(11); ++rep_) { if (rep_) REPBAR(11); ph_final(A, G); } }
#undef IN
#undef SEAM
}

#ifndef HH_N_LAUNCHES
#define HH_N_LAUNCHES 1
#endif
extern "C" void kernel_launch(void* const* d_in, const int* in_sizes, int n_in, void* d_out, int out_size, void* d_ws, size_t ws_size, hipStream_t stream) {
    static int grid = 0;
    if (grid == 0) {
        if (n_in != 34 || out_size != NB * SEQ * DM || ws_size < WS_END) { fprintf(stderr, "kernel_launch: unexpected shapes (n_in %d, out %d, ws %zu)\n", n_in, out_size, ws_size); grid = -1; return; }
        int dev = 0, cus = 0, per_cu = 0;
        if (hipGetDevice(&dev) != hipSuccess || hipDeviceGetAttribute(&cus, hipDeviceAttributeMultiprocessorCount, dev) != hipSuccess) { grid = -1; return; }
        if (hipFuncSetAttribute((const void*)hh_fwd, hipFuncAttributeMaxDynamicSharedMemorySize, LDS_BYTES) != hipSuccess) { fprintf(stderr, "kernel_launch: hipFuncSetAttribute failed\n"); grid = -1; return; }
        if (hipOccupancyMaxActiveBlocksPerMultiprocessor(&per_cu, (const void*)hh_fwd, 512, LDS_BYTES) != hipSuccess || per_cu < 1) { fprintf(stderr, "kernel_launch: occupancy query says %d\n", per_cu); (void)hipGetLastError(); }
        grid = cus > 256 ? 256 : cus;
    }
    if (grid < 0) return;
    (void)hipMemsetAsync((char*)d_ws + WS_CTL, 0, CTL_ZERO_BYTES, stream);
    Args a{};
    for (int i = 0; i < 34; ++i) a.in[i] = (const float*)d_in[i];
    a.out = (float*)d_out; a.ws = (unsigned char*)d_ws;
    if (HH_N_LAUNCHES == 1) { a.ph_lo = 0; a.ph_hi = NPHASE; hipLaunchKernelGGL(hh_fwd, dim3(grid), dim3(512), LDS_BYTES, stream, a); }
    else { for (int p = 0; p < NPHASE; ++p) { a.ph_lo = p; a.ph_hi = p + 1; hipLaunchKernelGGL(hh_fwd, dim3(grid), dim3(512), LDS_BYTES, stream, a); } }
}
```

```cpp
#include <hip/hip_runtime.h>
#include <cstdio>
#include <cstdint>
#include <cmath>

#define GAS __attribute__((address_space(1)))
#define LAS __attribute__((address_space(3)))
typedef unsigned short bf16;
typedef unsigned v4u __attribute__((ext_vector_type(4)));
typedef unsigned v2u __attribute__((ext_vector_type(2)));
typedef float f32x4 __attribute__((ext_vector_type(4)));
typedef float f32x2 __attribute__((ext_vector_type(2)));
typedef short bf16x8 __attribute__((ext_vector_type(8)));
typedef GAS unsigned gu32;
#define RLX_AGENT __ATOMIC_RELAXED, __HIP_MEMORY_SCOPE_AGENT
#define LDS_WAIT() asm volatile("s_waitcnt lgkmcnt(0)" ::: "memory")
#define VM_WAIT() asm volatile("s_waitcnt vmcnt(0)" ::: "memory")

constexpr int NB = 8, SEQ = 4096, CTXL = 256, TPB = SEQ + CTXL  , MROWS = NB * TPB  , DM = 1024;
constexpr int INW = 2048, NEXP = 32, TOPK = 4, NLAYER = 2;
constexpr int NSLOT_MAX = ((MROWS * TOPK + 255) / 256 + NEXP) * 256;
constexpr int NBLK_MAX = NSLOT_MAX / 256;
constexpr float EPSN = 1e-6f;
constexpr float LOG2E = 1.4426950408889634f;
constexpr float C2Q = 0.125f * LOG2E;
constexpr int COL_HY = 0, COL_GAQ = 768, COL_GAK = 1152, COL_GAV = 1280, COL_WAQ = 1408, COL_WAK = 1792, COL_WAV = 1920;

constexpr size_t MiB = 1u << 20;
constexpr size_t WS_CTL = 0, CTL_ZERO_BYTES = 1 * MiB;
constexpr size_t WS_MOD = 5 * MiB;
constexpr size_t WS_ROPE = 6 * MiB;
constexpr size_t WS_WRT = 6 * MiB + 512 * 1024;
constexpr size_t WS_GC = 7 * MiB;
constexpr size_t WS_HIST = 8 * MiB;
constexpr size_t WS_EXPST = 8 * MiB + 256 * 1024;
constexpr size_t WS_TOPI = 9 * MiB;
constexpr size_t WS_TOPG = 10 * MiB;
constexpr size_t WS_TOKSLOT = 11 * MiB;
constexpr size_t WS_SLOTTOK = 12 * MiB;
constexpr size_t WS_GB = 16 * MiB;
constexpr size_t WS_WINT = 24 * MiB;
constexpr size_t WS_WOUTT = 32 * MiB;
constexpr size_t WS_W1T = 40 * MiB;
constexpr size_t WS_W2T = 296 * MiB;
constexpr size_t WS_X = 424 * MiB;
constexpr size_t WS_H = 560 * MiB;
constexpr size_t WS_P = 632 * MiB;
constexpr size_t WS_Y = 768 * MiB;
constexpr size_t WS_ZT = 836 * MiB;
constexpr size_t WS_X0T = 852 * MiB;
constexpr size_t WS_ZTC = 868 * MiB;
constexpr size_t WS_X0TC = 869 * MiB;
constexpr size_t WS_ACT = 872 * MiB;
constexpr size_t WS_OUTS = 1160 * MiB;
constexpr size_t WS_KC = 1448 * MiB;
constexpr size_t WS_VC = 1484 * MiB;
constexpr size_t WS_H8 = 1520 * MiB;
constexpr size_t WS_END = 1556 * MiB;
static_assert(WS_H + (size_t)(MROWS + 1) * DM * 2 <= WS_P && WS_ACT + (size_t)NSLOT_MAX * DM * 2 <= WS_OUTS && WS_OUTS + (size_t)NSLOT_MAX * DM * 2 <= WS_KC && WS_KC + (size_t)2 * 8 * 2 * TPB * 64 * 2 <= WS_VC && WS_VC + (size_t)2 * 8 * 2 * TPB * 64 * 2 <= WS_END, "ws map");
constexpr int CW_BAR = 4096;

constexpr int RING_BYTES = 131072;
constexpr int LDSX_OFF = RING_BYTES;
constexpr int ROWS_OFF = LDSX_OFF + 2048, BIAS_OFF = LDSX_OFF + 20480;
constexpr int MISC_OFF = RING_BYTES + 28672;
constexpr int WTAB_OFF = MISC_OFF + 256;
constexpr int LDS_BYTES = MISC_OFF + 512;

__device__ __forceinline__ unsigned f2bf(float f) { unsigned u = __builtin_bit_cast(unsigned, f); return (u + 0x7fffu + ((u >> 16) & 1u)) >> 16; }
__device__ __forceinline__ unsigned pk2(float lo, float hi) { return f2bf(lo) | (f2bf(hi) << 16); }
__device__ __forceinline__ float bf2f(unsigned short h) { return __builtin_bit_cast(float, (unsigned)h << 16); }
__device__ __forceinline__ float bflo(unsigned w) { return __builtin_bit_cast(float, w << 16); }
__device__ __forceinline__ float bfhi(unsigned w) { return __builtin_bit_cast(float, w & 0xffff0000u); }
__device__ __forceinline__ int lane_now() { int l; asm volatile("v_mbcnt_lo_u32_b32 %0, -1, 0\n\tv_mbcnt_hi_u32_b32 %0, -1, %0" : "=v"(l)); return l; }
__device__ __forceinline__ float shflx(float v, int mask) { return __builtin_bit_cast(float, __builtin_amdgcn_ds_bpermute((lane_now() ^ mask) << 2, __builtin_bit_cast(int, v))); }
__device__ __forceinline__ float wave_sum(float v) {
    const int ln = lane_now();
#pragma unroll
    for (int o = 1; o < 64; o <<= 1) v += __builtin_bit_cast(float, __builtin_amdgcn_ds_bpermute((ln ^ o) << 2, __builtin_bit_cast(int, v)));
    return v;
}

__device__ __forceinline__ int hw_slot() { return (int)__builtin_amdgcn_s_getreg((5 << 11) | 4) & 63; }
__device__ __forceinline__ int otid() {
    int l; asm volatile("v_mbcnt_lo_u32_b32 %0, -1, 0\n\tv_mbcnt_hi_u32_b32 %0, -1, %0" : "=v"(l));
    const int w = __builtin_amdgcn_readfirstlane(*(const volatile LAS int*)(WTAB_OFF + 4 * hw_slot()));
    return (w << 6) | l;
}

__device__ __forceinline__ unsigned cvt4_fp8(float a, float b, float c, float d) { int p = 0; p = __builtin_amdgcn_cvt_pk_fp8_f32(a, b, p, false); p = __builtin_amdgcn_cvt_pk_fp8_f32(c, d, p, true); return (unsigned)p; }

#define XB_TMO      128
#define XB_XCNT(j)  (256  + 64 * (j))
#define XB_XSUB(j)  (1280 + 64 * (j))
#define XB_XGEN(j)  (2304 + 64 * (j))
#define XB_TOP      3328
#define XB_TOPGEN   3392
#define XCD_BAR_WORDS 3456
#define XB_SPIN_CAP (1u << 18)

__device__ __forceinline__ unsigned xb_ld(unsigned* p)              { return __hip_atomic_load(p, __ATOMIC_RELAXED, __HIP_MEMORY_SCOPE_AGENT); }
__device__ __forceinline__ unsigned xb_add(unsigned* p, unsigned v) { return __hip_atomic_fetch_add(p, v, __ATOMIC_RELAXED, __HIP_MEMORY_SCOPE_AGENT); }
__device__ __forceinline__ unsigned xb_xcc_id() { return (unsigned)__builtin_amdgcn_s_getreg((3 << 11) | 20) & 0xFu; }
#define XB_SPIN(cond, bar) do { unsigned _sp = 0; while (cond) { __builtin_amdgcn_s_sleep(1); \
    if ((++_sp & 255u) == 0u) { if (xb_ld(&(bar)[XB_TMO])) break; if (_sp > XB_SPIN_CAP) { atomicAdd(&(bar)[XB_TMO], 1u); break; } } } } while (0)

struct XcdBarrier {
    unsigned* bar; unsigned x;
    volatile LAS unsigned* st;
};

__device__ __forceinline__ XcdBarrier xcd_barrier_post(unsigned* bar, volatile LAS unsigned* st) {
    XcdBarrier b; b.bar = bar; b.x = xb_xcc_id(); b.st = st;
    if (threadIdx.x == 0) (void)xb_add(&bar[XB_XCNT(b.x)], 1u);
    return b;
}
__device__ __forceinline__ void xcd_barrier_complete(unsigned* bar, unsigned x, unsigned& nloc, unsigned& nx) {
    const unsigned G = gridDim.x * gridDim.y * gridDim.z;
    unsigned sum, cnt, mine, sp = 0u;
    for (;;) {
        sum = 0u; cnt = 0u; mine = 0u;
#pragma unroll
        for (unsigned j = 0; j < 16; ++j) { const unsigned c = xb_ld(&bar[XB_XCNT(j)]); sum += c; cnt += (c > 0u) ? 1u : 0u; mine = (j == x) ? c : mine; }
        if (sum == G) break;
        __builtin_amdgcn_s_sleep(1);
        if ((++sp & 255u) == 0u) { if (xb_ld(&bar[XB_TMO])) break; if (sp > XB_SPIN_CAP) { atomicAdd(&bar[XB_TMO], 1u); break; } }
    }
    nloc = mine > 0u ? mine : 1u; nx = cnt > 0u ? cnt : 1u;
}

__device__ __forceinline__ void xcd_barrier(const XcdBarrier& b) {
    asm volatile("s_waitcnt vmcnt(0)" ::: "memory");
    __syncthreads();
    if (threadIdx.x == 0) {
        unsigned* bar = b.bar;
        __builtin_amdgcn_s_waitcnt(0);
        unsigned nloc = b.st[0], nx = b.st[1];
        if (nloc == 0u) { xcd_barrier_complete(bar, b.x, nloc, nx); b.st[0] = nloc; b.st[1] = nx; }
        const unsigned old = xb_add(&bar[XB_XSUB(b.x)], 1u);
        const unsigned gen = old / nloc;
        if (old + 1u == (gen + 1u) * nloc) {
            __builtin_amdgcn_fence(__ATOMIC_RELEASE, "agent");
            asm volatile("s_waitcnt vmcnt(0)" ::: "memory");
            const unsigned og = xb_add(&bar[XB_TOP], 1u);
            const unsigned tg = og / nx;
            if (og + 1u == (tg + 1u) * nx) xb_add(&bar[XB_TOPGEN], 1u);
            else XB_SPIN(xb_ld(&bar[XB_TOPGEN]) == tg, bar);
            __builtin_amdgcn_fence(__ATOMIC_ACQUIRE, "agent");
            xb_add(&bar[XB_XGEN(b.x)], 1u);
            asm volatile("s_waitcnt vmcnt(0)" ::: "memory");
        } else {
            XB_SPIN(xb_ld(&bar[XB_XGEN(b.x)]) == gen, bar);
            __builtin_amdgcn_fence(__ATOMIC_ACQUIRE, "agent");
            asm volatile("s_waitcnt vmcnt(0)" ::: "memory");
        }
    }
    __syncthreads();
}

namespace pg8 {
constexpr int BM = 256, BK = 64, HALF = 128, HTB = HALF * BK * 2, KK = 1024, NT = KK / BK, WSL = 6  ;
__device__ __forceinline__ int lds_byte(int r, int c) { const int st = (r >> 4) * 2 + (c >> 5), rr = r & 15, cc = c & 31, ob = rr * 64 + cc * 2; return st * 1024 + (ob ^ (((ob >> 9) & 1) << 5)); }
__device__ __forceinline__ void stage_rc(int b, int& R, int& C) { const int st = b / 1024, sb = b % 1024, swz = sb ^ (((sb >> 9) & 1) << 5); R = (st >> 1) * 16 + swz / 64; C = (st & 1) * 32 + (swz % 64) / 2; }
__device__ __forceinline__ int g8(int r) { return ((r >> 1) & 1) | (((r >> 3) & 1) << 2); }
__device__ __forceinline__ void stage_rc8(int b, int& R, int& Cb) { const int sb = b >> 11, q = (b & 2047) >> 4, r = q >> 3, cpos = q & 7; R = sb * 16 + r; Cb = (cpos ^ g8(r)) * 16; }
typedef int v8i __attribute__((ext_vector_type(8)));
using ::lane_now;
typedef int v4i __attribute__((ext_vector_type(4)));
__device__ __forceinline__ v8i ld8(const LAS unsigned char* lds, int off) { const v4i lo = *(const LAS v4i*)(lds + off), hi = *(const LAS v4i*)(lds + (off ^ 16)); return __builtin_shufflevector(lo, hi, 0, 1, 2, 3, 4, 5, 6, 7); }
__device__ __forceinline__ int perm32(int rho) { const int n = rho >> 4, i = rho & 15; return 8 * (i >> 2) + 4 * n + (i & 3); }
__device__ __forceinline__ unsigned cvt_pk_bf16(float lo, float hi) { unsigned r; asm volatile("v_cvt_pk_bf16_f32 %0, %1, %2" : "=v"(r) : "v"(lo), "v"(hi)); return r; }

struct Unit { int pm, pn, idx; };

template <class Epi, class Sched, bool GATHER, bool ALIGN_EPI, bool FP8 = false>
__device__ __forceinline__ void gemm_phase(LAS unsigned char* lds, const Sched& S, const Epi& E) {
    const int tid = otid(), wid = __builtin_amdgcn_readfirstlane(tid >> 6), lane = tid & 63, wr = wid >> 2, wc = wid & 3, fr = lane & 15, fq = lane >> 4;
    constexpr int K = KK, KB = FP8 ? KK : KK * 2  , nt = FP8 ? 8 : NT;
    unsigned voffB[2];
#pragma unroll
    for (int i = 0; i < 2; ++i) { int R, C; if constexpr (FP8) stage_rc8(tid * 16 + i * 8192, R, C); else { stage_rc(tid * 16 + i * 8192, R, C); C *= 2; }
        const int Rb = Epi::PERM ? ((R & ~31) + perm32(R & 31)) : R; voffB[i] = (unsigned)(Rb * KB + C); }
    int rA[2], cA2[2];
#pragma unroll
    for (int i = 0; i < 2; ++i) { int R, C; if constexpr (FP8) stage_rc8(tid * 16 + i * 8192, R, C); else { stage_rc(tid * 16 + i * 8192, R, C); C *= 2; } rA[i] = R; cA2[i] = C; }
#define PG8_AOF(dst, h, uidx) do { _Pragma("unroll") for (int _i = 0; _i < 2; ++_i) { \
        if constexpr (GATHER) dst[_i] = (unsigned)S.arow_idx((uidx), (h) * HALF + rA[_i]) * (unsigned)KB + (unsigned)cA2[_i]; \
        else dst[_i] = (unsigned)(rA[_i] * KB + cA2[_i]); } } while (0)
#define PG8_AH(h) (GATHER ? (size_t)0 : (size_t)(h) * hstep)
    constexpr size_t kstep = (size_t)(BK * 2);
    constexpr size_t hstep = (size_t)HALF * KB;
    const unsigned ldsw = (unsigned)wid * 1024u;
    const int l8 = (fr * 8 + ((2 * fq) ^ g8(fr))) * 16;
    const int aoff = FP8 ? wr * 8192 + l8 : lds_byte(wr * 64 + fr, fq * 8), boff = FP8 ? wc * 4096 + l8 : lds_byte(wc * 32 + fr, fq * 8);
#define PG8_SA(b, h) (((b) * 2 + (h)) * HTB)
#define PG8_SB(b, h) ((4 + (b) * 2 + (h)) * HTB)
#define PG8_STAGE(bufoff, gbase, voff) do { _Pragma("unroll") for (int _i = 0; _i < 2; ++_i) \
        __builtin_amdgcn_global_load_lds((const unsigned*)((const char*)(gbase) + (voff)[_i]), (LAS unsigned*)(lds + (bufoff) + ldsw + _i * 8192), 16, 0, 0); } while (0)
#define PG8_LD8(base) ld8(lds, (base))
#define PG8_LDA(dst, b, h) do { _Pragma("unroll") for (int m = 0; m < 4; ++m) { if constexpr (FP8) dst##8[m] = PG8_LD8(PG8_SA(b, h) + aoff + m * 2048); \
        else { _Pragma("unroll") for (int k = 0; k < 2; ++k) dst[m][k] = *(const LAS bf16x8*)(lds + PG8_SA(b, h) + aoff + m * 2048 + k * 1024); } } } while (0)
#define PG8_LDB(dst, b, h) do { _Pragma("unroll") for (int n = 0; n < 2; ++n) { if constexpr (FP8) dst##8[n] = PG8_LD8(PG8_SB(b, h) + boff + n * 2048); \
        else { _Pragma("unroll") for (int k = 0; k < 2; ++k) dst[n][k] = *(const LAS bf16x8*)(lds + PG8_SB(b, h) + boff + n * 2048 + k * 1024); } } } while (0)
#define PG8_MMA(ai, bj, At, Bt) do { __builtin_amdgcn_s_setprio(1); _Pragma("unroll") for (int m = 0; m < 4; ++m) _Pragma("unroll") for (int n = 0; n < 2; ++n) { \
        if constexpr (FP8) asm volatile("v_mfma_scale_f32_16x16x128_f8f6f4 %0, %1, %2, %0, %3, %3 op_sel_hi:[0,0,0]" : "+v"(acc[ai][bj][m][n]) : "v"(Bt##8[n]), "v"(At##8[m]), "v"(scw)); \
        else { _Pragma("unroll") for (int k = 0; k < 2; ++k) acc[ai][bj][m][n] = __builtin_amdgcn_mfma_f32_16x16x32_bf16(Bt[n][k], At[m][k], acc[ai][bj][m][n], 0, 0, 0); } } \
        __builtin_amdgcn_s_setprio(0); } while (0)
#define PG8_WAIT_V(n) asm volatile("s_waitcnt vmcnt(" #n ")" ::: "memory")
#define PG8_WAIT_L(n) asm volatile("s_waitcnt lgkmcnt(" #n ")" ::: "memory")
#define PG8_BAR __builtin_amdgcn_s_barrier()
#define PG8_SCHED __builtin_amdgcn_sched_barrier(0)
    LAS unsigned char* biasl = lds + BIAS_OFF;
#define PG8_BIAS(u, slot) do { _Pragma("unroll") for (int _j = 0; _j < Epi::NDMA; ++_j) \
        __builtin_amdgcn_global_load_lds((const unsigned*)E.bias_src((u), lane_now(), _j), (LAS unsigned*)(biasl + (slot) + _j * 1024), 16, 0, 0); } while (0)
    Unit cur, nxt; int ui = 0;
    if (!S.next(0, cur)) return;
    int bs_cur = 0, bs_nxt = 2048;
    PG8_BIAS(cur, 0);
    unsigned va[2];
    f32x4 acc[2][2][4][2];
#pragma unroll
    for (int a = 0; a < 2; ++a)
#pragma unroll
        for (int b = 0; b < 2; ++b)
#pragma unroll
            for (int m = 0; m < 4; ++m)
#pragma unroll
                for (int n = 0; n < 2; ++n) acc[a][b][m][n] = (f32x4){0.f, 0.f, 0.f, 0.f};
    int scw = (127 - WSL / 2) * 0x01010101;
    asm volatile("" : "+v"(scw));
    bf16x8 At[4][2], B0[2][2], B1[2][2]; v8i At8[4], B08[2], B18[2];
    const char* cA = S.abase(cur); const char* cB = S.bbase(cur);
    PG8_STAGE(PG8_SB(0, 0), cB, voffB); PG8_STAGE(PG8_SB(0, 1), cB + hstep, voffB); PG8_AOF(va, 0, cur.idx); PG8_STAGE(PG8_SA(0, 0), cA, va); PG8_AOF(va, 1, cur.idx); PG8_STAGE(PG8_SA(0, 1), cA + PG8_AH(1), va);
    if (wr == 1) PG8_BAR;
    PG8_WAIT_V(2); PG8_BAR;
    PG8_STAGE(PG8_SB(1, 0), cB + kstep, voffB); PG8_AOF(va, 0, cur.idx); PG8_STAGE(PG8_SA(1, 0), cA + kstep, va); PG8_STAGE(PG8_SB(1, 1), cB + hstep + kstep, voffB);
    PG8_WAIT_V(6); PG8_BAR;
    for (;;) {
        const bool has_next = S.next(ui + 1, nxt);
        if (has_next) PG8_BIAS(nxt, bs_nxt);
        const char* nA = has_next ? S.abase(nxt) : cA; const char* nB = has_next ? S.bbase(nxt) : cB;
#pragma unroll 1
        for (int t = 0; t < nt; t += 2) {
            const bool last = (t == nt - 2);
            const char* a1 = cA + (size_t)(t + 1) * kstep;
            const char* a2 = last ? nA : cA + (size_t)(t + 2) * kstep; const char* b2 = last ? nB : cB + (size_t)(t + 2) * kstep;
            const char* a3 = a2 + kstep; const char* b3 = b2 + kstep;
            const int idx2 = (last && has_next) ? nxt.idx : cur.idx;
            PG8_AOF(va, 1, cur.idx); PG8_LDB(B0, 0, 0); PG8_LDB(B1, 0, 1); PG8_SCHED; PG8_LDA(At, 0, 0); PG8_STAGE(PG8_SA(1, 1), a1 + PG8_AH(1), va);
            PG8_WAIT_V(8); PG8_WAIT_L(0); PG8_BAR; PG8_MMA(0, 0, At, B0); PG8_MMA(0, 1, At, B1); PG8_BAR; PG8_SCHED;
            PG8_AOF(va, 0, idx2); PG8_LDA(At, 0, 1); PG8_STAGE(PG8_SB(0, 0), b2, voffB); PG8_STAGE(PG8_SB(0, 1), b2 + hstep, voffB); PG8_STAGE(PG8_SA(0, 0), a2, va);
            PG8_WAIT_V(8); PG8_WAIT_L(0); PG8_BAR; PG8_MMA(1, 0, At, B0); PG8_MMA(1, 1, At, B1); PG8_BAR; PG8_SCHED;
            PG8_AOF(va, 1, idx2); PG8_LDB(B0, 1, 0); PG8_LDB(B1, 1, 1); PG8_SCHED; PG8_LDA(At, 1, 0); PG8_STAGE(PG8_SA(0, 1), a2 + PG8_AH(1), va);
            PG8_WAIT_V(8); PG8_WAIT_L(0); PG8_BAR; PG8_MMA(0, 0, At, B0); PG8_MMA(0, 1, At, B1); PG8_BAR; PG8_SCHED;
            PG8_AOF(va, 0, idx2); PG8_LDA(At, 1, 1); PG8_STAGE(PG8_SB(1, 0), b3, voffB); PG8_STAGE(PG8_SB(1, 1), b3 + hstep, voffB); PG8_STAGE(PG8_SA(1, 0), a3, va);
            PG8_WAIT_V(8); PG8_WAIT_L(0); PG8_BAR; PG8_MMA(1, 0, At, B0); PG8_MMA(1, 1, At, B1); PG8_BAR; PG8_SCHED;
        }
        if constexpr (FP8) asm volatile("s_nop 15\n\ts_nop 7" ::: "memory");
        if constexpr (ALIGN_EPI) { if (wr == 0) PG8_BAR; }
        E(acc, cur, wr, wc, fr, fq, biasl + bs_cur);
        if (!has_next) break;
#pragma unroll
        for (int a = 0; a < 2; ++a)
#pragma unroll
            for (int b = 0; b < 2; ++b)
#pragma unroll
                for (int m = 0; m < 4; ++m)
#pragma unroll
                    for (int n = 0; n < 2; ++n) acc[a][b][m][n] = (f32x4){0.f, 0.f, 0.f, 0.f};
        cur = nxt; cA = nA; cB = nB; ++ui; bs_cur = bs_nxt; bs_nxt = (bs_nxt == 4096) ? 0 : bs_nxt + 2048;
        if constexpr (ALIGN_EPI) { if (wr == 1) PG8_BAR; }
    }
    PG8_WAIT_V(0);
    if constexpr (!ALIGN_EPI) { if (wr == 0) PG8_BAR; }
    PG8_BAR;
#undef PG8_BIAS
#undef PG8_LD8
#undef PG8_AOF
#undef PG8_AH
#undef PG8_SA
#undef PG8_SB
#undef PG8_STAGE
#undef PG8_LDA
#undef PG8_LDB
#undef PG8_MMA
#undef PG8_WAIT_V
#undef PG8_WAIT_L
#undef PG8_BAR
#undef PG8_SCHED
}
}

#include <hip/hip_bf16.h>
namespace attn_body {
using bf16=__hip_bfloat16;
struct AttnJob { const bf16* Q; const bf16* K; const bf16* V; bf16* O; int q0, NT, nA, rA, rB, masked; float sink_l2, mfix; };
using bf16x8=__attribute__((ext_vector_type(8)))short;
using s16x4=__attribute__((ext_vector_type(4)))short;
using f32x16=__attribute__((ext_vector_type(16)))float;
using u32x4=__attribute__((ext_vector_type(4)))unsigned;
constexpr int D=64,PQ=2048,PKV=64,PO=1024;
constexpr int NW=8,QBLK=32,QB=QBLK*NW,KVBLK=64;
__device__ __forceinline__ int crow(int r,int hi){return (r&3)+8*(r>>2)+4*hi;}
#define SBAR() __builtin_amdgcn_sched_barrier(0)
__device__ __forceinline__ void wmask(f32x16&p0,f32x16&p1,int dk){
  const float NEG=-INFINITY; asm volatile("":"+v"(dk));
  #pragma unroll
  for(int r=0;r<16;++r){const int d=dk+(r&3)+8*(r>>2); if((unsigned)(d+128)>256u)p0[r]=NEG; if((unsigned)(d+160)>256u)p1[r]=NEG;}
}

constexpr int NSLOT=3, SLOTB=8192;
constexpr int LDS_K=0, LDS_V=NSLOT*SLOTB, LDS_WS=2*NSLOT*SLOTB, LDS_OST=LDS_WS+NW*64*4, LDS_BYTES=LDS_OST+NW*4096;
constexpr float C2=0.125f*1.4426950408889634f;
__device__ __forceinline__ void glds16(const void*gsrc,unsigned lds_dst){unsigned keep;
  asm volatile("s_mov_b32 %0, m0\n\ts_mov_b32 m0, %2\n\ts_nop 0\n\tglobal_load_lds_dwordx4 %1, off\n\ts_mov_b32 m0, %0":"=&s"(keep):"v"(gsrc),"s"(lds_dst):"memory");}
__device__ __forceinline__ float max3f(float a,float b,float c){float r;asm("v_max3_f32 %0, %1, %2, %3":"=v"(r):"v"(a),"v"(b),"v"(c));return r;}
__device__ __forceinline__ float max2f(float a,float b){float r;asm("v_max_f32_e32 %0, %1, %2":"=v"(r):"v"(a),"v"(b));return r;}
__device__ __forceinline__ float fadd_s(float a,float b){float r;asm("v_add_f32_e32 %0, %1, %2":"=v"(r):"v"(a),"v"(b));return r;}
__device__ __forceinline__ float fsub_s(float a,float b){float r;asm("v_sub_f32_e32 %0, %1, %2":"=v"(r):"v"(a),"v"(b));return r;}
typedef float f32x2_t __attribute__((ext_vector_type(2))); typedef __bf16 bf16x2_t __attribute__((ext_vector_type(2)));
__device__ __forceinline__ unsigned cvtpk_s(float lo,float hi){f32x2_t v={lo,hi};bf16x2_t b=__builtin_convertvector(v,bf16x2_t);return __builtin_bit_cast(unsigned,b);}
#define WAIT_BAR(N) asm volatile("s_waitcnt vmcnt(" #N ") lgkmcnt(0)\n\ts_barrier":::"memory")

__device__ __forceinline__ void qkt(f32x16&p0,f32x16&p1,const char*Kslot,const bf16x8*qr,const f32x16&negm,int r32,int hi){
  const char*kb=Kslot+hi*1024+r32*16;
  #pragma unroll
  for(int d0=0;d0<4;++d0){
    const bf16x8 b0=*reinterpret_cast<const bf16x8*>(kb+d0*2048);
    const bf16x8 b1=*reinterpret_cast<const bf16x8*>(kb+d0*2048+512);
    if(d0==0){p0=__builtin_amdgcn_mfma_f32_32x32x16_bf16(b0,qr[0],negm,0,0,0);p1=__builtin_amdgcn_mfma_f32_32x32x16_bf16(b1,qr[0],negm,0,0,0);}
    else{p0=__builtin_amdgcn_mfma_f32_32x32x16_bf16(b0,qr[d0],p0,0,0,0);p1=__builtin_amdgcn_mfma_f32_32x32x16_bf16(b1,qr[d0],p1,0,0,0);}}
}
typedef __attribute__((address_space(3))) const char* lds_cptr;
typedef short v4i16_t __attribute__((ext_vector_type(4)));
__device__ __forceinline__ void kload8(bf16x8*kf,lds_cptr kp){
  kf[0]=*(const __attribute__((address_space(3))) bf16x8*)(kp);      kf[1]=*(const __attribute__((address_space(3))) bf16x8*)(kp+512);
  kf[2]=*(const __attribute__((address_space(3))) bf16x8*)(kp+2048); kf[3]=*(const __attribute__((address_space(3))) bf16x8*)(kp+2560);
  kf[4]=*(const __attribute__((address_space(3))) bf16x8*)(kp+4096); kf[5]=*(const __attribute__((address_space(3))) bf16x8*)(kp+4608);
  kf[6]=*(const __attribute__((address_space(3))) bf16x8*)(kp+6144); kf[7]=*(const __attribute__((address_space(3))) bf16x8*)(kp+6656);
}
__device__ __forceinline__ void kload2(bf16x8*kf,lds_cptr kp,int j){ kf[2*j]=*(const __attribute__((address_space(3))) bf16x8*)(kp+j*2048); kf[2*j+1]=*(const __attribute__((address_space(3))) bf16x8*)(kp+j*2048+512); }
__device__ __forceinline__ s16x4 vtr(lds_cptr p){ return __builtin_bit_cast(s16x4,__builtin_amdgcn_ds_read_tr16_b64_v4i16((__attribute__((address_space(3))) v4i16_t*)p)); }
__device__ __forceinline__ float rowmax(const f32x16&p0,const f32x16&p1){
  float a=max3f(p0[0],p0[1],p1[0]),b=max3f(p0[2],p0[3],p1[1]);a=max3f(a,p1[2],p1[3]);
  #pragma unroll
  for(int r=4;r<16;r+=4){a=max3f(a,p0[r],p0[r+1]);b=max3f(b,p0[r+2],p0[r+3]);a=max3f(a,p1[r],p1[r+1]);b=max3f(b,p1[r+2],p1[r+3]);}
  const float m=max2f(a,b);
  auto rr=__builtin_amdgcn_permlane32_swap(__float_as_uint(m),__float_as_uint(m),false,false);
  return max2f(__uint_as_float(rr[0]),__uint_as_float(rr[1]));
}
__device__ __forceinline__ void pv(f32x16*o,int vb,bf16x8 pa0,bf16x8 pa1,bf16x8 pa2,bf16x8 pa3){
  #pragma unroll
  for(int d0=0;d0<2;++d0){s16x4 lo[4],hi[4];
    #pragma unroll
    for(int ks=0;ks<4;++ks){
      asm volatile("ds_read_b64_tr_b16 %0,%1 offset:%c2":"=&v"(lo[ks]):"v"(vb),"i"(d0*4096+ks*1024):"memory");
      asm volatile("ds_read_b64_tr_b16 %0,%1 offset:%c2":"=&v"(hi[ks]):"v"(vb),"i"(d0*4096+ks*1024+512):"memory");}
    asm volatile("s_waitcnt lgkmcnt(0)":::"memory");SBAR();
    #define PK(k) (bf16x8){lo[k][0],lo[k][1],lo[k][2],lo[k][3],hi[k][0],hi[k][1],hi[k][2],hi[k][3]}
    o[d0]=__builtin_amdgcn_mfma_f32_32x32x16_bf16(pa0,PK(0),o[d0],0,0,0);
    o[d0]=__builtin_amdgcn_mfma_f32_32x32x16_bf16(pa1,PK(1),o[d0],0,0,0);
    o[d0]=__builtin_amdgcn_mfma_f32_32x32x16_bf16(pa2,PK(2),o[d0],0,0,0);
    o[d0]=__builtin_amdgcn_mfma_f32_32x32x16_bf16(pa3,PK(3),o[d0],0,0,0);
    #undef PK
  }
}

#ifndef ATTN_STORE16
#define ATTN_STORE16(p,v) (*(u32x4*)(p)=(v))
#endif
template<int THRL> __device__ __forceinline__ void attn_unit(const AttnJob&J,char*shm){
  const int tid=otid(),lane=tid&63,r32=lane&31,hi=lane>>5; const int wid=__builtin_amdgcn_readfirstlane(tid>>6);
  const int q0=J.q0;
  const bf16*Qw=J.Q+(long)(q0+wid*QBLK)*PQ;
  const bf16*Kh=J.K,*Vh=J.V;
  const unsigned lds0=(unsigned)(uintptr_t)shm;
  float*wsf=(float*)(shm+LDS_WS)+wid*64;
  const bf16*ksrc=Kh+(long)lane*PKV+wid*8;
  const bf16*vsrc=Vh+(long)(16*(wid&3)+(lane>>2))*PKV+(wid>>2)*32+(lane&3)*8;
  const unsigned kdst=lds0+LDS_K+wid*1024, vdst=lds0+LDS_V+wid*1024;
  #define TROW(t) (((t)<nA)?(rA+64*(t)):(rB+64*((t)-nA)))
  #define DMA_K(t,slot) glds16(ksrc+(long)TROW(t)*PKV,(unsigned)__builtin_amdgcn_readfirstlane(kdst+(slot)))
  #define DMA_V(t,slot) glds16(vsrc+(long)TROW(t)*PKV,(unsigned)__builtin_amdgcn_readfirstlane(vdst+(slot)))
  const int vb0=(int)(lds0+LDS_V)+((lane>>4)&1)*32+(lane&3)*8+(4*hi+((lane&15)>>2))*64;
  const char*Kbase=shm+LDS_K; bf16x8 kf[8];
  const lds_cptr shm3=(lds_cptr)shm; const lds_cptr kp0=shm3+LDS_K+hi*1024+r32*16; const lds_cptr vp0=shm3+LDS_V+((lane>>4)&1)*32+(lane&3)*8+(4*hi+((lane&15)>>2))*64;
  const int NT=J.NT,nA=J.nA,rA=J.rA,rB=J.rB; const bool msk=(J.masked!=0);
  DMA_K(0,0);DMA_V(0,0);DMA_K(1,SLOTB);
  bf16x8 qr[4];
  #pragma unroll
  for(int d0=0;d0<4;++d0)qr[d0]=*reinterpret_cast<const bf16x8*>(&Qw[(long)r32*PQ+d0*16+hi*8]);
  float mhat=0.f,l_reg=0.f;f32x16 o[2];o[0]=f32x16{};o[1]=f32x16{};f32x16 negm=f32x16{};asm volatile("":"+v"(negm));
  const int qpos=q0+wid*QBLK+r32;
  #define CMASK(P0,P1,t) do{ if(msk&&(t)>=nA)wmask(P0,P1,TROW(t)+4*hi-qpos); }while(0)
  bool resc=false;
  const bool nomax=(J.mfix>0.f);
  #define START(P0,P1) do{ const float rm=nomax?J.mfix:rowmax(P0,P1); resc=false; \
    { const float dl=rm; mhat=fadd_s(mhat,dl); \
      _Pragma("unroll") for(int r=0;r<16;++r){P0[r]=fsub_s(P0[r],dl);P1[r]=fsub_s(P1[r],dl);} \
      _Pragma("unroll") for(int r=0;r<16;++r)negm[r]=-mhat; asm volatile("":"+v"(negm)); } \
    _Pragma("unroll") for(int r=0;r<16;++r)P0[r]=__builtin_amdgcn_exp2f(P0[r]); }while(0)
  #define RESC() do{ if(resc){ asm volatile("s_waitcnt lgkmcnt(0)":::"memory"); \
      _Pragma("unroll") for(int d_=0;d_<2;++d_) _Pragma("unroll") for(int r=0;r<16;++r)o[d_][r]*=wsf[crow(r,hi)]; } }while(0)
  f32x16 pA0,pA1,pB0,pB1;
  int sl_prev=0,sl_cur=0,sl_next=SLOTB;
  #define ROT() do{sl_prev=sl_cur;sl_cur=sl_next;sl_next=(sl_next==(NSLOT-1)*SLOTB)?0:sl_next+SLOTB;}while(0)
  DMA_K(2,2*SLOTB);
  WAIT_BAR(3);
  qkt(pA0,pA1,Kbase,qr,negm,r32,hi);asm volatile("s_nop 15\n\ts_nop 7":"+v"(pA0),"+v"(pA1));CMASK(pA0,pA1,0);
  START(pA0,pA1);
  _Pragma("unroll") for(int r=0;r<16;++r)pA1[r]=__builtin_amdgcn_exp2f(pA1[r]);
  WAIT_BAR(0);
  DMA_K(3,0);DMA_V(1,SLOTB);
  ROT();
  kload8(kf,kp0+sl_cur);
  WAIT_BAR(2);
  s16x4 vlo[8],vhi[8]; u32x4 pw0,pw1,pw2,pw3;
  #define PKW(P,B) cvtpk_s(P[B],P[B+1])
  #define PAF(k) __builtin_bit_cast(bf16x8,pw##k)
  #define VFR(i) (bf16x8){vlo[i][0],vlo[i][1],vlo[i][2],vlo[i][3],vhi[i][0],vhi[i][1],vhi[i][2],vhi[i][3]}
  #define PIN(x) asm volatile("":"+v"(x))
  #define MX3(a,b,c) __builtin_fmaxf(__builtin_fmaxf((a),(b)),(c))
  #define GAPA(MF,A0,A1,A2,A3,W0,W1,PW) do{ MF; sacc+=A0; sacc+=A1; sacc+=A2; sacc+=A3; PIN(sacc); W0; W1; PIN(PW); SBAR(); }while(0)
  #define EX(v) __builtin_amdgcn_exp2f(v)
  #define GAPB(MF,X,B) do{ MF; X[B]=EX(X[B]); X[B+1]=EX(X[B+1]); X[B+2]=EX(X[B+2]); X[B+3]=EX(X[B+3]); PIN(X); SBAR(); }while(0)
  #define VRD(i) do{ vlo[i]=vtr(vp_+(((i)>>2)*4096+((i)&3)*1024)); vhi[i]=vtr(vp_+(((i)>>2)*4096+((i)&3)*1024+512)); }while(0)
  #define KRD(G,j) do{ if(G){ kload2(kf,kp0+sl_next,j); SBAR(); } }while(0)
  #define STEP(C0,C1,P0,P1,t,GK,GV,GL) do{ SBAR(); \
    const lds_cptr vp_=vp0+sl_prev; \
    VRD(0); SBAR(); float sacc=(P0[0]+P0[1]); \
    GAPA(C0=__builtin_amdgcn_mfma_f32_32x32x16_bf16(kf[0],qr[0],negm,0,0,0), P0[2],P0[3],P0[4],P0[5],     pw0[0]=PKW(P0,0), pw0[1]=PKW(P0,2), pw0); \
    VRD(4); SBAR(); GAPA(C1=__builtin_amdgcn_mfma_f32_32x32x16_bf16(kf[1],qr[0],negm,0,0,0), P0[6],P0[7],P0[8],P0[9],     pw0[2]=PKW(P0,4), pw0[3]=PKW(P0,6), pw0); \
    VRD(1); SBAR(); GAPA(C0=__builtin_amdgcn_mfma_f32_32x32x16_bf16(kf[2],qr[1],C0,0,0,0),   P0[10],P0[11],P0[12],P0[13], pw1[0]=PKW(P0,8), pw1[1]=PKW(P0,10), pw1); \
    VRD(5); SBAR(); GAPA(C1=__builtin_amdgcn_mfma_f32_32x32x16_bf16(kf[3],qr[1],C1,0,0,0),   P0[14],P0[15],P1[0],P1[1],   pw1[2]=PKW(P0,12),pw1[3]=PKW(P0,14), pw1); \
    VRD(2); SBAR(); GAPA(C0=__builtin_amdgcn_mfma_f32_32x32x16_bf16(kf[4],qr[2],C0,0,0,0),   P1[2],P1[3],P1[4],P1[5],     pw2[0]=PKW(P1,0), pw2[1]=PKW(P1,2), pw2); \
    VRD(6); SBAR(); GAPA(C1=__builtin_amdgcn_mfma_f32_32x32x16_bf16(kf[5],qr[2],C1,0,0,0),   P1[6],P1[7],P1[8],P1[9],     pw2[2]=PKW(P1,4), pw2[3]=PKW(P1,6), pw2); \
    VRD(3); SBAR(); GAPA(C0=__builtin_amdgcn_mfma_f32_32x32x16_bf16(kf[6],qr[3],C0,0,0,0),   P1[10],P1[11],P1[12],P1[13], pw3[0]=PKW(P1,8), pw3[1]=PKW(P1,10), pw3); \
    VRD(7); SBAR(); GAPA(C1=__builtin_amdgcn_mfma_f32_32x32x16_bf16(kf[7],qr[3],C1,0,0,0),   P1[14],P1[15],0.f,0.f,       pw3[2]=PKW(P1,12),pw3[3]=PKW(P1,14), pw3); \
    l_reg+=sacc; \
    if(GK){DMA_K((t)+3,sl_cur);} if(GV){DMA_V((t)+1,sl_next);} \
    CMASK(C0,C1,t); \
    resc=false; if(!nomax){ float a=MX3(C0[0],C0[1],C1[0]),b=MX3(C0[2],C0[3],C1[1]); a=MX3(a,C1[2],C1[3]); \
      _Pragma("unroll") for(int r=4;r<16;r+=4){a=MX3(a,C0[r],C0[r+1]);b=MX3(b,C0[r+2],C0[r+3]);a=MX3(a,C1[r],C1[r+1]);b=MX3(b,C1[r+2],C1[r+3]);} \
      float rm=__builtin_fmaxf(a,b); { auto rr=__builtin_amdgcn_permlane32_swap(__float_as_uint(rm),__float_as_uint(rm),false,false); rm=__builtin_fmaxf(__uint_as_float(rr[0]),__uint_as_float(rr[1])); } \
      resc=false; \
      if(__builtin_expect(__any(rm>(float)THRL),0)){ const float dl=__builtin_fmaxf(rm,0.f); mhat+=dl; \
        _Pragma("unroll") for(int r=0;r<16;++r){C0[r]-=dl;C1[r]-=dl;} \
        _Pragma("unroll") for(int r=0;r<16;++r)negm[r]=-mhat; asm volatile("":"+v"(negm)); \
        const float f=__builtin_amdgcn_exp2f(-dl); l_reg*=f; if(hi==0)wsf[r32]=f; resc=true; } } \
    SBAR(); \
    GAPB(o[0]=__builtin_amdgcn_mfma_f32_32x32x16_bf16(PAF(0),VFR(0),o[0],0,0,0), C0,0); \
    GAPB(o[1]=__builtin_amdgcn_mfma_f32_32x32x16_bf16(PAF(0),VFR(4),o[1],0,0,0), C0,4); \
    KRD(GL,0); GAPB(o[0]=__builtin_amdgcn_mfma_f32_32x32x16_bf16(PAF(1),VFR(1),o[0],0,0,0), C0,8); \
    KRD(GL,1); GAPB(o[1]=__builtin_amdgcn_mfma_f32_32x32x16_bf16(PAF(1),VFR(5),o[1],0,0,0), C0,12); \
    KRD(GL,2); GAPB(o[0]=__builtin_amdgcn_mfma_f32_32x32x16_bf16(PAF(2),VFR(2),o[0],0,0,0), C1,0); \
    KRD(GL,3); GAPB(o[1]=__builtin_amdgcn_mfma_f32_32x32x16_bf16(PAF(2),VFR(6),o[1],0,0,0), C1,4); \
    GAPB(o[0]=__builtin_amdgcn_mfma_f32_32x32x16_bf16(PAF(3),VFR(3),o[0],0,0,0), C1,8); \
    GAPB(o[1]=__builtin_amdgcn_mfma_f32_32x32x16_bf16(PAF(3),VFR(7),o[1],0,0,0), C1,12); \
    }while(0)
  int t=1;
  #undef CMASK
  #define CMASK(P0,P1,t) do{}while(0)
  for(;(!msk)&&t+5<NT;t+=2){
    STEP(pB0,pB1,pA0,pA1,t,true,true,true);     WAIT_BAR(2); RESC(); ROT();
    STEP(pA0,pA1,pB0,pB1,t+1,true,true,true);   WAIT_BAR(2); RESC(); ROT();
  }
  #undef CMASK
  #define CMASK(P0,P1,t) do{ if(msk&&(t)>=nA)wmask(P0,P1,TROW(t)+4*hi-qpos); }while(0)
  #define ENDW(tt) do{ if((tt)+3<NT){WAIT_BAR(2);} else if((tt)+2<NT){WAIT_BAR(1);} else {WAIT_BAR(0);} }while(0)
  for(;t+1<NT;t+=2){
    STEP(pB0,pB1,pA0,pA1,t,(t+3<NT),(t+1<NT),(t+1<NT));       ENDW(t);   RESC(); ROT();
    STEP(pA0,pA1,pB0,pB1,t+1,(t+4<NT),(t+2<NT),(t+2<NT));     ENDW(t+1); RESC(); ROT();
  }
  STEP(pB0,pB1,pA0,pA1,NT-1,false,false,false); RESC();
  { float sacc=pB0[0]+pB0[1]; _Pragma("unroll") for(int r=2;r<16;++r)sacc+=pB0[r]; _Pragma("unroll") for(int r=0;r<16;++r)sacc+=pB1[r]; l_reg+=sacc;
    pw0=(u32x4){PKW(pB0,0),PKW(pB0,2),PKW(pB0,4),PKW(pB0,6)};pw1=(u32x4){PKW(pB0,8),PKW(pB0,10),PKW(pB0,12),PKW(pB0,14)};pw2=(u32x4){PKW(pB1,0),PKW(pB1,2),PKW(pB1,4),PKW(pB1,6)};pw3=(u32x4){PKW(pB1,8),PKW(pB1,10),PKW(pB1,12),PKW(pB1,14)};
    SBAR(); pv(o,vb0+sl_cur,PAF(0),PAF(1),PAF(2),PAF(3)); }
  #undef PKW
  #undef PAF
  #undef VFR
  #undef PIN
  #undef MX3
  #undef GAPA
  #undef GAPB
  #undef EX
  #undef VRD
  #undef KRD
  #undef STEP
  #undef ENDW
  if(hi==0)l_reg+=__builtin_amdgcn_exp2f(J.sink_l2-mhat);
  {auto rr=__builtin_amdgcn_permlane32_swap(__float_as_uint(l_reg),__float_as_uint(l_reg),false,false);l_reg=__uint_as_float(rr[0])+__uint_as_float(rr[1]);}
  if(hi==0)wsf[32+r32]=l_reg;asm volatile("s_waitcnt lgkmcnt(0)":::"memory");
  float rli[16];
  #pragma unroll
  for(int r=0;r<16;++r)rli[r]=__builtin_amdgcn_rcpf(wsf[32+crow(r,hi)]);
  bf16*Ow=J.O+(long)(q0+wid*QBLK)*PO;
  { bf16*stg=(bf16*)(shm+LDS_OST)+wid*2048;
    #pragma unroll
    for(int r=0;r<16;++r){const int orow=crow(r,hi);
      #pragma unroll
      for(int d0=0;d0<2;++d0)stg[orow*64+d0*32+r32]=__float2bfloat16(o[d0][r]*rli[r]);}
    asm volatile("s_waitcnt lgkmcnt(0)":::"memory");
    #pragma unroll
    for(int i=0;i<4;++i){const int row=i*8+(lane>>3),ch=lane&7; const u32x4 v=*(const u32x4*)(stg+row*64+ch*8); ATTN_STORE16(Ow+(long)row*PO+ch*8,v);} }
  asm volatile("s_waitcnt lgkmcnt(0)\n\ts_barrier":::"memory");
  #undef DMA_K
  #undef TROW
  #undef DMA_V
  #undef CMASK
  #undef START
  #undef RESC
  #undef ROT
}
constexpr int ATTN_LDS_BYTES=LDS_BYTES;
#undef SBAR
#undef WAIT_BAR
}

#define DPPF(v, ctrl) __builtin_bit_cast(float, __builtin_amdgcn_update_dpp(0, __builtin_bit_cast(int, (v)), (ctrl), 0xF, 0xF, false))
struct Args { const float* in[34]; float* out; unsigned char* ws; int ph_lo, ph_hi; };
enum { I_X = 0, I_C, I_CTX, I_CCTX, I_WADA, I_BADA, I_NMIX, I_NFFN, I_WIN, I_BIN, I_CONVW, I_CONVB, I_FW1, I_FB1, I_FW2, I_FB2, I_FW3, I_FB3, I_FFREQ, I_FOUT, I_SKIP,
       I_QNORM, I_KNORM, I_SINK, I_BNORM, I_WOUT, I_BOUT, I_WR, I_BR, I_W1, I_B1, I_W2, I_B2, I_NFINAL };

#define KARG_PTRS ((const void* const __attribute__((address_space(4)))*)__builtin_amdgcn_kernarg_segment_ptr())
__device__ __forceinline__ unsigned char* ws_ptr(const Args&) { int i = 35; asm volatile("" : "+s"(i)); return (unsigned char*)KARG_PTRS[i]; }
__device__ __forceinline__ bool in_range(const Args&, int k) { int i = 72; asm volatile("" : "+s"(i)); const int __attribute__((address_space(4)))* p = (const int __attribute__((address_space(4)))*)__builtin_amdgcn_kernarg_segment_ptr(); const int lo = p[i], hi = p[i + 1]; return lo <= k && k < hi; }
#define WSP(T, off) ((T*)(ws_ptr(A) + (off)))
__device__ __forceinline__ const float* inp_ptr(const Args&, int i) { asm volatile("" : "+s"(i)); return (const float*)KARG_PTRS[i]; }
#define INP(i) inp_ptr(A, (i))
__device__ __forceinline__ int lat_row(int i) { return (i >> 12) * TPB + (i & 4095); }
__device__ __forceinline__ int lat_tile(int i) { return (i >> 4) * 17 + (i & 15); }

struct SchedProj {
    const char* Ab; const char* Bb; int l, G, c;
    __device__ __forceinline__ bool next(int i, pg8::Unit& u) const {
        const int L = i * G + c;
        u.idx = i; if (l == 0) { if (L >= 136 * 8) return false; u.pm = L >> 3; u.pn = L & 7; return true; }
        if (L < 1024) { u.pm = lat_tile(L >> 3); u.pn = L & 7; return true; }
        const int j = L - 1024; if (j >= 24) return false;
        const int b = j / 3, q = j - 3 * b; u.pm = b * 17 + 16; u.pn = q == 0 ? 4 : (q == 1 ? 5 : 7); return true;
    }
    __device__ __forceinline__ const char* abase(const pg8::Unit& u) const { return Ab + (size_t)u.pm * (256 * 1024 * 2); }
    __device__ __forceinline__ const char* bbase(const pg8::Unit& u) const { return Bb + (size_t)u.pn * (256 * 1024 * 2); }
    __device__ __forceinline__ int arow_idx(int, int) const { return 0; }
};
struct EpiProj {
    static constexpr bool PERM = true; static constexpr int NDMA = 1;
    bf16* P; const float* bias;
    __device__ __forceinline__ const float* bias_src(const pg8::Unit& u, int lane, int) const { return bias + u.pn * 256 + 4 * lane; }
    __device__ __forceinline__ void operator()(const f32x4 (&acc)[2][2][4][2], const pg8::Unit& u, int wr, int wc, int fr, int fq, const LAS unsigned char* bl) const {
        const int row0 = u.pm * 256 + wr * 64 + fr, col0 = u.pn * 256 + wc * 32 + 8 * fq;
        f32x4 bv[2][2];
#pragma unroll
        for (int bj = 0; bj < 2; ++bj)
#pragma unroll
            for (int n = 0; n < 2; ++n) bv[bj][n] = *(const LAS f32x4*)(bl + (wc * 32 + 8 * fq + bj * 128 + 4 * n) * 4);
#pragma unroll
        for (int ai = 0; ai < 2; ++ai)
#pragma unroll
            for (int m = 0; m < 4; ++m) { bf16* rowp = P + (size_t)(row0 + ai * 128 + m * 16) * INW + col0;
#pragma unroll
                for (int bj = 0; bj < 2; ++bj) { const f32x4 v0 = acc[ai][bj][m][0] + bv[bj][0], v1 = acc[ai][bj][m][1] + bv[bj][1];
                    v4u w; w.x = pg8::cvt_pk_bf16(v0[0], v0[1]); w.y = pg8::cvt_pk_bf16(v0[2], v0[3]); w.z = pg8::cvt_pk_bf16(v1[0], v1[1]); w.w = pg8::cvt_pk_bf16(v1[2], v1[3]);
                    *(v4u*)(rowp + bj * 128) = w; } }
    }
};
struct SchedOut {
    const char* Ab; const char* Bb; int l, G, c;
    __device__ __forceinline__ bool next(int i, pg8::Unit& u) const {
        const int L = i * G + c;
        u.idx = i; if (l == 0) { if (L >= 136 * 4) return false; u.pm = L >> 2; u.pn = L & 3; return true; }
        if (L >= 128 * 4) return false; u.pm = lat_tile(L >> 2); u.pn = L & 3; return true;
    }
    __device__ __forceinline__ const char* abase(const pg8::Unit& u) const { return Ab + (size_t)u.pm * (256 * 1024 * 2); }
    __device__ __forceinline__ const char* bbase(const pg8::Unit& u) const { return Bb + (size_t)u.pn * (256 * 1024 * 2); }
    __device__ __forceinline__ int arow_idx(int, int) const { return 0; }
};
struct EpiOut {
    static constexpr bool PERM = true; static constexpr int NDMA = 2;
    bf16* X; const float* bias; const float* g1;
    const float* xin; const float* cin;
    __device__ __forceinline__ const float* bias_src(const pg8::Unit& u, int lane, int j) const {
        const int tb = u.pm / 17, tt = u.pm - 17 * tb, mi = (tt == 16) ? 8 : tb;
        return (j == 0 ? bias : g1 + mi * 6144) + u.pn * 256 + 4 * lane; }
    __device__ __forceinline__ void operator()(const f32x4 (&acc)[2][2][4][2], const pg8::Unit& u, int wr, int wc, int fr, int fq, const LAS unsigned char* bl) const {
        const int col0 = u.pn * 256 + wc * 32 + 8 * fq;
        const int tb = u.pm / 17, tt = u.pm - 17 * tb;
        bf16* db = X + (size_t)u.pm * 256 * DM;
        const float* sb = (tt == 16) ? cin + (size_t)tb * CTXL * DM : xin + ((size_t)tb * SEQ + tt * 256) * DM;
        f32x4 bv[2][2], gv[2][2];
#pragma unroll
        for (int bj = 0; bj < 2; ++bj)
#pragma unroll
            for (int n = 0; n < 2; ++n) { bv[bj][n] = *(const LAS f32x4*)(bl + (wc * 32 + 8 * fq + bj * 128 + 4 * n) * 4); gv[bj][n] = *(const LAS f32x4*)(bl + 1024 + (wc * 32 + 8 * fq + bj * 128 + 4 * n) * 4); }
#pragma unroll
        for (int ai = 0; ai < 2; ++ai)
#pragma unroll
          for (int mp = 0; mp < 2; ++mp) {
            f32x4 x0[2][2], x1[2][2];
            if (xin) {
#pragma unroll
                for (int mm = 0; mm < 2; ++mm)
#pragma unroll
                    for (int bj = 0; bj < 2; ++bj) { const int off = (wr * 64 + fr + ai * 128 + (2 * mp + mm) * 16) * DM + col0 + bj * 128; x0[mm][bj] = *(const f32x4*)(sb + off); x1[mm][bj] = *(const f32x4*)(sb + off + 4); }
            } else { v4u w_[2][2];
#pragma unroll
                for (int mm = 0; mm < 2; ++mm)
#pragma unroll
                    for (int bj = 0; bj < 2; ++bj) w_[mm][bj] = *(const v4u*)(db + (wr * 64 + fr + ai * 128 + (2 * mp + mm) * 16) * DM + col0 + bj * 128);
#pragma unroll
                for (int mm = 0; mm < 2; ++mm)
#pragma unroll
                    for (int bj = 0; bj < 2; ++bj) { const v4u w = w_[mm][bj]; x0[mm][bj] = (f32x4){bflo(w.x), bfhi(w.x), bflo(w.y), bfhi(w.y)}; x1[mm][bj] = (f32x4){bflo(w.z), bfhi(w.z), bflo(w.w), bfhi(w.w)}; }
            }
#pragma unroll
            for (int mm = 0; mm < 2; ++mm)
#pragma unroll
                for (int bj = 0; bj < 2; ++bj) { const int m = 2 * mp + mm; const int off = (wr * 64 + fr + ai * 128 + m * 16) * DM + col0 + bj * 128;
                    const f32x4 y0 = x0[mm][bj] + gv[bj][0] * (acc[ai][bj][m][0] + bv[bj][0]), y1 = x1[mm][bj] + gv[bj][1] * (acc[ai][bj][m][1] + bv[bj][1]);
                    v4u o; o.x = pg8::cvt_pk_bf16(y0[0], y0[1]); o.y = pg8::cvt_pk_bf16(y0[2], y0[3]); o.z = pg8::cvt_pk_bf16(y1[0], y1[1]); o.w = pg8::cvt_pk_bf16(y1[2], y1[3]);
                    *(v4u*)(db + off) = o; }
          }
    }
};
struct SchedMoe {
    const char* Ab; const char* Bb; const LAS int* rows; const LAS unsigned char* blkexp; int nblk, npn_shift, G, c; size_t bexp_stride;
    __device__ __forceinline__ bool next(int i, pg8::Unit& u) const {
        const int L = i * G + c; const int blk = L >> npn_shift; if (blk >= nblk) return false;
        u.pm = blk; u.pn = L & ((1 << npn_shift) - 1); u.idx = i; return true;
    }
    __device__ __forceinline__ int expert(const pg8::Unit& u) const { return __builtin_amdgcn_readfirstlane((int)blkexp[u.pm]); }
    __device__ __forceinline__ const char* abase(const pg8::Unit& u) const { return rows ? Ab : Ab + (size_t)u.pm * (256 * 1024); }
    __device__ __forceinline__ const char* bbase(const pg8::Unit& u) const { return Bb + (size_t)expert(u) * bexp_stride + (size_t)u.pn * (256 * 1024); }
    __device__ __forceinline__ int arow_idx(int idx, int r) const { return rows[idx * 256 + r]; }
};
__device__ __forceinline__ v4u pair16(v2u wm, v2u wn) {
    unsigned ax = wm.x, bx = wn.x, ay = wm.y, by = wn.y;
    asm volatile("s_nop 1\n\tv_permlane16_swap_b32 %0, %1" : "+v"(ax), "+v"(bx));
    asm volatile("s_nop 1\n\tv_permlane16_swap_b32 %0, %1" : "+v"(ay), "+v"(by));
    return (v4u){ax, ay, bx, by};
}
struct EpiGlu {
    static constexpr bool PERM = true; static constexpr int NDMA = 1;
    unsigned char* ACT; const float* b1; const SchedMoe* S; int dry;
    __device__ __forceinline__ const float* bias_src(const pg8::Unit& u, int lane, int) const {
        return b1 + S->expert(u) * 2048 + ((lane >> 5) << 10) + u.pn * 128 + 4 * (lane & 31); }
    __device__ __forceinline__ void operator()(const f32x4 (&acc)[2][2][4][2], const pg8::Unit& u, int wr, int wc, int fr, int fq, const LAS unsigned char* bls) const {
        if (dry) return;
        const int row0 = u.pm * 256 + wr * 64 + fr, j0 = u.pn * 128 + wc * 32 + 8 * fq;
        f32x4 bg[2], bl[2];
#pragma unroll
        for (int n = 0; n < 2; ++n) { bg[n] = *(const LAS f32x4*)(bls + (wc * 32 + 8 * fq + 4 * n) * 4); bl[n] = *(const LAS f32x4*)(bls + 512 + (wc * 32 + 8 * fq + 4 * n) * 4); }
#pragma unroll
        for (int ai = 0; ai < 2; ++ai)
#pragma unroll
            for (int mp = 0; mp < 2; ++mp) { v2u wv[2];
#pragma unroll
              for (int mm = 0; mm < 2; ++mm) { const int m = 2 * mp + mm;
                float o[8];
#pragma unroll
                for (int n = 0; n < 2; ++n) { const f32x4 g = acc[ai][0][m][n] + bg[n], li = acc[ai][1][m][n] + bl[n];
#pragma unroll
                    for (int q = 0; q < 4; q += 2) {
                        const f32x2 gl = (f32x2){fminf(g[q], 7.0f), fminf(g[q + 1], 7.0f)};
                        const f32x2 ln1 = (f32x2){__builtin_amdgcn_fmed3f(li[q], -7.0f, 7.0f), __builtin_amdgcn_fmed3f(li[q + 1], -7.0f, 7.0f)} + 1.0f;
                        const f32x2 ea = gl * (-1.702f * LOG2E);
                        const f32x2 den = (f32x2){__builtin_amdgcn_exp2f(ea.x), __builtin_amdgcn_exp2f(ea.y)} + 1.0f;
                        const f32x2 sg = (f32x2){__builtin_amdgcn_rcpf(den.x), __builtin_amdgcn_rcpf(den.y)};
                        const f32x2 r = (gl * sg) * ln1;
                        o[4 * n + q] = r.x; o[4 * n + q + 1] = r.y; } }
                wv[mm].x = cvt4_fp8(o[0], o[1], o[2], o[3]); wv[mm].y = cvt4_fp8(o[4], o[5], o[6], o[7]); }
              const v4u w16 = pair16(wv[0], wv[1]);
              const unsigned off = (unsigned)(row0 + ai * 128 + (2 * mp + (fq & 1)) * 16) * (unsigned)DM + (unsigned)(j0 - 8 * (fq & 1));
              *(v4u*)(ACT + off) = w16; }
    }
};
struct EpiOuts {
    static constexpr bool PERM = true; static constexpr int NDMA = 1;
    unsigned char* O; const float* b2; const SchedMoe* S; int dry;
    __device__ __forceinline__ const float* bias_src(const pg8::Unit& u, int lane, int) const { return b2 + S->expert(u) * 1024 + u.pn * 256 + 4 * lane; }
    __device__ __forceinline__ void operator()(const f32x4 (&acc)[2][2][4][2], const pg8::Unit& u, int wr, int wc, int fr, int fq, const LAS unsigned char* bl) const {
        if (dry) return;
        const int row0 = u.pm * 256 + wr * 64 + fr, col0 = u.pn * 256 + wc * 32 + 8 * fq;
        f32x4 bv[2][2];
#pragma unroll
        for (int bj = 0; bj < 2; ++bj)
#pragma unroll
            for (int n = 0; n < 2; ++n) bv[bj][n] = *(const LAS f32x4*)(bl + (wc * 32 + 8 * fq + bj * 128 + 4 * n) * 4);
#pragma unroll
        for (int ai = 0; ai < 2; ++ai)
#pragma unroll
            for (int mp = 0; mp < 2; ++mp)
#pragma unroll
                for (int bj = 0; bj < 2; ++bj) { v2u wv[2];
#pragma unroll
                    for (int mm = 0; mm < 2; ++mm) { const int m = 2 * mp + mm; const f32x4 v0 = acc[ai][bj][m][0] + bv[bj][0], v1 = acc[ai][bj][m][1] + bv[bj][1];
                        wv[mm].x = cvt4_fp8(v0[0], v0[1], v0[2], v0[3]); wv[mm].y = cvt4_fp8(v1[0], v1[1], v1[2], v1[3]); }
                    const v4u w16 = pair16(wv[0], wv[1]);
                    const unsigned off = (unsigned)(row0 + ai * 128 + (2 * mp + (fq & 1)) * 16) * (unsigned)DM + (unsigned)(col0 + bj * 128 - 8 * (fq & 1));
                    *(v4u*)(O + off) = w16; }
    }
};

constexpr int CV_SMALL = 1536, CV_MOE_L = 24576;
struct CvItem { const float* W; bf16* WT; int N, row0, k0, n0, f8; };
__device__ __forceinline__ CvItem cv_decode(const Args& A, int it) {
    CvItem c; int r = it;
    if (r < 1024) { const int l = r >> 9, q = r & 511, kb = q >> 5, nb = q & 31; c.f8 = 0; c.W = INP(I_WIN) + (size_t)l * 1024 * 2048; c.WT = WSP(bf16, WS_WINT) + (size_t)l * 2048 * 1024; c.N = 2048; c.row0 = 64 * nb; c.k0 = 64 * kb; c.n0 = 64 * nb; return c; }
    r -= 1024;
    if (r < 512) { const int l = r >> 8, q = r & 255, kb = q >> 4, nb = q & 15; c.f8 = 0; c.W = INP(I_WOUT) + (size_t)l * 1024 * 1024; c.WT = WSP(bf16, WS_WOUTT) + (size_t)l * 1024 * 1024; c.N = 1024; c.row0 = 64 * nb; c.k0 = 64 * kb; c.n0 = 64 * nb; return c; }
    r -= 512;
    const int l = r / CV_MOE_L; r -= l * CV_MOE_L;
    if (r < 16384) { const int le = l * 32 + (r >> 9), q = r & 511, kb = q >> 5, nb = q & 31, n0 = 64 * nb;
        c.f8 = 1; c.W = INP(I_W1) + (size_t)le * 1024 * 2048; c.WT = (bf16*)(WSP(unsigned char, WS_W1T) + (size_t)le * 2048 * 1024); c.N = 2048; c.k0 = 64 * kb; c.n0 = n0;
        c.row0 = (n0 < 1024) ? ((n0 >> 7) * 256 + (n0 & 127)) : ((((n0 - 1024) >> 7) * 256) + 128 + ((n0 - 1024) & 127)); return c; }
    r -= 16384;
    { const int le = l * 32 + (r >> 8), q = r & 255, kb = q >> 4, nb = q & 15; c.f8 = 1; c.W = INP(I_W2) + (size_t)le * 1024 * 1024; c.WT = (bf16*)(WSP(unsigned char, WS_W2T) + (size_t)le * 1024 * 1024); c.N = 1024; c.row0 = 64 * nb; c.k0 = 64 * kb; c.n0 = 64 * nb; return c; }
}
__device__ __forceinline__ void cv_load(const CvItem& c, float (&tv)[64], int lane) {
#pragma unroll
    for (int i = 0; i < 64; ++i) tv[i] = __builtin_nontemporal_load(c.W + (size_t)(c.k0 + i) * c.N + c.n0 + lane);
}
__device__ __forceinline__ void cv_store(const CvItem& c, const float (&tv)[64], LAS float*, int lane) {
    if (c.f8) { unsigned char* dst = (unsigned char*)c.WT + (size_t)(c.row0 + lane) * 1024 + c.k0;
#pragma unroll
        for (int j = 0; j < 4; ++j) { v4u o;
            o.x = cvt4_fp8(64.f * tv[16 * j + 0], 64.f * tv[16 * j + 1], 64.f * tv[16 * j + 2], 64.f * tv[16 * j + 3]);
            o.y = cvt4_fp8(64.f * tv[16 * j + 4], 64.f * tv[16 * j + 5], 64.f * tv[16 * j + 6], 64.f * tv[16 * j + 7]);
            o.z = cvt4_fp8(64.f * tv[16 * j + 8], 64.f * tv[16 * j + 9], 64.f * tv[16 * j + 10], 64.f * tv[16 * j + 11]);
            o.w = cvt4_fp8(64.f * tv[16 * j + 12], 64.f * tv[16 * j + 13], 64.f * tv[16 * j + 14], 64.f * tv[16 * j + 15]);
            *(v4u*)(dst + 16 * j) = o; }
    } else { bf16* dst = c.WT + (size_t)(c.row0 + lane) * 1024 + c.k0;
#pragma unroll
        for (int j = 0; j < 8; ++j) { v4u o; o.x = pk2(tv[8 * j + 0], tv[8 * j + 1]); o.y = pk2(tv[8 * j + 2], tv[8 * j + 3]); o.z = pk2(tv[8 * j + 4], tv[8 * j + 5]); o.w = pk2(tv[8 * j + 6], tv[8 * j + 7]);
            *(v4u*)(dst + 8 * j) = o; }
    }
}
__device__ __forceinline__ void cv_range(const Args& A, LAS unsigned char* lds, int lo, int hi, int wl, int nw) {
    const int tid = otid(), lane = tid & 63, wave = tid >> 6;
    LAS float* scr = (LAS float*)(lds + wave * 17408);
    int it = lo + wl;
    if (it >= hi) return;
    CvItem c0 = cv_decode(A, it), c1 = c0; float t0[64], t1[64];
    cv_load(c0, t0, lane);
    for (;;) {
        const int it1 = it + nw; const bool has1 = it1 < hi;
        if (has1) { c1 = cv_decode(A, it1); cv_load(c1, t1, lane); }
        cv_store(c0, t0, scr, lane);
        if (!has1) break;
        const int it2 = it1 + nw; const bool has2 = it2 < hi;
        if (has2) { c0 = cv_decode(A, it2); cv_load(c0, t0, lane); }
        cv_store(c1, t1, scr, lane);
        if (!has2) break;
        it = it2;
    }
}
constexpr int CVB_L = 3072;
struct CvBlk { const float* W; unsigned char* WT; int N, k0, n0, w1; };
__device__ __forceinline__ CvBlk cvb_decode(const Args& A, int b) {
    CvBlk c; const int l = b / CVB_L; int r = b - l * CVB_L;
    if (r < 2048) { const int le = l * 32 + (r >> 6), q = r & 63; c.w1 = 1; c.N = 2048; c.k0 = 128 * (q >> 3); c.n0 = 256 * (q & 7); c.W = INP(I_W1) + (size_t)le * 1024 * 2048; c.WT = WSP(unsigned char, WS_W1T) + (size_t)le * 2048 * 1024; }
    else { r -= 2048; const int le = l * 32 + (r >> 5), q = r & 31; c.w1 = 0; c.N = 1024; c.k0 = 128 * (q >> 2); c.n0 = 256 * (q & 3); c.W = INP(I_W2) + (size_t)le * 1024 * 1024; c.WT = WSP(unsigned char, WS_W2T) + (size_t)le * 1024 * 1024; }
    return c;
}
__device__ __forceinline__ void cvb_load(const CvBlk& c, f32x4 (&v)[16], int wave, int lane) {
    const float* p = c.W + (size_t)(c.k0 + 16 * wave) * c.N + c.n0 + 4 * lane;
#pragma unroll
    for (int i = 0; i < 16; ++i) v[i] = __builtin_nontemporal_load((const f32x4*)(p + (size_t)i * c.N));
}
__device__ __forceinline__ void cvb_stage(const f32x4 (&v)[16], LAS unsigned char* buf, int wave, int lane) {
#pragma unroll
    for (int j = 0; j < 4; ++j) { v4u o;
        o.x = cvt4_fp8(64.f * v[0][j], 64.f * v[1][j], 64.f * v[2][j], 64.f * v[3][j]); o.y = cvt4_fp8(64.f * v[4][j], 64.f * v[5][j], 64.f * v[6][j], 64.f * v[7][j]);
        o.z = cvt4_fp8(64.f * v[8][j], 64.f * v[9][j], 64.f * v[10][j], 64.f * v[11][j]); o.w = cvt4_fp8(64.f * v[12][j], 64.f * v[13][j], 64.f * v[14][j], 64.f * v[15][j]);
        *(LAS v4u*)(buf + (4 * lane + j) * 128 + ((wave ^ (lane & 7)) << 4)) = o; }
}
__device__ __forceinline__ void cvb_store(const CvBlk& c, const LAS unsigned char* buf, int tid) {
#pragma unroll
    for (int q = 0; q < 4; ++q) { const int p = tid + 512 * q, row = p >> 3, pc = p & 7; const v4u o = *(const LAS v4u*)(buf + row * 128 + ((pc ^ ((row >> 2) & 7)) << 4));
        const int n = c.n0 + row; const int orow = c.w1 ? ((n < 1024) ? ((n >> 7) * 256 + (n & 127)) : (((n - 1024) >> 7) * 256 + 128 + ((n - 1024) & 127))) : n;
        *(v4u*)(c.WT + (size_t)orow * 1024 + c.k0 + 16 * pc) = o; }
}
__device__ __forceinline__ void cv_blocks(const Args& A, LAS unsigned char* lds, int lo, int hi, int wgi, int nwg) {
    const int tid = otid(), lane = tid & 63, wave = tid >> 6;
    int b = lo + wgi;
    if (b >= hi) return;
    CvBlk c0 = cvb_decode(A, b), c1 = c0; f32x4 va[16], vb[16]; int par = 0;
    cvb_load(c0, va, wave, lane);
    for (;;) {
        const int b1 = b + nwg; const bool has1 = b1 < hi;
        if (has1) { c1 = cvb_decode(A, b1); cvb_load(c1, vb, wave, lane); }
        cvb_stage(va, lds + par * 32768, wave, lane); __syncthreads(); cvb_store(c0, lds + par * 32768, tid); par ^= 1;
        if (!has1) break;
        const int b2 = b1 + nwg; const bool has2 = b2 < hi;
        if (has2) { c0 = cvb_decode(A, b2); cvb_load(c0, va, wave, lane); }
        cvb_stage(vb, lds + par * 32768, wave, lane); __syncthreads(); cvb_store(c1, lds + par * 32768, tid); par ^= 1;
        if (!has2) break;
        b = b2;
    }
    __syncthreads();
}
__device__ __forceinline__ void ph_prologue(const Args& A, LAS unsigned char* lds, int G, int n_blocks) {
    const int tid = otid(), lane = tid & 63, wave = __builtin_amdgcn_readfirstlane(tid >> 6);
    for (int item = blockIdx.x; item < 192; item += G) {
        const int l = item / 96, jc = item % 96;
        LAS float* S = (LAS float*)lds;
        LAS float* R = S + 9 * 1024;
        for (int idx = tid; idx < 9 * 1024; idx += 512) { const int i = idx >> 10, k = idx & 1023; const float v = (i < 8) ? INP(I_C)[i * 1024 + k] : INP(I_CCTX)[k]; S[idx] = v / (1.0f + __expf(-v)); }
        __syncthreads();
        const int c4 = tid & 15, kg = tid >> 4;
        float acc[9][4];
#pragma unroll
        for (int i = 0; i < 9; ++i) { acc[i][0] = 0.f; acc[i][1] = 0.f; acc[i][2] = 0.f; acc[i][3] = 0.f; }
        const float* w = INP(I_WADA) + (size_t)l * 1024 * 6144 + jc * 64 + 4 * c4;
#pragma unroll 16
        for (int kk = 0; kk < 32; ++kk) { const int k = kg + 32 * kk; const f32x4 wv = *(const f32x4*)(w + (size_t)k * 6144);
#pragma unroll
            for (int i = 0; i < 9; ++i) { const float sv = S[i * 1024 + k]; acc[i][0] += sv * wv.x; acc[i][1] += sv * wv.y; acc[i][2] += sv * wv.z; acc[i][3] += sv * wv.w; } }
#pragma unroll
        for (int i = 0; i < 9; ++i) *(LAS f32x4*)(R + (kg * 9 + i) * 64 + 4 * c4) = (f32x4){acc[i][0], acc[i][1], acc[i][2], acc[i][3]};
        __syncthreads();
        for (int idx = tid; idx < 9 * 64; idx += 512) { const int i = idx >> 6, cc = idx & 63; float s = INP(I_BADA)[l * 6144 + jc * 64 + cc];
#pragma unroll
            for (int q = 0; q < 32; ++q) s += R[(q * 9 + i) * 64 + cc];
            WSP(float, WS_MOD)[(l * 9 + i) * 6144 + jc * 64 + cc] = s; }
        __syncthreads();
    }
    for (int gi = (int)blockIdx.x * 512 + tid; gi < 2 * 32768; gi += G * 512) { const int l = gi >> 15, r = gi & 32767, k = r >> 5, e = r & 31;
        WSP(float, WS_WRT)[l * 32768 + e * 1024 + k] = INP(I_WR)[(size_t)l * 32768 + r]; }
    if (blockIdx.x == G - 1) {
        for (int idx = tid; idx < 1024; idx += 512) { const int pos = idx >> 4, f = idx & 15; const float inv = powf(10000.0f, -(float)f / 16.0f); const float ang = (float)pos * inv;
            WSP(float, WS_ROPE)[idx * 2] = cosf(ang); WSP(float, WS_ROPE)[idx * 2 + 1] = sinf(ang); }
    }
    for (int item = G - 1 - (int)blockIdx.x; item < 264; item += G) {
        int l, n, chunk;
        if (item < 128) { l = 0; n = 4096; chunk = item; } else if (item < 256) { l = 1; n = 4096; chunk = item - 128; } else { l = 0; n = 256; chunk = item - 256; }
        const int i0 = chunk * 32;
        const float* w1 = INP(I_FW1) + l * 33 * 64; const float* b1 = INP(I_FB1) + l * 64; const float* w2 = INP(I_FW2) + l * 4096; const float* b2 = INP(I_FB2) + l * 64;
        const float* w3 = INP(I_FW3) + l * 4096; const float* b3 = INP(I_FB3) + l * 64; const float* fr = INP(I_FFREQ) + l * 64; const float* wo = INP(I_FOUT) + l * 64 * 512;
        LAS float* zf = (LAS float*)lds; LAS float* ha = zf + 1056; LAS float* hb = ha + 2048; LAS float* outs = hb + 2048;
        LAS float* w1s = outs + 32 * 512; LAS float* w2s = w1s + 33 * 64; LAS float* w3s = w2s + 4096; LAS float* bfs = w3s + 4096;
        { float a_[5], b_[8], c_[8];
#pragma unroll
          for (int q = 0; q < 5; ++q) a_[q] = (tid + 512 * q < 33 * 64) ? w1[tid + 512 * q] : 0.f;
#pragma unroll
          for (int q = 0; q < 8; ++q) { b_[q] = w2[tid + 512 * q]; c_[q] = w3[tid + 512 * q]; }
#pragma unroll
          for (int q = 0; q < 5; ++q) if (tid + 512 * q < 33 * 64) w1s[tid + 512 * q] = a_[q];
#pragma unroll
          for (int q = 0; q < 8; ++q) { w2s[tid + 512 * q] = b_[q]; w3s[tid + 512 * q] = c_[q]; } }
        if (tid < 64) { bfs[tid] = b1[tid]; bfs[64 + tid] = b2[tid]; bfs[128 + tid] = b3[tid]; bfs[192 + tid] = fr[tid]; }
        for (int idx = tid; idx < 32 * 33; idx += 512) { const int p = idx / 33, f = idx - 33 * p, i = i0 + p;
            const float tt = (float)i / (float)(n - 1), wpos = (6.283185307179586f / (float)n) * (float)i;
            float v;
            if (f == 0) v = tt; else { const int jb = (f - 1) & 15; const float band = 1e-4f + (float)jb * ((15.0f - 1e-4f) / 15.0f); const float a = wpos * band; v = (f <= 16) ? cosf(a) : -sinf(a); }
            zf[idx] = v; }
        __syncthreads();
        { const int j = tid & 63, pq = tid >> 6;
          { float wc[33];
#pragma unroll
            for (int f = 0; f < 33; ++f) wc[f] = w1s[f * 64 + j];
#pragma unroll
            for (int q = 0; q < 4; ++q) { const int p = pq + 8 * q; float s = bfs[j];
#pragma unroll
                for (int f = 0; f < 33; ++f) s += zf[p * 33 + f] * wc[f];
                ha[p * 64 + j] = sinf(bfs[192 + j] * s); } }
          __syncthreads();
#pragma unroll 1
          for (int ly = 0; ly < 2; ++ly) { const LAS float* ws_ = ly ? w3s : w2s; const LAS float* hi_ = ly ? hb : ha; LAS float* ho_ = ly ? ha : hb;
            float wc[64];
#pragma unroll
            for (int f = 0; f < 64; ++f) wc[f] = ws_[f * 64 + j];
#pragma unroll
            for (int q = 0; q < 4; ++q) { const int p = pq + 8 * q; float s0 = bfs[64 + 64 * ly + j], s1 = 0.f;
#pragma unroll
                for (int f = 0; f < 64; f += 4) { const f32x4 h4 = *(const LAS f32x4*)(hi_ + p * 64 + f); s0 += h4.x * wc[f]; s1 += h4.y * wc[f + 1]; s0 += h4.z * wc[f + 2]; s1 += h4.w * wc[f + 3]; }
                ho_[p * 64 + j] = sinf(bfs[192 + j] * (s0 + s1)); }
            __syncthreads(); }
        }
        {   const int o = tid, c = o & 255, kind = o >> 8;
            const float delta = 3.0701134573253945f + (float)c * ((15.350567286626973f - 3.0701134573253945f) / 255.0f);
            float wv[64];
#pragma unroll
            for (int j = 0; j < 64; ++j) wv[j] = wo[j * 512 + o];
            bf16* gb = WSP(bf16, WS_GB) + (size_t)(l * 256 + c) * 8192;
            float* gc = WSP(float, WS_GC) + c * 512;
#pragma unroll 1
            for (int k = 0; k < 4; ++k) {
                float ov[8];
#pragma unroll
                for (int m = 0; m < 8; ++m) { const int p = kind == 0 ? 8 * k + m : 31 - 8 * k - m; float a0 = 0.f, a1 = 0.f;
#pragma unroll
                    for (int j = 0; j < 64; j += 4) { const f32x4 h4 = *(const LAS f32x4*)(ha + p * 64 + j); a0 += h4.x * wv[j]; a1 += h4.y * wv[j + 1]; a0 += h4.z * wv[j + 2]; a1 += h4.w * wv[j + 3]; }
                    const float tt = (float)(i0 + p) / (float)(n - 1); ov[m] = (a0 + a1) * __expf(-tt * delta);
                    if (n != 4096) { const int i = i0 + p; gc[kind == 0 ? 256 + i : 255 - i] = ov[m]; }
                    __builtin_amdgcn_sched_barrier(0); }
                if (n == 4096) ((v4u*)(gb + (kind == 0 ? 4096 + i0 : 4064 - i0)))[k] = (v4u){pk2(ov[0], ov[1]), pk2(ov[2], ov[3]), pk2(ov[4], ov[5]), pk2(ov[6], ov[7])};
            }
            if (n == 4096) { if (chunk == 127 && kind == 1) gb[0] = 0; }
            else if (chunk == 7 && kind == 1) gc[0] = 0.f;
        }
        __syncthreads();
    }
    __syncthreads();
    cv_range(A, lds, 0, CV_SMALL, (int)blockIdx.x * 8 + wave, G * 8);
    __syncthreads();
    cv_blocks(A, lds, 0, n_blocks, (int)blockIdx.x, G);
}

struct RowV { f32x4 v[4]; };
__device__ __forceinline__ float row_ssq(const RowV& r) { float s = 0.f;
#pragma unroll
    for (int j = 0; j < 4; ++j) s += (r.v[j].x * r.v[j].x + r.v[j].y * r.v[j].y) + (r.v[j].z * r.v[j].z + r.v[j].w * r.v[j].w);
    return wave_sum(s); }
__device__ __forceinline__ void row_modulate(const RowV& x, float rs, const float* nw, const float* sh, const float* sc, int lane, RowV& h) {
#pragma unroll
    for (int j = 0; j < 4; ++j) { const f32x4 w = ((const f32x4*)nw)[lane + 64 * j], s = ((const f32x4*)sc)[lane + 64 * j], t = ((const f32x4*)sh)[lane + 64 * j];
        h.v[j] = (x.v[j] * rs * w) * (s + 1.0f) + t; }
}
__device__ __forceinline__ void row_load_bf16(RowV& x, const bf16* src, int lane) {
#pragma unroll
    for (int j = 0; j < 4; ++j) { const v2u w = ((const v2u*)src)[lane + 64 * j]; x.v[j] = (f32x4){bflo(w.x), bfhi(w.x), bflo(w.y), bfhi(w.y)}; }
}
__device__ __forceinline__ void row_store_bf16(const RowV& h, bf16* dst, int lane) {
#pragma unroll
    for (int j = 0; j < 4; ++j) { v2u o; o.x = pk2(h.v[j].x, h.v[j].y); o.y = pk2(h.v[j].z, h.v[j].w); ((v2u*)dst)[lane + 64 * j] = o; }
}
template <int NR>
__device__ __forceinline__ void row_combine(RowV (&x)[NR], const Args& A, int l, const int (&r)[NR], const int (&mi)[NR], int lane) {
    int slot[NR][4]; float g[NR][4];
#pragma unroll
    for (int q = 0; q < NR; ++q) { const int* ts = WSP(int, WS_TOKSLOT) + r[q] * 4; const float* tg = WSP(float, WS_TOPG) + r[q] * 4;
#pragma unroll
        for (int k = 0; k < 4; ++k) { slot[q][k] = ts[k]; g[q][k] = tg[k]; } }
    int w[NR][4][4];
#pragma unroll
    for (int q = 0; q < NR; ++q)
#pragma unroll
        for (int k = 0; k < 4; ++k) { const int* src = (const int*)(WSP(unsigned char, WS_OUTS) + (size_t)slot[q][k] * DM);
#pragma unroll
            for (int j = 0; j < 4; ++j) w[q][k][j] = src[lane + 64 * j]; }
#pragma unroll
    for (int q = 0; q < NR; ++q) { const float* g2 = WSP(float, WS_MOD) + (l * 9 + mi[q]) * 6144 + 5120;
#pragma unroll
        for (int j = 0; j < 4; ++j) { f32x4 y = (f32x4){0.f, 0.f, 0.f, 0.f};
#pragma unroll
            for (int k = 0; k < 4; ++k) { const int ww = w[q][k][j]; const float gg = g[q][k];
                y.x += gg * __builtin_amdgcn_cvt_f32_fp8(ww, 0); y.y += gg * __builtin_amdgcn_cvt_f32_fp8(ww, 1); y.z += gg * __builtin_amdgcn_cvt_f32_fp8(ww, 2); y.w += gg * __builtin_amdgcn_cvt_f32_fp8(ww, 3); }
            x[q].v[j] = x[q].v[j] + ((const f32x4*)g2)[lane + 64 * j] * y; } }
}
__device__ __forceinline__ void ph_rowpass_a(const Args& A, int l, int G) {
    const int tid = otid(), lane = tid & 63, wave = tid >> 6, gw = blockIdx.x * 8 + wave, NGW = G * 8;
    for (int i = blockIdx.x * 512 + tid; i < NSLOT_MAX; i += G * 512) WSP(int, WS_SLOTTOK)[i] = MROWS;
    if (blockIdx.x == 0) { for (int i = tid; i < 512; i += 512) ((unsigned*)(WSP(bf16, WS_H) + (size_t)MROWS * DM))[i] = 0u; }
    bf16* X = WSP(bf16, WS_X); bf16* H = WSP(bf16, WS_H);
    constexpr int NR = 2;
    for (int r0 = gw * NR; r0 < MROWS; r0 += NGW * NR) {
        int r[NR], mi[NR]; RowV x[NR];
#pragma unroll
        for (int q = 0; q < NR; ++q) { r[q] = r0 + q; const int b = r[q] / TPB, t = r[q] - b * TPB; mi[q] = (t < SEQ) ? b : 8;
            if (l == 0) { const float* src = (t < SEQ) ? INP(I_X) + ((size_t)b * SEQ + t) * DM : INP(I_CTX) + ((size_t)b * CTXL + (t - SEQ)) * DM;
#pragma unroll
                for (int j = 0; j < 4; ++j) x[q].v[j] = ((const f32x4*)src)[lane + 64 * j];
            } else row_load_bf16(x[q], X + (size_t)r[q] * DM, lane); }
        if (l != 0) { row_combine<NR>(x, A, 0, r, mi, lane);
#pragma unroll
            for (int q = 0; q < NR; ++q) row_store_bf16(x[q], X + (size_t)r[q] * DM, lane); }
#pragma unroll
        for (int q = 0; q < NR; ++q) {
            const float rs = rsqrtf(row_ssq(x[q]) * (1.0f / DM) + EPSN);
            const float* mod = WSP(float, WS_MOD) + (l * 9 + mi[q]) * 6144;
            RowV h; row_modulate(x[q], rs, INP(I_NMIX) + l * DM, mod, mod + 1024, lane, h);
            row_store_bf16(h, H + (size_t)r[q] * DM, lane); }
    }
}
__device__ __forceinline__ void ph_final(const Args& A, int G) {
    const int tid = otid(), lane = tid & 63, wave = tid >> 6, gw = blockIdx.x * 8 + wave, NGW = G * 8;
    const bf16* X = WSP(bf16, WS_X);
    constexpr int NR = 2;
    f32x4 nf[4];
#pragma unroll
    for (int j = 0; j < 4; ++j) nf[j] = ((const f32x4*)INP(I_NFINAL))[lane + 64 * j];
    for (int i0 = gw * NR; i0 < NB * SEQ; i0 += NGW * NR) {
        int r[NR], mi[NR]; RowV x[NR];
#pragma unroll
        for (int q = 0; q < NR; ++q) { r[q] = lat_row(i0 + q); mi[q] = (i0 + q) >> 12; row_load_bf16(x[q], X + (size_t)r[q] * DM, lane); }
        row_combine<NR>(x, A, 1, r, mi, lane);
#pragma unroll
        for (int q = 0; q < NR; ++q) {
            const float rs = rsqrtf(row_ssq(x[q]) * (1.0f / DM) + EPSN);
            float* dst = (float*)inp_ptr(A, 34) + (size_t)(i0 + q) * DM;
#pragma unroll
            for (int j = 0; j < 4; ++j) ((f32x4*)dst)[lane + 64 * j] = x[q].v[j] * rs * nf[j]; }
    }
}
__device__ __forceinline__ float swap32_sum(float a, float b) { asm volatile("s_nop 1\n\tv_permlane32_swap_b32 %0, %1" : "+v"(a), "+v"(b)); return a + b; }
__device__ __forceinline__ float swap32_max(float a, float b) { asm volatile("s_nop 1\n\tv_permlane32_swap_b32 %0, %1" : "+v"(a), "+v"(b)); return fmaxf(a, b); }
__device__ __forceinline__ float wave_max_all(float x) {
    x = fmaxf(x, DPPF(x, 0xB1)); x = fmaxf(x, DPPF(x, 0x4E)); x = fmaxf(x, DPPF(x, 0x141)); x = fmaxf(x, DPPF(x, 0x140));
    x = fmaxf(x, shflx(x, 16));
    return swap32_max(x, x);
}
__device__ __forceinline__ float wave_sum_all(float x) {
    x += DPPF(x, 0xB1); x += DPPF(x, 0x4E); x += DPPF(x, 0x141); x += DPPF(x, 0x140);
    x += shflx(x, 16);
    return swap32_sum(x, x);
}
constexpr int RG = 2, RGS = 1;
__device__ __forceinline__ void g_tiles(int l, int G, int& t_lo, int& tcnt) {
    const int ntiles = ((l == 0) ? MROWS : NB * SEQ) >> 4, tq = ntiles / G, trem = ntiles - tq * G, bx = (int)blockIdx.x;
    t_lo = bx * tq + (bx < trem ? bx : trem); tcnt = tq + (bx < trem ? 1 : 0);
}
__device__ __forceinline__ void split_bf(float x, unsigned& hi, unsigned& lo) { hi = f2bf(x); lo = f2bf(x - __builtin_bit_cast(float, hi << 16)); }
__device__ __forceinline__ void ph_rowpass_g(const Args& A, LAS unsigned char* lds, int l, int G) {
    const int tid = otid(), lane = tid & 63, wave = __builtin_amdgcn_readfirstlane(tid >> 6);
    constexpr int ROWP = 2048 + 16, LO_OFF = 16 * ROWP, P_OFF = 2 * LO_OFF;
    LAS int* hist = (LAS int*)(lds + LDSX_OFF);
    __syncthreads();
    if (tid < 32) hist[tid] = 0;
    bf16x8 bh[4][2], bl[4][2];
    { const float* wt = WSP(float, WS_WRT) + l * 32768;
#pragma unroll
      for (int s_ = 0; s_ < 4; ++s_)
#pragma unroll
          for (int t_ = 0; t_ < 2; ++t_) { const float* wp = wt + (16 * t_ + (lane & 15)) * 1024 + 128 * wave + 32 * s_ + 8 * (lane >> 4);
              const f32x4 w0 = ((const f32x4*)wp)[0], w1 = ((const f32x4*)wp)[1]; unsigned h_[8], l_[8];
              split_bf(w0.x, h_[0], l_[0]); split_bf(w0.y, h_[1], l_[1]); split_bf(w0.z, h_[2], l_[2]); split_bf(w0.w, h_[3], l_[3]);
              split_bf(w1.x, h_[4], l_[4]); split_bf(w1.y, h_[5], l_[5]); split_bf(w1.z, h_[6], l_[6]); split_bf(w1.w, h_[7], l_[7]);
              bh[s_][t_] = __builtin_bit_cast(bf16x8, (v4u){h_[0] | (h_[1] << 16), h_[2] | (h_[3] << 16), h_[4] | (h_[5] << 16), h_[6] | (h_[7] << 16)});
              bl[s_][t_] = __builtin_bit_cast(bf16x8, (v4u){l_[0] | (l_[1] << 16), l_[2] | (l_[3] << 16), l_[4] | (l_[5] << 16), l_[6] | (l_[7] << 16)}); } }
    __syncthreads();
    const bf16* X = WSP(bf16, WS_X); unsigned char* H8 = WSP(unsigned char, WS_H8);
    if (blockIdx.x == 0 && tid < 256) ((unsigned*)(H8 + (size_t)MROWS * DM))[tid] = 0u;
    const float brl = INP(I_BR)[l * 32 + (lane >> 1)];
    const float* nffn = INP(I_NFFN) + l * DM;
    int t_lo, tcnt; g_tiles(l, G, t_lo, tcnt);
    int mi_cur = -1; f32x4 am[4], shv[4]; v2u w_[2][4];
    if (tcnt > 0) { const int i0 = t_lo * 16 + 2 * wave, r0 = (l == 0) ? i0 : lat_row(i0); const v2u* xp = (const v2u*)(X + (size_t)r0 * DM) + lane;
#pragma unroll
        for (int q = 0; q < 2; ++q)
#pragma unroll
            for (int j = 0; j < 4; ++j) w_[q][j] = xp[256 * q + 64 * j]; }
#pragma unroll 1
    for (int it = 0; it < tcnt; ++it) {
        const int tile = t_lo + it;
        const int i0 = tile * 16 + 2 * wave;
        const int r0 = (l == 0) ? i0 : lat_row(i0);
        const int b = r0 / TPB, t = r0 - b * TPB, mi = (t < SEQ) ? b : 8;
        if (mi != mi_cur) { mi_cur = mi; const float* mod = WSP(float, WS_MOD) + (l * 9 + mi) * 6144;
#pragma unroll
            for (int j = 0; j < 4; ++j) { const f32x4 wv = ((const f32x4*)nffn)[lane + 64 * j], sc = ((const f32x4*)(mod + 4096))[lane + 64 * j]; shv[j] = ((const f32x4*)(mod + 3072))[lane + 64 * j]; am[j] = wv * (sc + 1.0f); } }
        RowV h[2];
#pragma unroll
        for (int q = 0; q < 2; ++q)
#pragma unroll
            for (int j = 0; j < 4; ++j) h[q].v[j] = (f32x4){bflo(w_[q][j].x), bfhi(w_[q][j].x), bflo(w_[q][j].y), bfhi(w_[q][j].y)};
        if (it + 1 < tcnt) { const int i1 = (tile + 1) * 16 + 2 * wave, r1 = (l == 0) ? i1 : lat_row(i1); const v2u* xp = (const v2u*)(X + (size_t)r1 * DM) + lane;
#pragma unroll
            for (int q = 0; q < 2; ++q)
#pragma unroll
                for (int j = 0; j < 4; ++j) w_[q][j] = xp[256 * q + 64 * j]; }
        float rs[2];
#pragma unroll
        for (int q = 0; q < 2; ++q) { float s = 0.f;
#pragma unroll
            for (int j = 0; j < 4; ++j) s += (h[q].v[j].x * h[q].v[j].x + h[q].v[j].y * h[q].v[j].y) + (h[q].v[j].z * h[q].v[j].z + h[q].v[j].w * h[q].v[j].w);
            rs[q] = rsqrtf(wave_sum_all(s) * (1.0f / DM) + EPSN); }
#pragma unroll
        for (int j = 0; j < 4; ++j)
#pragma unroll
            for (int q = 0; q < 2; ++q) h[q].v[j] = (h[q].v[j] * rs[q]) * am[j] + shv[j];
#pragma unroll
        for (int q = 0; q < 2; ++q) { unsigned* hp = (unsigned*)(H8 + (size_t)(r0 + q) * DM);
            LAS unsigned char* th = lds + (2 * wave + q) * ROWP;
#pragma unroll
            for (int j = 0; j < 4; ++j) { hp[lane + 64 * j] = cvt4_fp8(h[q].v[j].x, h[q].v[j].y, h[q].v[j].z, h[q].v[j].w);
                unsigned h0, l0, h1, l1, h2, l2, h3, l3; split_bf(h[q].v[j].x, h0, l0); split_bf(h[q].v[j].y, h1, l1); split_bf(h[q].v[j].z, h2, l2); split_bf(h[q].v[j].w, h3, l3);
                *(LAS v2u*)(th + (4 * lane + 256 * j) * 2) = (v2u){h0 | (h1 << 16), h2 | (h3 << 16)};
                *(LAS v2u*)(th + LO_OFF + (4 * lane + 256 * j) * 2) = (v2u){l0 | (l1 << 16), l2 | (l3 << 16)}; } }
        __syncthreads();
        {   f32x4 acc[2] = {(f32x4){0.f, 0.f, 0.f, 0.f}, (f32x4){0.f, 0.f, 0.f, 0.f}};
            const LAS unsigned char* ap = lds + (lane & 15) * ROWP + (128 * wave + 8 * (lane >> 4)) * 2;
#pragma unroll
            for (int s_ = 0; s_ < 4; ++s_) { const bf16x8 ah = *(const LAS bf16x8*)(ap + 64 * s_), al = *(const LAS bf16x8*)(ap + LO_OFF + 64 * s_);
#pragma unroll
                for (int t_ = 0; t_ < 2; ++t_) { acc[t_] = __builtin_amdgcn_mfma_f32_16x16x32_bf16(ah, bh[s_][t_], acc[t_], 0, 0, 0); acc[t_] = __builtin_amdgcn_mfma_f32_16x16x32_bf16(ah, bl[s_][t_], acc[t_], 0, 0, 0);
                    acc[t_] = __builtin_amdgcn_mfma_f32_16x16x32_bf16(al, bh[s_][t_], acc[t_], 0, 0, 0); } }
#pragma unroll
            for (int t_ = 0; t_ < 2; ++t_) *(LAS f32x4*)(lds + P_OFF + ((wave * 32 + 16 * t_ + (lane & 15)) * 16 + 4 * (lane >> 4)) * 4) = acc[t_];
        }
        __syncthreads();
#pragma unroll
        for (int q = 0; q < 2; ++q) {
            float lg = brl;
#pragma unroll
            for (int w_ = 0; w_ < 8; ++w_) lg += *(const LAS float*)(lds + P_OFF + ((w_ * 32 + (lane >> 1)) * 16 + 2 * wave + q) * 4);
            int bi[4]; float bv[4];
#pragma unroll
            for (int k = 0; k < 4; ++k) { const float m = wave_max_all(lg); const unsigned long long bal = __ballot(lg == m); const int fl = (int)__builtin_ctzll(bal);
                bi[k] = fl >> 1; bv[k] = m; if ((lane >> 1) == (fl >> 1)) lg = -INFINITY; }
            const float e1 = __expf(bv[1] - bv[0]), e2 = __expf(bv[2] - bv[0]), e3 = __expf(bv[3] - bv[0]); const float inv = 1.0f / (1.0f + e1 + e2 + e3);
            if (lane == 0) { const int r = r0 + q;
                int* ti = WSP(int, WS_TOPI) + r * 4; float* tg = WSP(float, WS_TOPG) + r * 4;
                ti[0] = bi[0]; ti[1] = bi[1]; ti[2] = bi[2]; ti[3] = bi[3]; tg[0] = inv; tg[1] = e1 * inv; tg[2] = e2 * inv; tg[3] = e3 * inv;
#pragma unroll
                for (int k = 0; k < 4; ++k) atomicAdd((int*)&hist[bi[k]], 1); }
        }
    }
    __syncthreads();
    if (tid < 32) WSP(int, WS_HIST)[(l * 256 + blockIdx.x) * 32 + tid] = hist[tid];
    __syncthreads();
}
__device__ __forceinline__ void ph_route(const Args& A, LAS unsigned char* lds, int l, int G) {
    const int tid = otid(), lane = tid & 63, wave = tid >> 6, gw = blockIdx.x * 8 + wave, NGW = G * 8;
    LAS int* tot = (LAS int*)(lds + LDSX_OFF); LAS int* off = tot + 32; LAS int* pst = off + 32; LAS int* cur = pst + 40;
    {
        LAS int* hb = (LAS int*)lds; const int* hs = WSP(int, WS_HIST) + l * 256 * 32;
        __syncthreads();
        { int t_[16];
#pragma unroll
          for (int q = 0; q < 16; ++q) t_[q] = (tid + 512 * q < G * 32) ? hs[tid + 512 * q] : 0;
#pragma unroll
          for (int q = 0; q < 16; ++q) if (tid + 512 * q < G * 32) hb[tid + 512 * q] = t_[q]; }
        __syncthreads();
        if (tid < 32) { int s = 0, my = 0;
            for (int w = 0; w < G; ++w) { if (w == (int)blockIdx.x) my = s; s += hb[w * 32 + tid]; }
            tot[tid] = s; off[tid] = my; cur[tid] = 0; }
    }
    __syncthreads();
    if (tid == 0) { int p = 0; for (int e = 0; e < 32; ++e) { pst[e] = p; p += ((tot[e] + 255) >> 8) << 8; } pst[32] = p; }
    __syncthreads();
    if (blockIdx.x == 0 && tid < 34) WSP(int, WS_EXPST)[l * 64 + tid] = (tid < 33) ? pst[tid] : (pst[32] >> 8);
    int t_lo, tcnt; g_tiles(l, G, t_lo, tcnt);
    for (int p = tid; p < tcnt * 64; p += 512) { const int i = t_lo * 16 + (p >> 2), k = p & 3, r = (l == 0) ? i : lat_row(i);
        const int e = WSP(int, WS_TOPI)[r * 4 + k]; const int pos = atomicAdd((int*)&cur[e], 1); const int slot = pst[e] + off[e] + pos;
        WSP(int, WS_SLOTTOK)[slot] = r; WSP(int, WS_TOKSLOT)[r * 4 + k] = slot; }
    __syncthreads();
}
__device__ __forceinline__ int moe_table(const Args& A, LAS unsigned char* lds, int l) {
    const int tid = otid(); LAS int* pst = (LAS int*)(lds + LDSX_OFF); LAS unsigned char* be = (LAS unsigned char*)(lds + LDSX_OFF + 1024);
    if (tid < 34) pst[tid] = WSP(int, WS_EXPST)[l * 64 + tid];
    __syncthreads();
    const int nblk = pst[33];
    for (int bk = tid; bk < nblk; bk += 512) { int e = 0; for (int q = 1; q < 32; ++q) e += (pst[q] <= bk * 256) ? 1 : 0; be[bk] = (unsigned char)e; }
    __syncthreads();
    return __builtin_amdgcn_readfirstlane(nblk);
}

__device__ __forceinline__ void ph_post(const Args& A, LAS unsigned char* lds, int l, int G) {
    const int tid = otid(), lane = tid & 63, wave = tid >> 6, gw = blockIdx.x * 8 + wave, NGW = G * 8;
    bf16* P = WSP(bf16, WS_P);
    {
        const int hd = lane >> 2, part = lane & 3;
        const int cb = (hd < 6) ? COL_GAQ + 64 * hd : (hd < 8) ? COL_GAK + 64 * (hd - 6) : (hd < 14) ? COL_WAQ + 64 * (hd - 8) : COL_WAK + 64 * (hd - 14);
        const bool isq = (hd < 6) || (hd >= 8 && hd < 14), donorm = hd < 8;
        const float* nw = (hd < 6) ? INP(I_QNORM) + l * 64 : INP(I_KNORM) + l * 64;
        float nwv[16];
#pragma unroll
        for (int k = 0; k < 4; ++k) { const f32x4 t4 = ((const f32x4*)(nw + 16 * part))[k]; nwv[4 * k] = t4.x; nwv[4 * k + 1] = t4.y; nwv[4 * k + 2] = t4.z; nwv[4 * k + 3] = t4.w; }
        const float* rope = WSP(float, WS_ROPE);
        constexpr int NR = 2;
        for (int r0 = gw * NR; r0 < MROWS; r0 += NGW * NR) {
            v4u w0[NR], w1[NR]; v2u vv[NR]; bf16* p[NR]; int bq[NR], tq[NR];
            const int vc = 4 * lane, vsel = vc >> 7, vkvh = (vc >> 6) & 1, vd = vc & 63;
#pragma unroll
            for (int q = 0; q < NR; ++q) { const int r = r0 + q; bq[q] = r / TPB; tq[q] = r - bq[q] * TPB; p[q] = P + (size_t)r * INW + cb + 16 * part;
                w0[q] = ((const v4u*)p[q])[0]; w1[q] = ((const v4u*)p[q])[1]; vv[q] = *(const v2u*)(P + (size_t)r * INW + (vsel ? COL_WAV : COL_GAV) + 64 * vkvh + vd); }
#pragma unroll
            for (int q = 0; q < NR; ++q) { const int b = bq[q], t = tq[q];
                float v[16];
                v[0] = bflo(w0[q].x); v[1] = bfhi(w0[q].x); v[2] = bflo(w0[q].y); v[3] = bfhi(w0[q].y); v[4] = bflo(w0[q].z); v[5] = bfhi(w0[q].z); v[6] = bflo(w0[q].w); v[7] = bfhi(w0[q].w);
                v[8] = bflo(w1[q].x); v[9] = bfhi(w1[q].x); v[10] = bflo(w1[q].y); v[11] = bfhi(w1[q].y); v[12] = bflo(w1[q].z); v[13] = bfhi(w1[q].z); v[14] = bflo(w1[q].w); v[15] = bfhi(w1[q].w);
                if (donorm) { float ss = 0.f;
#pragma unroll
                    for (int i = 0; i < 16; ++i) ss += v[i] * v[i];
                    ss += DPPF(ss, 0xB1); ss += DPPF(ss, 0x4E);
                    const float rs = rsqrtf(ss * (1.0f / 64.0f) + EPSN);
#pragma unroll
                    for (int i = 0; i < 16; ++i) v[i] = v[i] * rs * nwv[i]; }
                if (t < SEQ) {
                    const int pos = (part < 2) ? (t >> 6) : (t & 63); const f32x4* cs4 = (const f32x4*)(rope + pos * 32);
#pragma unroll
                    for (int k = 0; k < 8; ++k) { const f32x4 cs = cs4[k];
                        const float o0_ = DPPF(v[2 * k], 0xB1), o1_ = DPPF(v[2 * k + 1], 0xB1);
                        v[2 * k] = (part & 1) ? (v[2 * k] * cs.x + o0_ * cs.y) : (v[2 * k] * cs.x - o0_ * cs.y);
                        v[2 * k + 1] = (part & 1) ? (v[2 * k + 1] * cs.z + o1_ * cs.w) : (v[2 * k + 1] * cs.z - o1_ * cs.w); }
                }
                if (isq) {
#pragma unroll
                    for (int i = 0; i < 16; ++i) v[i] *= C2Q; }
                v4u o0, o1;
                o0.x = pk2(v[0], v[1]); o0.y = pk2(v[2], v[3]); o0.z = pk2(v[4], v[5]); o0.w = pk2(v[6], v[7]);
                o1.x = pk2(v[8], v[9]); o1.y = pk2(v[10], v[11]); o1.z = pk2(v[12], v[13]); o1.w = pk2(v[14], v[15]);
                if (isq) { ((v4u*)p[q])[0] = o0; ((v4u*)p[q])[1] = o1; }
                else { const int wsel = (hd >= 14) ? 1 : 0, kvh = (hd - 6) & 1;
                    bf16* kc = WSP(bf16, WS_KC) + ((size_t)(((wsel * 8 + b) * 2 + kvh)) * TPB + t) * 64 + 16 * part;
                    ((v4u*)kc)[0] = o0; ((v4u*)kc)[1] = o1; }
                *(v2u*)(WSP(bf16, WS_VC) + ((size_t)(((vsel * 8 + b) * 2 + vkvh)) * TPB + t) * 64 + vd) = vv[q];
            }
        }
    }
    {
        constexpr int UST = 1536 + 16;
        const float* cw = INP(I_CONVW) + l * 3 * 768; const float* cbv = INP(I_CONVB) + l * 768;
        const int c = tid & 255, half = tid >> 8;
        float w0[3], w1[3], w2[3], wb[3];
#pragma unroll
        for (int g = 0; g < 3; ++g) { w0[g] = cw[g * 256 + c]; w1[g] = cw[768 + g * 256 + c]; w2[g] = cw[1536 + g * 256 + c]; wb[g] = cbv[g * 256 + c]; }
        const int nunits = (l == 0) ? NB * 68 : NB * 64;
        for (int u = blockIdx.x; u < nunits; u += G) {
            int b, n, t0, rowbase; bf16 *zt, *xt;
            if (u < NB * 64) { b = u >> 6; n = SEQ; t0 = (u & 63) * 64; rowbase = b * TPB; zt = WSP(bf16, WS_ZT) + (size_t)b * 256 * SEQ; xt = WSP(bf16, WS_X0T) + (size_t)b * 256 * SEQ; }
            else { const int q = u - NB * 64; b = q >> 2; n = CTXL; t0 = (q & 3) * 64; rowbase = b * TPB + SEQ; zt = WSP(bf16, WS_ZTC) + (size_t)b * 256 * CTXL; xt = WSP(bf16, WS_X0TC) + (size_t)b * 256 * CTXL; }
            __syncthreads();
            { v4u t_[13];
#pragma unroll
              for (int q = 0; q < 13; ++q) { const int idx = tid + 512 * q, rr = idx / 96, ch = idx - 96 * rr, t = t0 - 1 + rr;
                  t_[q] = (v4u){0u, 0u, 0u, 0u};
                  if (idx < 66 * 96 && t >= 0 && t < n) t_[q] = *(const v4u*)(P + (size_t)(rowbase + t) * INW + ch * 8); }
#pragma unroll
              for (int q = 0; q < 13; ++q) { const int idx = tid + 512 * q, rr = idx / 96, ch = idx - 96 * rr;
                  if (idx < 66 * 96) *(LAS v4u*)(lds + rr * UST + ch * 16) = t_[q]; } }
            __syncthreads();
            const LAS unsigned short* up = (const LAS unsigned short*)(lds + (32 * half) * UST) + c;
            float pm[3], pc[3];
#pragma unroll
            for (int g = 0; g < 3; ++g) { pm[g] = bf2f(up[g * 256]); pc[g] = bf2f(up[(UST / 2) + g * 256]); }
            unsigned zo[16], xo[16];
#pragma unroll
            for (int i = 0; i < 32; ++i) {
                float uc[3];
#pragma unroll
                for (int g = 0; g < 3; ++g) { const float pn = bf2f(up[(i + 2) * (UST / 2) + g * 256]); uc[g] = w0[g] * pm[g] + w1[g] * pc[g] + w2[g] * pn + wb[g]; pm[g] = pc[g]; pc[g] = pn; }
                const unsigned zb = f2bf(uc[2] * uc[1]), xb = f2bf(uc[0]);
                if (i & 1) { zo[i >> 1] |= zb << 16; xo[i >> 1] |= xb << 16; } else { zo[i >> 1] = zb; xo[i >> 1] = xb; }
            }
            bf16* zp = zt + (size_t)c * n + t0 + 32 * half; bf16* xp = xt + (size_t)c * n + t0 + 32 * half;
#pragma unroll
            for (int k = 0; k < 4; ++k) { v4u a, d; a.x = zo[4 * k]; a.y = zo[4 * k + 1]; a.z = zo[4 * k + 2]; a.w = zo[4 * k + 3]; d.x = xo[4 * k]; d.y = xo[4 * k + 1]; d.z = xo[4 * k + 2]; d.w = xo[4 * k + 3];
                ((v4u*)zp)[k] = a; ((v4u*)xp)[k] = d; }
        }
        __syncthreads();
    }
}

__device__ __forceinline__ void hyena_latent_unit(const Args& A, LAS unsigned char* lds, int l, int c) {
    const int tid = otid();
    LAS float* Gf = (LAS float*)lds; LAS float* Zf = Gf + 8192;
    const bf16* g = WSP(bf16, WS_GB) + (size_t)(l * 256 + c) * 8192;
    for (int i = tid; i < 8192; i += 512) Gf[i] = bf2f(g[i]);
    const float skip = INP(I_SKIP)[l * 256 + c];
    bf16* Y = WSP(bf16, WS_Y);
    for (int bg = 0; bg < 2; ++bg) {
        __syncthreads();
        for (int i = tid; i < 4 * 4096; i += 512) { const int bb = i >> 12, s = i & 4095; Zf[i] = bf2f(WSP(bf16, WS_ZT)[((size_t)((bg * 4 + bb) * 256 + c)) * SEQ + s]); }
        __syncthreads();
        float acc[4][8];
#pragma unroll
        for (int bb = 0; bb < 4; ++bb)
#pragma unroll
            for (int i = 0; i < 8; ++i) acc[bb][i] = 0.f;
        const LAS float* gp = Gf + tid + 4096;
#pragma unroll 2
        for (int s = 0; s < 4096; ++s) {
            const float z0 = Zf[s], z1 = Zf[4096 + s], z2 = Zf[8192 + s], z3 = Zf[12288 + s];
#pragma unroll
            for (int i = 0; i < 8; ++i) { const float gg = gp[512 * i - s]; acc[0][i] += gg * z0; acc[1][i] += gg * z1; acc[2][i] += gg * z2; acc[3][i] += gg * z3; }
        }
#pragma unroll
        for (int bb = 0; bb < 4; ++bb)
#pragma unroll
            for (int i = 0; i < 8; ++i) { const int t = tid + 512 * i, b = bg * 4 + bb;
                const float x0 = bf2f(WSP(bf16, WS_X0T)[((size_t)(b * 256 + c)) * SEQ + t]);
                Y[((size_t)(b * TPB + t)) * DM + c] = (bf16)f2bf(x0 * (acc[bb][i] + Zf[bb * 4096 + t] * skip)); }
    }
    __syncthreads();
}
__device__ __forceinline__ void hyena_mfma_unit(const Args& A, LAS unsigned char* lds, int l, int c) {
    const int tid = otid(), lane = tid & 63, w = __builtin_amdgcn_readfirstlane(tid >> 6);
    constexpr int RCOPY = 16384 + 64, ZOFF = 4 * RCOPY, ZS = 8192 + 32, ZERO_OFF = ZOFF + 8 * ZS;
    const bf16* gsrc = WSP(bf16, WS_GB) + (size_t)(l * 256 + c) * 8192;
    __syncthreads();
#pragma unroll
    for (int ch = tid; ch < 1024; ch += 512) {
        const v4u g4 = *(const v4u*)(gsrc + 8184 - 8 * ch);
        v4u o; o.x = __builtin_amdgcn_alignbit(g4.w, g4.w, 16); o.y = __builtin_amdgcn_alignbit(g4.z, g4.z, 16); o.z = __builtin_amdgcn_alignbit(g4.y, g4.y, 16); o.w = __builtin_amdgcn_alignbit(g4.x, g4.x, 16);
        *(LAS v4u*)(lds + ch * 16) = o; }
    __syncthreads();
    for (int idx = tid; idx < 3 * 4096; idx += 512) { const int k = 1 + (idx >> 12), wd = idx & 4095;
        const int e0 = 2 * wd + k; const unsigned d0 = *(const LAS unsigned*)(lds + (e0 >> 1) * 4), d1 = (e0 + 1 < 8192 && ((e0 + 1) >> 1) < 4096) ? *(const LAS unsigned*)(lds + ((e0 + 1) >> 1) * 4) : 0u;
        const unsigned v = (k & 1) ? __builtin_amdgcn_alignbit(d1, d0, 16) : d0;
        *(LAS unsigned*)(lds + k * RCOPY + wd * 4) = ((e0 >> 1) < 4096) ? v : 0u; }
    { v4u t_[8];
#pragma unroll
      for (int b = 0; b < 8; ++b) t_[b] = *(const v4u*)(WSP(bf16, WS_ZT) + ((size_t)(b * 256 + c)) * SEQ + tid * 8);
#pragma unroll
      for (int b = 0; b < 8; ++b) *(LAS v4u*)(lds + ZOFF + b * ZS + tid * 16) = t_[b]; }
    if (tid < 32) *(LAS unsigned*)(lds + ZERO_OFF + tid * 4) = 0u;
    __syncthreads();
    const int r = lane & 15, g = lane >> 4, bcol = r >> 1, hcol = r & 1;
    const int Q = 4095 - r + 8 * g, kq = Q & 3;
    const int abase = kq * RCOPY + (Q - kq) * 2;
    const int zlane = ZOFF + bcol * ZS + 16 * g;
    f32x4 acc[4][4];
#pragma unroll
    for (int i = 0; i < 4; ++i)
#pragma unroll
        for (int j = 0; j < 4; ++j) acc[i][j] = (f32x4){0.f, 0.f, 0.f, 0.f};
    const int dlo = 8 * w - 63, dhi = 8 * w + 7;
#define HY_LDA(e) ({ const int a_ = abase - 32 * (e); const v2u lo_ = *(const LAS v2u*)(lds + a_), hi_ = *(const LAS v2u*)(lds + a_ + 8); v4u t_; t_.x = lo_.x; t_.y = lo_.y; t_.z = hi_.x; t_.w = hi_.y; __builtin_bit_cast(bf16x8, t_); })
    bf16x8 F0 = HY_LDA(4 * dlo - 2), F1 = HY_LDA(4 * dlo - 1), F2 = HY_LDA(4 * dlo), F3 = HY_LDA(4 * dlo + 1), F4 = HY_LDA(4 * dlo + 2), F5 = HY_LDA(4 * dlo + 3);
    for (int d = dlo; d <= dhi; ++d) {
        const int dn = (d < dhi) ? d + 1 : d;
        const bf16x8 N2 = HY_LDA(4 * dn), N3 = HY_LDA(4 * dn + 1), N4 = HY_LDA(4 * dn + 2), N5 = HY_LDA(4 * dn + 3);
        bf16x8 Bv[4][2]; bool okc[4];
#pragma unroll
        for (int cb = 0; cb < 4; ++cb) {
            const int s1a = 8 * w + 2 * cb - d;
            okc[cb] = !(s1a > 63 || s1a + 1 < 0);
            if (okc[cb]) { const int s1 = s1a + hcol; const bool ok = (s1 >= 0) && (s1 < 64);
                const int za = ok ? zlane + s1 * 128 : ZERO_OFF;
                Bv[cb][0] = *(const LAS bf16x8*)(lds + za); Bv[cb][1] = *(const LAS bf16x8*)(lds + za + 64); }
        }
#pragma unroll
        for (int cb = 0; cb < 4; ++cb) {
            if (!okc[cb]) continue;
            const bf16x8 B0 = Bv[cb][0], B1 = Bv[cb][1];
            acc[0][cb] = __builtin_amdgcn_mfma_f32_16x16x32_bf16(F2, B0, acc[0][cb], 0, 0, 0);
            acc[1][cb] = __builtin_amdgcn_mfma_f32_16x16x32_bf16(F3, B0, acc[1][cb], 0, 0, 0);
            acc[2][cb] = __builtin_amdgcn_mfma_f32_16x16x32_bf16(F4, B0, acc[2][cb], 0, 0, 0);
            acc[3][cb] = __builtin_amdgcn_mfma_f32_16x16x32_bf16(F5, B0, acc[3][cb], 0, 0, 0);
            acc[0][cb] = __builtin_amdgcn_mfma_f32_16x16x32_bf16(F0, B1, acc[0][cb], 0, 0, 0);
            acc[1][cb] = __builtin_amdgcn_mfma_f32_16x16x32_bf16(F1, B1, acc[1][cb], 0, 0, 0);
            acc[2][cb] = __builtin_amdgcn_mfma_f32_16x16x32_bf16(F2, B1, acc[2][cb], 0, 0, 0);
            acc[3][cb] = __builtin_amdgcn_mfma_f32_16x16x32_bf16(F3, B1, acc[3][cb], 0, 0, 0);
        }
        F0 = F4; F1 = F5; F2 = N2; F3 = N3; F4 = N4; F5 = N5;
    }
#undef HY_LDA
    const float skip = INP(I_SKIP)[l * 256 + c];
    bf16* yt = WSP(bf16, WS_ZT) + ((size_t)(bcol * 256 + c)) * SEQ;
    const bf16* x0p = WSP(bf16, WS_X0T) + ((size_t)(bcol * 256 + c)) * SEQ;
    v2u xx[4][4];
#pragma unroll
    for (int cb = 0; cb < 4; ++cb)
#pragma unroll
        for (int rb = 0; rb < 4; ++rb) xx[cb][rb] = *(const v2u*)(x0p + 64 * (8 * w + 2 * cb + hcol) + 16 * rb + 4 * g);
#pragma unroll
    for (int cb = 0; cb < 4; ++cb)
#pragma unroll
        for (int rb = 0; rb < 4; ++rb) { const int t = 64 * (8 * w + 2 * cb + hcol) + 16 * rb + 4 * g;
            const v2u zz = *(const LAS v2u*)(lds + ZOFF + bcol * ZS + t * 2);
            const f32x4 a = acc[rb][cb]; const v2u x4 = xx[cb][rb];
            v2u o; o.x = pk2(bflo(x4.x) * (a[0] + bflo(zz.x) * skip), bfhi(x4.x) * (a[1] + bfhi(zz.x) * skip)); o.y = pk2(bflo(x4.y) * (a[2] + bflo(zz.y) * skip), bfhi(x4.y) * (a[3] + bfhi(zz.y) * skip));
            *(v2u*)(yt + t) = o; }
    __syncthreads();
}
__device__ __forceinline__ void hyena_ctx_unit(const Args& A, LAS unsigned char* lds, int l, int b, int cg) {
    const int tid = otid(), ch = tid >> 5, tg = tid & 31;
    LAS float* Gf = (LAS float*)lds; LAS float* Zf = Gf + 16 * 512;
    bf16* Y = WSP(bf16, WS_Y);
    __syncthreads();
    { float g_[16]; unsigned short z_[8];
#pragma unroll
      for (int q = 0; q < 16; ++q) g_[q] = WSP(float, WS_GC)[(cg * 16) * 512 + tid + 512 * q];
#pragma unroll
      for (int q = 0; q < 8; ++q) z_[q] = WSP(bf16, WS_ZTC)[((size_t)(b * 256 + cg * 16)) * CTXL + tid + 512 * q];
#pragma unroll
      for (int q = 0; q < 16; ++q) Gf[tid + 512 * q] = g_[q];
#pragma unroll
      for (int q = 0; q < 8; ++q) Zf[tid + 512 * q] = bf2f(z_[q]); }
    __syncthreads();
    float acc[8];
#pragma unroll
    for (int i = 0; i < 8; ++i) acc[i] = 0.f;
    const LAS float* gp = Gf + ch * 512 + 256 + tg; const LAS float* zp = Zf + ch * 256;
    for (int s = 0; s < 256; ++s) { const float z = zp[s];
#pragma unroll
        for (int i = 0; i < 8; ++i) acc[i] += gp[32 * i - s] * z; }
    const int c = cg * 16 + ch; const float skip = INP(I_SKIP)[l * 256 + c];
    unsigned short x0v[8];
#pragma unroll
    for (int i = 0; i < 8; ++i) x0v[i] = WSP(bf16, WS_X0TC)[((size_t)(b * 256 + c)) * CTXL + tg + 32 * i];
#pragma unroll
    for (int i = 0; i < 8; ++i) { const int t = tg + 32 * i;
        Y[((size_t)(b * TPB + SEQ + t)) * DM + c] = (bf16)f2bf(bf2f(x0v[i]) * (acc[i] + zp[t] * skip)); }
    __syncthreads();
}
__device__ __forceinline__ void ph_mixers(const Args& A, unsigned char* lds_generic, LAS unsigned char* lds, int l, int G, int vcu, int cv_lo, int cv_hi) {
#ifndef NO_HY
#ifdef HY_VALU
    for (int u = blockIdx.x; u < 256; u += G) hyena_latent_unit(A, lds, l, u);
#else
#ifndef HY_REPS
#define HY_REPS 1
#endif
    for (int hr = 0; hr < HY_REPS; ++hr)
    for (int u = blockIdx.x; u < 256; u += G) hyena_mfma_unit(A, lds, l, ((u & 7) << 5) | (u >> 3));
#endif
    if (l == 0) { for (int u = G - 1 - (int)blockIdx.x; u < 128; u += G) hyena_ctx_unit(A, lds, l, u >> 4, u & 15); }
#endif
    __syncthreads();
    const attn_body::bf16* P = (const attn_body::bf16*)WSP(bf16, WS_P); attn_body::bf16* Y = (attn_body::bf16*)WSP(bf16, WS_Y);
    const int nunits = (l == 0) ? 1632 : 1536;
    float mfix_ga; { float gq = 0.f, gk = 0.f; const float* qn = INP(I_QNORM) + l * 64; const float* kn = INP(I_KNORM) + l * 64;
        for (int i = 0; i < 64; ++i) { gq = fmaxf(gq, fabsf(qn[i])); gk = fmaxf(gk, fabsf(kn[i])); }
        mfix_ga = 8.0f * LOG2E * gq * gk * 1.02f; }
#ifndef NO_ATT
    int aj = 0;
    for (int u = vcu; u < nunits; u += G, ++aj) {
        if (cv_hi > cv_lo && aj == (vcu & 3)) { __syncthreads(); cv_blocks(A, lds, cv_lo, cv_hi, 0, 1); }
        attn_body::AttnJob J; int b, h, win;
        if (u < 1536) { win = (u >= 768) ? 1 : 0; const int q = win ? u - 768 : u; b = q / 96; const int r = q - 96 * b; h = r >> 4; const int qb = r & 15; J.q0 = 256 * qb;
            if (!win) { J.NT = 68; J.nA = 68; J.rA = 0; J.rB = 0; J.masked = 0; }
            else { const int klo = (J.q0 >= 128) ? J.q0 - 128 : 0, khi = (J.q0 + 384 <= SEQ) ? J.q0 + 384 : SEQ; J.nA = 4; J.rA = SEQ; J.rB = klo; J.NT = 4 + (khi - klo) / 64; J.masked = 1; } }
        else { const int q = u - 1536; win = q / 48; const int r = q - 48 * win; b = r / 6; h = r - 6 * b; J.q0 = SEQ; J.NT = 4; J.nA = 4; J.rA = SEQ; J.rB = 0; J.masked = 0; }
        const int kvh = h / 3;
        const size_t rb = (size_t)b * TPB;
        J.Q = P + rb * INW + (win ? COL_WAQ : COL_GAQ) + 64 * h;
        { const size_t kvo = (size_t)(((win * 8 + b) * 2 + kvh)) * TPB * 64; J.K = (const attn_body::bf16*)WSP(bf16, WS_KC) + kvo; J.V = (const attn_body::bf16*)WSP(bf16, WS_VC) + kvo; }
        J.O = Y + rb * DM + (win ? 640 : 256) + 64 * h;
        J.sink_l2 = win ? INP(I_SINK)[l * 6 + h] * LOG2E : -INFINITY;
        J.mfix = (!win && mfix_ga <= 60.f) ? mfix_ga : 0.f;
        attn_body::attn_unit<8>(J, (char*)lds_generic);
    }
#endif
    __syncthreads();
}
__device__ __forceinline__ void bn_row(v4u w0, v4u w1, bf16* p, int lane, const float (&bw)[16]) {
    float v[16];
    v[0] = bflo(w0.x); v[1] = bfhi(w0.x); v[2] = bflo(w0.y); v[3] = bfhi(w0.y); v[4] = bflo(w0.z); v[5] = bfhi(w0.z); v[6] = bflo(w0.w); v[7] = bfhi(w0.w);
    v[8] = bflo(w1.x); v[9] = bfhi(w1.x); v[10] = bflo(w1.y); v[11] = bfhi(w1.y); v[12] = bflo(w1.z); v[13] = bfhi(w1.z); v[14] = bflo(w1.w); v[15] = bfhi(w1.w);
    float ss = 0.f;
#pragma unroll
    for (int k = 0; k < 16; ++k) ss += v[k] * v[k];
    ss += DPPF(ss, 0xB1); ss += DPPF(ss, 0x4E); ss += DPPF(ss, 0x141);
    float gs[8];
#pragma unroll
    for (int k = 0; k < 8; ++k) gs[k] = __builtin_bit_cast(float, __builtin_amdgcn_readlane(__builtin_bit_cast(int, ss), 8 * k));
    const float s0 = gs[0] + gs[1], s1 = (gs[2] + gs[3]) + gs[4], s2 = (gs[5] + gs[6]) + gs[7];
    const float rs = (lane < 16) ? rsqrtf(s0 * (1.0f / 256.0f) + EPSN) : (lane < 40) ? rsqrtf(s1 * (1.0f / 384.0f) + EPSN) : rsqrtf(s2 * (1.0f / 384.0f) + EPSN);
#pragma unroll
    for (int k = 0; k < 16; ++k) v[k] = v[k] * rs * bw[k];
    v4u o0, o1;
    o0.x = pk2(v[0], v[1]); o0.y = pk2(v[2], v[3]); o0.z = pk2(v[4], v[5]); o0.w = pk2(v[6], v[7]);
    o1.x = pk2(v[8], v[9]); o1.y = pk2(v[10], v[11]); o1.z = pk2(v[12], v[13]); o1.w = pk2(v[14], v[15]);
    ((v4u*)p)[0] = o0; ((v4u*)p)[1] = o1;
}
__device__ __forceinline__ void ph_branchnorm(const Args& A, LAS unsigned char* lds, int l, int G) {
    const int tid = otid(), lane = tid & 63, wave = tid >> 6, gw = blockIdx.x * 8 + wave, NGW = G * 8;
    bf16* Y = WSP(bf16, WS_Y); const float* bn = INP(I_BNORM) + l * DM; const bf16* YT = WSP(bf16, WS_ZT);
    constexpr int NR = 4, TP = 144  , TBUF = 256 * TP;
    float bw[16];
#pragma unroll
    for (int k = 0; k < 4; ++k) { const f32x4 t = ((const f32x4*)(bn + 16 * lane))[k]; bw[4 * k] = t.x; bw[4 * k + 1] = t.y; bw[4 * k + 2] = t.z; bw[4 * k + 3] = t.w; }
    v4u st[4];
    __syncthreads();
    int tx = blockIdx.x, par = 0;
    if (tx < 512) {
#pragma unroll
        for (int j = 0; j < 4; ++j) { const int pz = tid + 512 * j; st[j] = *(const v4u*)(YT + ((size_t)((tx >> 6) * 256 + (pz >> 3))) * SEQ + 64 * (tx & 63) + 8 * (pz & 7)); } }
    for (; tx < 512; tx += G, par ^= 1) {
        LAS unsigned char* buf = lds + par * TBUF;
#pragma unroll
        for (int j = 0; j < 4; ++j) { const int pz = tid + 512 * j; *(LAS v4u*)(buf + (pz >> 3) * TP + (pz & 7) * 16) = st[j]; }
        __syncthreads();
        if (tx + G < 512) { const int tn = tx + G;
#pragma unroll
            for (int j = 0; j < 4; ++j) { const int pz = tid + 512 * j; st[j] = *(const v4u*)(YT + ((size_t)((tn >> 6) * 256 + (pz >> 3))) * SEQ + 64 * (tn & 63) + 8 * (pz & 7)); } }
        const int r0 = (tx >> 6) * TPB + 64 * (tx & 63) + 8 * wave;
#pragma unroll 1
        for (int it = 0; it < 2; ++it) {
            v4u w0[NR], w1[NR]; bf16* p[NR];
#pragma unroll
            for (int q = 0; q < NR; ++q) { p[q] = Y + (size_t)(r0 + 4 * it + q) * DM + 16 * lane;
                if (lane >= 16) { w0[q] = ((const v4u*)p[q])[0]; w1[q] = ((const v4u*)p[q])[1]; }
                else { const LAS unsigned char* cp = buf + (16 * lane) * TP + 2 * (8 * wave + 4 * it + q); unsigned h[16];
#pragma unroll
                    for (int k = 0; k < 16; ++k) h[k] = *(const LAS unsigned short*)(cp + k * TP);
                    w0[q].x = h[0] | (h[1] << 16); w0[q].y = h[2] | (h[3] << 16); w0[q].z = h[4] | (h[5] << 16); w0[q].w = h[6] | (h[7] << 16);
                    w1[q].x = h[8] | (h[9] << 16); w1[q].y = h[10] | (h[11] << 16); w1[q].z = h[12] | (h[13] << 16); w1[q].w = h[14] | (h[15] << 16); } }
#pragma unroll
            for (int q = 0; q < NR; ++q) bn_row(w0[q], w1[q], p[q], lane, bw);
        }
    }
    if (l == 0) {
        for (int i0 = gw * NR; i0 < NB * CTXL; i0 += NGW * NR) {
            v4u w0[NR], w1[NR]; bf16* p[NR];
#pragma unroll
            for (int q = 0; q < NR; ++q) { const int i = i0 + q, r = (i >> 8) * TPB + SEQ + (i & 255); p[q] = Y + (size_t)r * DM + 16 * lane; w0[q] = ((const v4u*)p[q])[0]; w1[q] = ((const v4u*)p[q])[1]; }
#pragma unroll
            for (int q = 0; q < NR; ++q) bn_row(w0[q], w1[q], p[q], lane, bw);
        }
    }
    __syncthreads();
}

constexpr int NPHASE = 22;
__global__ void __launch_bounds__(512, 2) hh_fwd(Args A) {
    extern __shared__ __attribute__((aligned(16))) unsigned char lds_raw[];
    LAS unsigned char* lds = (LAS unsigned char*)lds_raw;
    const int G = gridDim.x;
    volatile LAS unsigned* MISC = (volatile LAS unsigned*)(lds + MISC_OFF);
    if (threadIdx.x < 64) MISC[threadIdx.x] = 0u;
    if ((threadIdx.x & 63) == 0) *(volatile LAS int*)(lds + WTAB_OFF + 4 * hw_slot()) = (int)(threadIdx.x >> 6);
    __syncthreads();
    const bool OVL = (G == 256);
#define SPARE_SPLIT(k_) const int kk_ = OVL ? (k_) : 0, xl_ = vcu & 31, xc_ = vcu >> 5; const bool is_cv = OVL && xl_ >= 32 - kk_; \
    const int Gg = OVL ? 8 * (32 - kk_) : G, cg = OVL ? xc_ * (32 - kk_) + xl_ : vcu, cvw = xc_ * kk_ + (xl_ - (32 - kk_)), cvn = 8 * kk_
    constexpr int CV_A = 650, CV_B = 1947, CV_C = 800, CV_D = 800, CV_E = 2 * CVB_L - CV_A - CV_B - CV_C - CV_D;
    static_assert(CV_A + CV_B + CV_C >= CVB_L && CV_E >= 0, "layer 0's blocks must be done before its MoE GEMMs");
    const int vcu = (G % 8 == 0) ? ((int)blockIdx.x % 8) * (G / 8) + (int)blockIdx.x / 8 : (int)blockIdx.x;
    { const int __attribute__((address_space(4)))* kp = (const int __attribute__((address_space(4)))*)__builtin_amdgcn_kernarg_segment_ptr();
      if (kp[73] - kp[72] > 1) (void)xcd_barrier_post((unsigned*)ws_ptr(A) + CW_BAR, MISC + 8); }
#define IN(k) in_range(A, (k))
#define SEAM(k) do { if (IN(k) && IN((k) + 1)) { XcdBarrier b_; b_.bar = (unsigned*)ws_ptr(A) + CW_BAR; b_.x = xb_xcc_id(); b_.st = (volatile LAS unsigned*)(lds + MISC_OFF) + 8; xcd_barrier(b_); } } while (0)

#ifndef PH_MASK
#define PH_MASK 0xFFF
#endif
#define PHON(k) ((PH_MASK >> (k)) & 1)
#ifndef HH_REPEAT
#define HH_REPEAT -1
#endif
#ifndef HH_DRY
#define HH_DRY 0
#endif
#define REPS(k) ((HH_REPEAT == (k)) ? 2 : 1)
#define REPBAR(k) do { if (HH_REPEAT == (k)) { XcdBarrier b_; b_.bar = (unsigned*)ws_ptr(A) + CW_BAR; b_.x = xb_xcc_id(); b_.st = (volatile LAS unsigned*)(lds + MISC_OFF) + 8; xcd_barrier(b_); } } while (0)
    if (PHON(0) && IN(0)) { for (int rep_ = 0; rep_ < REPS(0); ++rep_) { if (rep_) REPBAR(0); ph_prologue(A, lds, G, OVL ? 0 : 2 * CVB_L);   } SEAM(0); }
    #pragma unroll 1
    for (int l = 0; l < NLAYER; ++l) {
        const int pb = 1 + 10 * l;
        if (PHON(1) && IN(pb + 0)) { ph_rowpass_a(A, l, G); SEAM(pb + 0); }
        if (PHON(2) && IN(pb + 1)) {
            SPARE_SPLIT(l == 0 ? 4 : 5);
            SchedProj S{(const char*)WSP(bf16, WS_H), (const char*)(WSP(bf16, WS_WINT) + (size_t)l * 2048 * 1024), l, Gg, cg};
            EpiProj E{WSP(bf16, WS_P), INP(I_BIN) + l * INW};
            if (is_cv) { if (l == 0) cv_blocks(A, lds, 0, CV_A, cvw, cvn); else cv_blocks(A, lds, CV_A + CV_B + CV_C, CV_A + CV_B + CV_C + CV_D, cvw, cvn); }
            else for (int rep_ = 0; rep_ < REPS(2); ++rep_) { if (rep_) REPBAR(2); pg8::gemm_phase<EpiProj, SchedProj, false, true>(lds, S, E); }
            SEAM(pb + 1);
        }
        if (PHON(3) && IN(pb + 2)) { ph_post(A, lds, l, G); SEAM(pb + 2); }
        const int cvm_0 = (l == 0) ? CV_A : CV_A + CV_B + CV_C + CV_D, cvm_n = (l == 0) ? CV_B : CV_E, cvm_q = cvm_n / G, cvm_r = cvm_n - cvm_q * G;
        const int cvm_lo = OVL ? cvm_0 + vcu * cvm_q + (vcu < cvm_r ? vcu : cvm_r) : 0, cvm_hi = OVL ? cvm_lo + cvm_q + (vcu < cvm_r ? 1 : 0) : 0;
        if (PHON(4) && IN(pb + 3)) { for (int rep_ = 0; rep_ < REPS(4); ++rep_) { if (rep_) REPBAR(4); ph_mixers(A, lds_raw, lds, l, G, vcu, cvm_lo, cvm_hi); } SEAM(pb + 3); }
        if (PHON(5) && IN(pb + 4)) { ph_branchnorm(A, lds, l, G); SEAM(pb + 4); }
        if (PHON(6) && IN(pb + 5)) {
            SPARE_SPLIT(l == 0 ? 9 : 0);
            SchedOut S{(const char*)WSP(bf16, WS_Y), (const char*)(WSP(bf16, WS_WOUTT) + (size_t)l * 1024 * 1024), l, Gg, cg};
            EpiOut E{WSP(bf16, WS_X), INP(I_BOUT) + l * DM, WSP(float, WS_MOD) + l * 9 * 6144 + 2048, (l == 0) ? INP(I_X) : nullptr, (l == 0) ? INP(I_CTX) : nullptr};
            if (is_cv) cv_blocks(A, lds, CV_A + CV_B, CV_A + CV_B + CV_C, cvw, cvn);
            else pg8::gemm_phase<EpiOut, SchedOut, false, true>(lds, S, E);
            SEAM(pb + 5);
        }
        if (PHON(7) && IN(pb + 6)) { for (int rep_ = 0; rep_ < REPS(7); ++rep_) { if (rep_) REPBAR(7); ph_rowpass_g(A, lds, l, G); } SEAM(pb + 6); }
        if (PHON(8) && IN(pb + 7)) { ph_route(A, lds, l, G); SEAM(pb + 7); }
        if (PHON(9) && IN(pb + 8)) {
            const int nblk = moe_table(A, lds, l);
            SchedMoe S{(const char*)WSP(unsigned char, WS_H8), (const char*)(WSP(unsigned char, WS_W1T) + (size_t)l * 32 * 2048 * 1024), (const LAS int*)(lds + ROWS_OFF), (const LAS unsigned char*)(lds + LDSX_OFF + 1024), nblk, 3, G, vcu, (size_t)2048 * 1024};
            {
                pg8::Unit uu; const int* st = WSP(int, WS_SLOTTOK);
                const int t_ = otid(), th_ = t_ >> 8, tl_ = t_ & 255;
                int rv_[9];
#pragma unroll
                for (int j = 0; j < 9; ++j) { const int i = 2 * j + th_; rv_[j] = S.next(i, uu) ? st[uu.pm * 256 + tl_] : MROWS; }
#pragma unroll
                for (int j = 0; j < 9; ++j) ((LAS int*)(lds + ROWS_OFF))[(2 * j + th_) * 256 + tl_] = rv_[j];
                __syncthreads();
            }
            EpiGlu E{WSP(unsigned char, WS_ACT), INP(I_B1) + (size_t)l * 32 * 2048, &S, 0};
            #ifndef G1_REPS
#define G1_REPS 1
#endif
#pragma unroll 1
            for (int rep_ = 0; rep_ < G1_REPS; ++rep_) { if (rep_) E.dry = HH_DRY; pg8::gemm_phase<EpiGlu, SchedMoe, true, true, true>(lds, S, E); }
            SEAM(pb + 8);
        }
        if (PHON(10) && IN(pb + 9)) {
            const int nblk = moe_table(A, lds, l);
            SchedMoe S{(const char*)WSP(unsigned char, WS_ACT), (const char*)(WSP(unsigned char, WS_W2T) + (size_t)l * 32 * 1024 * 1024), nullptr, (const LAS unsigned char*)(lds + LDSX_OFF + 1024), nblk, 2, G, vcu, (size_t)1024 * 1024};
            EpiOuts E{WSP(unsigned char, WS_OUTS), INP(I_B2) + (size_t)l * 32 * 1024, &S, 0};
            for (int rep_ = 0; rep_ < REPS(10); ++rep_) { if (rep_) { REPBAR(10); E.dry = HH_DRY; } pg8::gemm_phase<EpiOuts, SchedMoe, false, true, true>(lds, S, E); }
            SEAM(pb + 9);
        }
    }
    if (PHON(11) && IN(21)) { for (int rep_ = 0; rep_ < REPS(11); ++rep_) { if (rep_) REPBAR(11); ph_final(A, G); } }
#undef IN
#undef SEAM
}

#ifndef HH_N_LAUNCHES
#define HH_N_LAUNCHES 1
#endif
extern "C" void kernel_launch(void* const* d_in, const int* in_sizes, int n_in, void* d_out, int out_size, void* d_ws, size_t ws_size, hipStream_t stream) {
    static int grid = 0;
    if (grid == 0) {
        if (n_in != 34 || out_size != NB * SEQ * DM || ws_size < WS_END) { fprintf(stderr, "kernel_launch: unexpected shapes (n_in %d, out %d, ws %zu)\n", n_in, out_size, ws_size); grid = -1; return; }
        int dev = 0, cus = 0, per_cu = 0;
        if (hipGetDevice(&dev) != hipSuccess || hipDeviceGetAttribute(&cus, hipDeviceAttributeMultiprocessorCount, dev) != hipSuccess) { grid = -1; return; }
        if (hipFuncSetAttribute((const void*)hh_fwd, hipFuncAttributeMaxDynamicSharedMemorySize, LDS_BYTES) != hipSuccess) { fprintf(stderr, "kernel_launch: hipFuncSetAttribute failed\n"); grid = -1; return; }
        if (hipOccupancyMaxActiveBlocksPerMultiprocessor(&per_cu, (const void*)hh_fwd, 512, LDS_BYTES) != hipSuccess || per_cu < 1) { fprintf(stderr, "kernel_launch: occupancy query says %d\n", per_cu); (void)hipGetLastError(); }
        grid = cus > 256 ? 256 : cus;
    }
    if (grid < 0) return;
    (void)hipMemsetAsync((char*)d_ws + WS_CTL, 0, CTL_ZERO_BYTES, stream);
    Args a{};
    for (int i = 0; i < 34; ++i) a.in[i] = (const float*)d_in[i];
    a.out = (float*)d_out; a.ws = (unsigned char*)d_ws;
    if (HH_N_LAUNCHES == 1) { a.ph_lo = 0; a.ph_hi = NPHASE; hipLaunchKernelGGL(hh_fwd, dim3(grid), dim3(512), LDS_BYTES, stream, a); }
    else { for (int p = 0; p < NPHASE; ++p) { a.ph_lo = p; a.ph_hi = p + 1; hipLaunchKernelGGL(hh_fwd, dim3(grid), dim3(512), LDS_BYTES, stream, a); } }
}
```

```cpp
#include <hip/hip_runtime.h>
#include <cstdio>
#include <cstdint>
#include <cmath>

#define GAS __attribute__((address_space(1)))
#define LAS __attribute__((address_space(3)))
typedef unsigned short bf16;
typedef unsigned v4u __attribute__((ext_vector_type(4)));
typedef unsigned v2u __attribute__((ext_vector_type(2)));
typedef float f32x4 __attribute__((ext_vector_type(4)));
typedef float f32x2 __attribute__((ext_vector_type(2)));
typedef short bf16x8 __attribute__((ext_vector_type(8)));
typedef GAS unsigned gu32;
#define RLX_AGENT __ATOMIC_RELAXED, __HIP_MEMORY_SCOPE_AGENT
#define LDS_WAIT() asm volatile("s_waitcnt lgkmcnt(0)" ::: "memory")
#define VM_WAIT() asm volatile("s_waitcnt vmcnt(0)" ::: "memory")

constexpr int NB = 8, SEQ = 4096, CTXL = 256, TPB = SEQ + CTXL  , MROWS = NB * TPB  , DM = 1024;
constexpr int INW = 2048, NEXP = 32, TOPK = 4, NLAYER = 2;
constexpr int NSLOT_MAX = ((MROWS * TOPK + 255) / 256 + NEXP) * 256;
constexpr int NBLK_MAX = NSLOT_MAX / 256;
constexpr float EPSN = 1e-6f;
constexpr float LOG2E = 1.4426950408889634f;
constexpr float C2Q = 0.125f * LOG2E;
constexpr int COL_HY = 0, COL_GAQ = 768, COL_GAK = 1152, COL_GAV = 1280, COL_WAQ = 1408, COL_WAK = 1792, COL_WAV = 1920;

constexpr size_t MiB = 1u << 20;
constexpr size_t WS_CTL = 0, CTL_ZERO_BYTES = 1 * MiB;
constexpr size_t WS_MOD = 5 * MiB;
constexpr size_t WS_ROPE = 6 * MiB;
constexpr size_t WS_WRT = 6 * MiB + 512 * 1024;
constexpr size_t WS_GC = 7 * MiB;
constexpr size_t WS_HIST = 8 * MiB;
constexpr size_t WS_EXPST = 8 * MiB + 256 * 1024;
constexpr size_t WS_TOPI = 9 * MiB;
constexpr size_t WS_TOPG = 10 * MiB;
constexpr size_t WS_TOKSLOT = 11 * MiB;
constexpr size_t WS_SLOTTOK = 12 * MiB;
constexpr size_t WS_GB = 16 * MiB;
constexpr size_t WS_WINT = 24 * MiB;
constexpr size_t WS_WOUTT = 32 * MiB;
constexpr size_t WS_W1T = 40 * MiB;
constexpr size_t WS_W2T = 296 * MiB;
constexpr size_t WS_X = 424 * MiB;
constexpr size_t WS_H = 560 * MiB;
constexpr size_t WS_P = 632 * MiB;
constexpr size_t WS_Y = 768 * MiB;
constexpr size_t WS_ZT = 836 * MiB;
constexpr size_t WS_X0T = 852 * MiB;
constexpr size_t WS_ZTC = 868 * MiB;
constexpr size_t WS_X0TC = 869 * MiB;
constexpr size_t WS_ACT = 872 * MiB;
constexpr size_t WS_OUTS = 1160 * MiB;
constexpr size_t WS_KC = 1448 * MiB;
constexpr size_t WS_VC = 1484 * MiB;
constexpr size_t WS_H8 = 1520 * MiB;
constexpr size_t WS_END = 1556 * MiB;
static_assert(WS_H + (size_t)(MROWS + 1) * DM * 2 <= WS_P && WS_ACT + (size_t)NSLOT_MAX * DM * 2 <= WS_OUTS && WS_OUTS + (size_t)NSLOT_MAX * DM * 2 <= WS_KC && WS_KC + (size_t)2 * 8 * 2 * TPB * 64 * 2 <= WS_VC && WS_VC + (size_t)2 * 8 * 2 * TPB * 64 * 2 <= WS_END, "ws map");
constexpr int CW_BAR = 4096;

constexpr int RING_BYTES = 131072;
constexpr int LDSX_OFF = RING_BYTES;
constexpr int ROWS_OFF = LDSX_OFF + 2048, BIAS_OFF = LDSX_OFF + 20480;
constexpr int MISC_OFF = RING_BYTES + 28672;
constexpr int WTAB_OFF = MISC_OFF + 256;
constexpr int LDS_BYTES = MISC_OFF + 512;

__device__ __forceinline__ unsigned f2bf(float f) { unsigned u = __builtin_bit_cast(unsigned, f); return (u + 0x7fffu + ((u >> 16) & 1u)) >> 16; }
typedef __bf16 hbf16x2 __attribute__((ext_vector_type(2)));
__device__ __forceinline__ unsigned pk2(float lo, float hi) { const f32x2 v = {lo, hi}; return __builtin_bit_cast(unsigned, __builtin_convertvector(v, hbf16x2)); }
__device__ __forceinline__ float bf2f(unsigned short h) { return __builtin_bit_cast(float, (unsigned)h << 16); }
__device__ __forceinline__ float bflo(unsigned w) { return __builtin_bit_cast(float, w << 16); }
__device__ __forceinline__ float bfhi(unsigned w) { return __builtin_bit_cast(float, w & 0xffff0000u); }
__device__ __forceinline__ int lane_now() { int l; asm volatile("v_mbcnt_lo_u32_b32 %0, -1, 0\n\tv_mbcnt_hi_u32_b32 %0, -1, %0" : "=v"(l)); return l; }
__device__ __forceinline__ float shflx(float v, int mask) { return __builtin_bit_cast(float, __builtin_amdgcn_ds_bpermute((lane_now() ^ mask) << 2, __builtin_bit_cast(int, v))); }
__device__ __forceinline__ float wave_sum(float v) {
    const int ln = lane_now();
#pragma unroll
    for (int o = 1; o < 64; o <<= 1) v += __builtin_bit_cast(float, __builtin_amdgcn_ds_bpermute((ln ^ o) << 2, __builtin_bit_cast(int, v)));
    return v;
}

__device__ __forceinline__ int hw_slot() { return (int)__builtin_amdgcn_s_getreg((5 << 11) | 4) & 63; }
__device__ __forceinline__ int otid() {
    int l; asm volatile("v_mbcnt_lo_u32_b32 %0, -1, 0\n\tv_mbcnt_hi_u32_b32 %0, -1, %0" : "=v"(l));
    const int w = __builtin_amdgcn_readfirstlane(*(const volatile LAS int*)(WTAB_OFF + 4 * hw_slot()));
    return (w << 6) | l;
}

__device__ __forceinline__ unsigned cvt4_fp8(float a, float b, float c, float d) { int p = 0; p = __builtin_amdgcn_cvt_pk_fp8_f32(a, b, p, false); p = __builtin_amdgcn_cvt_pk_fp8_f32(c, d, p, true); return (unsigned)p; }

#define XB_TMO      128
#define XB_XCNT(j)  (256  + 64 * (j))
#define XB_XSUB(j)  (1280 + 64 * (j))
#define XB_XGEN(j)  (2304 + 64 * (j))
#define XB_TOP      3328
#define XB_TOPGEN   3392
#define XCD_BAR_WORDS 3456
#define XB_SPIN_CAP (1u << 18)

__device__ __forceinline__ unsigned xb_ld(unsigned* p)              { return __hip_atomic_load(p, __ATOMIC_RELAXED, __HIP_MEMORY_SCOPE_AGENT); }
__device__ __forceinline__ unsigned xb_add(unsigned* p, unsigned v) { return __hip_atomic_fetch_add(p, v, __ATOMIC_RELAXED, __HIP_MEMORY_SCOPE_AGENT); }
__device__ __forceinline__ unsigned xb_xcc_id() { return (unsigned)__builtin_amdgcn_s_getreg((3 << 11) | 20) & 0xFu; }
#define XB_SPIN(cond, bar) do { unsigned _sp = 0; while (cond) { __builtin_amdgcn_s_sleep(1); \
    if ((++_sp & 255u) == 0u) { if (xb_ld(&(bar)[XB_TMO])) break; if (_sp > XB_SPIN_CAP) { atomicAdd(&(bar)[XB_TMO], 1u); break; } } } } while (0)

struct XcdBarrier {
    unsigned* bar; unsigned x;
    volatile LAS unsigned* st;
};

__device__ __forceinline__ XcdBarrier xcd_barrier_post(unsigned* bar, volatile LAS unsigned* st) {
    XcdBarrier b; b.bar = bar; b.x = xb_xcc_id(); b.st = st;
    if (threadIdx.x == 0) (void)xb_add(&bar[XB_XCNT(b.x)], 1u);
    return b;
}
__device__ __forceinline__ void xcd_barrier_complete(unsigned* bar, unsigned x, unsigned& nloc, unsigned& nx) {
    const unsigned G = gridDim.x * gridDim.y * gridDim.z;
    unsigned sum, cnt, mine, sp = 0u;
    for (;;) {
        sum = 0u; cnt = 0u; mine = 0u;
#pragma unroll
        for (unsigned j = 0; j < 16; ++j) { const unsigned c = xb_ld(&bar[XB_XCNT(j)]); sum += c; cnt += (c > 0u) ? 1u : 0u; mine = (j == x) ? c : mine; }
        if (sum == G) break;
        __builtin_amdgcn_s_sleep(1);
        if ((++sp & 255u) == 0u) { if (xb_ld(&bar[XB_TMO])) break; if (sp > XB_SPIN_CAP) { atomicAdd(&bar[XB_TMO], 1u); break; } }
    }
    nloc = mine > 0u ? mine : 1u; nx = cnt > 0u ? cnt : 1u;
}

__device__ __forceinline__ void xcd_barrier(const XcdBarrier& b) {
    asm volatile("s_waitcnt vmcnt(0)" ::: "memory");
    __syncthreads();
    if (threadIdx.x == 0) {
        unsigned* bar = b.bar;
        __builtin_amdgcn_s_waitcnt(0);
        unsigned nloc = b.st[0], nx = b.st[1];
        if (nloc == 0u) { xcd_barrier_complete(bar, b.x, nloc, nx); b.st[0] = nloc; b.st[1] = nx; }
        const unsigned old = xb_add(&bar[XB_XSUB(b.x)], 1u);
        const unsigned gen = old / nloc;
        if (old + 1u == (gen + 1u) * nloc) {
            __builtin_amdgcn_fence(__ATOMIC_RELEASE, "agent");
            asm volatile("s_waitcnt vmcnt(0)" ::: "memory");
            const unsigned og = xb_add(&bar[XB_TOP], 1u);
            const unsigned tg = og / nx;
            if (og + 1u == (tg + 1u) * nx) xb_add(&bar[XB_TOPGEN], 1u);
            else XB_SPIN(xb_ld(&bar[XB_TOPGEN]) == tg, bar);
            __builtin_amdgcn_fence(__ATOMIC_ACQUIRE, "agent");
            xb_add(&bar[XB_XGEN(b.x)], 1u);
            asm volatile("s_waitcnt vmcnt(0)" ::: "memory");
        } else {
            XB_SPIN(xb_ld(&bar[XB_XGEN(b.x)]) == gen, bar);
            __builtin_amdgcn_fence(__ATOMIC_ACQUIRE, "agent");
            asm volatile("s_waitcnt vmcnt(0)" ::: "memory");
        }
    }
    __syncthreads();
}

namespace pg8 {
constexpr int BM = 256, BK = 64, HALF = 128, HTB = HALF * BK * 2, KK = 1024, NT = KK / BK, WSL = 6  ;
__device__ __forceinline__ int lds_byte(int r, int c) { const int st = (r >> 4) * 2 + (c >> 5), rr = r & 15, cc = c & 31, ob = rr * 64 + cc * 2; return st * 1024 + (ob ^ (((ob >> 9) & 1) << 5)); }
__device__ __forceinline__ void stage_rc(int b, int& R, int& C) { const int st = b / 1024, sb = b % 1024, swz = sb ^ (((sb >> 9) & 1) << 5); R = (st >> 1) * 16 + swz / 64; C = (st & 1) * 32 + (swz % 64) / 2; }
__device__ __forceinline__ int g8(int r) { return ((r >> 1) & 1) | (((r >> 3) & 1) << 2); }
__device__ __forceinline__ void stage_rc8(int b, int& R, int& Cb) { const int sb = b >> 11, q = (b & 2047) >> 4, r = q >> 3, cpos = q & 7; R = sb * 16 + r; Cb = (cpos ^ g8(r)) * 16; }
typedef int v8i __attribute__((ext_vector_type(8)));
using ::lane_now;
typedef int v4i __attribute__((ext_vector_type(4)));
__device__ __forceinline__ v8i ld8(const LAS unsigned char* lds, int off) { const v4i lo = *(const LAS v4i*)(lds + off), hi = *(const LAS v4i*)(lds + (off ^ 16)); return __builtin_shufflevector(lo, hi, 0, 1, 2, 3, 4, 5, 6, 7); }
__device__ __forceinline__ int perm32(int rho) { const int n = rho >> 4, i = rho & 15; return 8 * (i >> 2) + 4 * n + (i & 3); }
__device__ __forceinline__ unsigned cvt_pk_bf16(float lo, float hi) { unsigned r; asm volatile("v_cvt_pk_bf16_f32 %0, %1, %2" : "=v"(r) : "v"(lo), "v"(hi)); return r; }

struct Unit { int pm, pn, idx; };

template <class Epi, class Sched, bool GATHER, bool ALIGN_EPI, bool FP8 = false>
__device__ __forceinline__ void gemm_phase(LAS unsigned char* lds, const Sched& S, const Epi& E) {
    const int tid = otid(), wid = __builtin_amdgcn_readfirstlane(tid >> 6), lane = tid & 63, wr = wid >> 2, wc = wid & 3, fr = lane & 15, fq = lane >> 4;
    constexpr int K = KK, KB = FP8 ? KK : KK * 2  , nt = FP8 ? 8 : NT;
    unsigned voffB[2];
#pragma unroll
    for (int i = 0; i < 2; ++i) { int R, C; if constexpr (FP8) stage_rc8(tid * 16 + i * 8192, R, C); else { stage_rc(tid * 16 + i * 8192, R, C); C *= 2; }
        const int Rb = Epi::PERM ? ((R & ~31) + perm32(R & 31)) : R; voffB[i] = (unsigned)(Rb * KB + C); }
    int rA[2], cA2[2];
#pragma unroll
    for (int i = 0; i < 2; ++i) { int R, C; if constexpr (FP8) stage_rc8(tid * 16 + i * 8192, R, C); else { stage_rc(tid * 16 + i * 8192, R, C); C *= 2; } rA[i] = R; cA2[i] = C; }
#define PG8_AOF(dst, h, uidx) do { _Pragma("unroll") for (int _i = 0; _i < 2; ++_i) { \
        if constexpr (GATHER) dst[_i] = (unsigned)S.arow_idx((uidx), (h) * HALF + rA[_i]) * (unsigned)KB + (unsigned)cA2[_i]; \
        else dst[_i] = (unsigned)(rA[_i] * KB + cA2[_i]); } } while (0)
#define PG8_AH(h) (GATHER ? (size_t)0 : (size_t)(h) * hstep)
    constexpr size_t kstep = (size_t)(BK * 2);
    constexpr size_t hstep = (size_t)HALF * KB;
    const unsigned ldsw = (unsigned)wid * 1024u;
    const int l8 = (fr * 8 + ((2 * fq) ^ g8(fr))) * 16;
    const int aoff = FP8 ? wr * 8192 + l8 : lds_byte(wr * 64 + fr, fq * 8), boff = FP8 ? wc * 4096 + l8 : lds_byte(wc * 32 + fr, fq * 8);
#define PG8_SA(b, h) (((b) * 2 + (h)) * HTB)
#define PG8_SB(b, h) ((4 + (b) * 2 + (h)) * HTB)
#define PG8_STAGE(bufoff, gbase, voff) do { _Pragma("unroll") for (int _i = 0; _i < 2; ++_i) \
        __builtin_amdgcn_global_load_lds((const unsigned*)((const char*)(gbase) + (voff)[_i]), (LAS unsigned*)(lds + (bufoff) + ldsw + _i * 8192), 16, 0, 0); } while (0)
#define PG8_LD8(base) ld8(lds, (base))
#define PG8_LDA(dst, b, h) do { _Pragma("unroll") for (int m = 0; m < 4; ++m) { if constexpr (FP8) dst##8[m] = PG8_LD8(PG8_SA(b, h) + aoff + m * 2048); \
        else { _Pragma("unroll") for (int k = 0; k < 2; ++k) dst[m][k] = *(const LAS bf16x8*)(lds + PG8_SA(b, h) + aoff + m * 2048 + k * 1024); } } } while (0)
#define PG8_LDB(dst, b, h) do { _Pragma("unroll") for (int n = 0; n < 2; ++n) { if constexpr (FP8) dst##8[n] = PG8_LD8(PG8_SB(b, h) + boff + n * 2048); \
        else { _Pragma("unroll") for (int k = 0; k < 2; ++k) dst[n][k] = *(const LAS bf16x8*)(lds + PG8_SB(b, h) + boff + n * 2048 + k * 1024); } } } while (0)
#define PG8_MMA(ai, bj, At, Bt) do { __builtin_amdgcn_s_setprio(1); _Pragma("unroll") for (int m = 0; m < 4; ++m) _Pragma("unroll") for (int n = 0; n < 2; ++n) { \
        if constexpr (FP8) asm volatile("v_mfma_scale_f32_16x16x128_f8f6f4 %0, %1, %2, %0, %3, %3 op_sel_hi:[0,0,0]" : "+v"(acc[ai][bj][m][n]) : "v"(Bt##8[n]), "v"(At##8[m]), "v"(scw)); \
        else { _Pragma("unroll") for (int k = 0; k < 2; ++k) acc[ai][bj][m][n] = __builtin_amdgcn_mfma_f32_16x16x32_bf16(Bt[n][k], At[m][k], acc[ai][bj][m][n], 0, 0, 0); } } \
        __builtin_amdgcn_s_setprio(0); } while (0)
#define PG8_WAIT_V(n) asm volatile("s_waitcnt vmcnt(" #n ")" ::: "memory")
#define PG8_WAIT_L(n) asm volatile("s_waitcnt lgkmcnt(" #n ")" ::: "memory")
#define PG8_BAR __builtin_amdgcn_s_barrier()
#define PG8_SCHED __builtin_amdgcn_sched_barrier(0)
    LAS unsigned char* biasl = lds + BIAS_OFF;
#define PG8_BIAS(u, slot) do { _Pragma("unroll") for (int _j = 0; _j < Epi::NDMA; ++_j) \
        __builtin_amdgcn_global_load_lds((const unsigned*)E.bias_src((u), lane_now(), _j), (LAS unsigned*)(biasl + (slot) + _j * 1024), 16, 0, 0); } while (0)
    Unit cur, nxt; int ui = 0;
    if (!S.next(0, cur)) return;
    int bs_cur = 0, bs_nxt = 2048;
    PG8_BIAS(cur, 0);
    unsigned va[2];
    f32x4 acc[2][2][4][2];
#pragma unroll
    for (int a = 0; a < 2; ++a)
#pragma unroll
        for (int b = 0; b < 2; ++b)
#pragma unroll
            for (int m = 0; m < 4; ++m)
#pragma unroll
                for (int n = 0; n < 2; ++n) acc[a][b][m][n] = (f32x4){0.f, 0.f, 0.f, 0.f};
    int scw = (127 - WSL / 2) * 0x01010101;
    asm volatile("" : "+v"(scw));
    bf16x8 At[4][2], B0[2][2], B1[2][2]; v8i At8[4], B08[2], B18[2];
    const char* cA = S.abase(cur); const char* cB = S.bbase(cur);
    PG8_STAGE(PG8_SB(0, 0), cB, voffB); PG8_STAGE(PG8_SB(0, 1), cB + hstep, voffB); PG8_AOF(va, 0, cur.idx); PG8_STAGE(PG8_SA(0, 0), cA, va); PG8_AOF(va, 1, cur.idx); PG8_STAGE(PG8_SA(0, 1), cA + PG8_AH(1), va);
    if (wr == 1) PG8_BAR;
    PG8_WAIT_V(2); PG8_BAR;
    PG8_STAGE(PG8_SB(1, 0), cB + kstep, voffB); PG8_AOF(va, 0, cur.idx); PG8_STAGE(PG8_SA(1, 0), cA + kstep, va); PG8_STAGE(PG8_SB(1, 1), cB + hstep + kstep, voffB);
    PG8_WAIT_V(6); PG8_BAR;
    for (;;) {
        const bool has_next = S.next(ui + 1, nxt);
        if (has_next) PG8_BIAS(nxt, bs_nxt);
        const char* nA = has_next ? S.abase(nxt) : cA; const char* nB = has_next ? S.bbase(nxt) : cB;
#pragma unroll 1
        for (int t = 0; t < nt; t += 2) {
            const bool last = (t == nt - 2);
            const char* a1 = cA + (size_t)(t + 1) * kstep;
            const char* a2 = last ? nA : cA + (size_t)(t + 2) * kstep; const char* b2 = last ? nB : cB + (size_t)(t + 2) * kstep;
            const char* a3 = a2 + kstep; const char* b3 = b2 + kstep;
            const int idx2 = (last && has_next) ? nxt.idx : cur.idx;
            PG8_AOF(va, 1, cur.idx); PG8_LDB(B0, 0, 0); PG8_LDB(B1, 0, 1); PG8_SCHED; PG8_LDA(At, 0, 0); PG8_STAGE(PG8_SA(1, 1), a1 + PG8_AH(1), va);
            PG8_WAIT_V(8); PG8_WAIT_L(0); PG8_BAR; PG8_MMA(0, 0, At, B0); PG8_MMA(0, 1, At, B1); PG8_BAR; PG8_SCHED;
            PG8_AOF(va, 0, idx2); PG8_LDA(At, 0, 1); PG8_STAGE(PG8_SB(0, 0), b2, voffB); PG8_STAGE(PG8_SB(0, 1), b2 + hstep, voffB); PG8_STAGE(PG8_SA(0, 0), a2, va);
            PG8_WAIT_V(8); PG8_WAIT_L(0); PG8_BAR; PG8_MMA(1, 0, At, B0); PG8_MMA(1, 1, At, B1); PG8_BAR; PG8_SCHED;
            PG8_AOF(va, 1, idx2); PG8_LDB(B0, 1, 0); PG8_LDB(B1, 1, 1); PG8_SCHED; PG8_LDA(At, 1, 0); PG8_STAGE(PG8_SA(0, 1), a2 + PG8_AH(1), va);
            PG8_WAIT_V(8); PG8_WAIT_L(0); PG8_BAR; PG8_MMA(0, 0, At, B0); PG8_MMA(0, 1, At, B1); PG8_BAR; PG8_SCHED;
            PG8_AOF(va, 0, idx2); PG8_LDA(At, 1, 1); PG8_STAGE(PG8_SB(1, 0), b3, voffB); PG8_STAGE(PG8_SB(1, 1), b3 + hstep, voffB); PG8_STAGE(PG8_SA(1, 0), a3, va);
            PG8_WAIT_V(8); PG8_WAIT_L(0); PG8_BAR; PG8_MMA(1, 0, At, B0); PG8_MMA(1, 1, At, B1); PG8_BAR; PG8_SCHED;
        }
        if constexpr (FP8) asm volatile("s_nop 15\n\ts_nop 7" ::: "memory");
        if constexpr (ALIGN_EPI) { if (wr == 0) PG8_BAR; }
        E(acc, cur, wr, wc, fr, fq, biasl + bs_cur);
        if (!has_next) break;
#pragma unroll
        for (int a = 0; a < 2; ++a)
#pragma unroll
            for (int b = 0; b < 2; ++b)
#pragma unroll
                for (int m = 0; m < 4; ++m)
#pragma unroll
                    for (int n = 0; n < 2; ++n) acc[a][b][m][n] = (f32x4){0.f, 0.f, 0.f, 0.f};
        cur = nxt; cA = nA; cB = nB; ++ui; bs_cur = bs_nxt; bs_nxt = (bs_nxt == 4096) ? 0 : bs_nxt + 2048;
        if constexpr (ALIGN_EPI) { if (wr == 1) PG8_BAR; }
    }
    PG8_WAIT_V(0);
    if constexpr (!ALIGN_EPI) { if (wr == 0) PG8_BAR; }
    PG8_BAR;
#undef PG8_BIAS
#undef PG8_LD8
#undef PG8_AOF
#undef PG8_AH
#undef PG8_SA
#undef PG8_SB
#undef PG8_STAGE
#undef PG8_LDA
#undef PG8_LDB
#undef PG8_MMA
#undef PG8_WAIT_V
#undef PG8_WAIT_L
#undef PG8_BAR
#undef PG8_SCHED
}
}

#include <hip/hip_bf16.h>
namespace attn_body {
using bf16=__hip_bfloat16;
struct AttnJob { const bf16* Q; const bf16* K; const bf16* V; bf16* O; int q0, NT, nA, rA, rB, masked; float sink_l2, mfix; };
using bf16x8=__attribute__((ext_vector_type(8)))short;
using s16x4=__attribute__((ext_vector_type(4)))short;
using f32x16=__attribute__((ext_vector_type(16)))float;
using u32x4=__attribute__((ext_vector_type(4)))unsigned;
constexpr int D=64,PQ=2048,PKV=64,PO=1024;
constexpr int NW=8,QBLK=32,QB=QBLK*NW,KVBLK=64;
__device__ __forceinline__ int crow(int r,int hi){return (r&3)+8*(r>>2)+4*hi;}
#define SBAR() __builtin_amdgcn_sched_barrier(0)
__device__ __forceinline__ void wmask(f32x16&p0,f32x16&p1,int dk){
  const float NEG=-INFINITY; asm volatile("":"+v"(dk));
  #pragma unroll
  for(int r=0;r<16;++r){const int d=dk+(r&3)+8*(r>>2); if((unsigned)(d+128)>256u)p0[r]=NEG; if((unsigned)(d+160)>256u)p1[r]=NEG;}
}

constexpr int NSLOT=3, SLOTB=8192;
constexpr int LDS_K=0, LDS_V=NSLOT*SLOTB, LDS_WS=2*NSLOT*SLOTB, LDS_OST=LDS_WS+NW*64*4, LDS_BYTES=LDS_OST+NW*4096;
constexpr float C2=0.125f*1.4426950408889634f;
__device__ __forceinline__ void glds16(const void*gsrc,unsigned lds_dst){unsigned keep;
  asm volatile("s_mov_b32 %0, m0\n\ts_mov_b32 m0, %2\n\ts_nop 0\n\tglobal_load_lds_dwordx4 %1, off\n\ts_mov_b32 m0, %0":"=&s"(keep):"v"(gsrc),"s"(lds_dst):"memory");}
__device__ __forceinline__ float max3f(float a,float b,float c){float r;asm("v_max3_f32 %0, %1, %2, %3":"=v"(r):"v"(a),"v"(b),"v"(c));return r;}
__device__ __forceinline__ float max2f(float a,float b){float r;asm("v_max_f32_e32 %0, %1, %2":"=v"(r):"v"(a),"v"(b));return r;}
__device__ __forceinline__ float fadd_s(float a,float b){float r;asm("v_add_f32_e32 %0, %1, %2":"=v"(r):"v"(a),"v"(b));return r;}
__device__ __forceinline__ float fsub_s(float a,float b){float r;asm("v_sub_f32_e32 %0, %1, %2":"=v"(r):"v"(a),"v"(b));return r;}
typedef float f32x2_t __attribute__((ext_vector_type(2))); typedef __bf16 bf16x2_t __attribute__((ext_vector_type(2)));
__device__ __forceinline__ unsigned cvtpk_s(float lo,float hi){f32x2_t v={lo,hi};bf16x2_t b=__builtin_convertvector(v,bf16x2_t);return __builtin_bit_cast(unsigned,b);}
#define WAIT_BAR(N) asm volatile("s_waitcnt vmcnt(" #N ") lgkmcnt(0)\n\ts_barrier":::"memory")

__device__ __forceinline__ void qkt(f32x16&p0,f32x16&p1,const char*Kslot,const bf16x8*qr,const f32x16&negm,int r32,int hi){
  const char*kb=Kslot+hi*1024+r32*16;
  #pragma unroll
  for(int d0=0;d0<4;++d0){
    const bf16x8 b0=*reinterpret_cast<const bf16x8*>(kb+d0*2048);
    const bf16x8 b1=*reinterpret_cast<const bf16x8*>(kb+d0*2048+512);
    if(d0==0){p0=__builtin_amdgcn_mfma_f32_32x32x16_bf16(b0,qr[0],negm,0,0,0);p1=__builtin_amdgcn_mfma_f32_32x32x16_bf16(b1,qr[0],negm,0,0,0);}
    else{p0=__builtin_amdgcn_mfma_f32_32x32x16_bf16(b0,qr[d0],p0,0,0,0);p1=__builtin_amdgcn_mfma_f32_32x32x16_bf16(b1,qr[d0],p1,0,0,0);}}
}
typedef __attribute__((address_space(3))) const char* lds_cptr;
typedef short v4i16_t __attribute__((ext_vector_type(4)));
__device__ __forceinline__ void kload8(bf16x8*kf,lds_cptr kp){
  kf[0]=*(const __attribute__((address_space(3))) bf16x8*)(kp);      kf[1]=*(const __attribute__((address_space(3))) bf16x8*)(kp+512);
  kf[2]=*(const __attribute__((address_space(3))) bf16x8*)(kp+2048); kf[3]=*(const __attribute__((address_space(3))) bf16x8*)(kp+2560);
  kf[4]=*(const __attribute__((address_space(3))) bf16x8*)(kp+4096); kf[5]=*(const __attribute__((address_space(3))) bf16x8*)(kp+4608);
  kf[6]=*(const __attribute__((address_space(3))) bf16x8*)(kp+6144); kf[7]=*(const __attribute__((address_space(3))) bf16x8*)(kp+6656);
}
__device__ __forceinline__ void kload2(bf16x8*kf,lds_cptr kp,int j){ kf[2*j]=*(const __attribute__((address_space(3))) bf16x8*)(kp+j*2048); kf[2*j+1]=*(const __attribute__((address_space(3))) bf16x8*)(kp+j*2048+512); }
__device__ __forceinline__ s16x4 vtr(lds_cptr p){ return __builtin_bit_cast(s16x4,__builtin_amdgcn_ds_read_tr16_b64_v4i16((__attribute__((address_space(3))) v4i16_t*)p)); }
__device__ __forceinline__ float rowmax(const f32x16&p0,const f32x16&p1){
  float a=max3f(p0[0],p0[1],p1[0]),b=max3f(p0[2],p0[3],p1[1]);a=max3f(a,p1[2],p1[3]);
  #pragma unroll
  for(int r=4;r<16;r+=4){a=max3f(a,p0[r],p0[r+1]);b=max3f(b,p0[r+2],p0[r+3]);a=max3f(a,p1[r],p1[r+1]);b=max3f(b,p1[r+2],p1[r+3]);}
  const float m=max2f(a,b);
  auto rr=__builtin_amdgcn_permlane32_swap(__float_as_uint(m),__float_as_uint(m),false,false);
  return max2f(__uint_as_float(rr[0]),__uint_as_float(rr[1]));
}
__device__ __forceinline__ void pv(f32x16*o,int vb,bf16x8 pa0,bf16x8 pa1,bf16x8 pa2,bf16x8 pa3){
  #pragma unroll
  for(int d0=0;d0<2;++d0){s16x4 lo[4],hi[4];
    #pragma unroll
    for(int ks=0;ks<4;++ks){
      asm volatile("ds_read_b64_tr_b16 %0,%1 offset:%c2":"=&v"(lo[ks]):"v"(vb),"i"(d0*4096+ks*1024):"memory");
      asm volatile("ds_read_b64_tr_b16 %0,%1 offset:%c2":"=&v"(hi[ks]):"v"(vb),"i"(d0*4096+ks*1024+512):"memory");}
    asm volatile("s_waitcnt lgkmcnt(0)":::"memory");SBAR();
    #define PK(k) (bf16x8){lo[k][0],lo[k][1],lo[k][2],lo[k][3],hi[k][0],hi[k][1],hi[k][2],hi[k][3]}
    o[d0]=__builtin_amdgcn_mfma_f32_32x32x16_bf16(pa0,PK(0),o[d0],0,0,0);
    o[d0]=__builtin_amdgcn_mfma_f32_32x32x16_bf16(pa1,PK(1),o[d0],0,0,0);
    o[d0]=__builtin_amdgcn_mfma_f32_32x32x16_bf16(pa2,PK(2),o[d0],0,0,0);
    o[d0]=__builtin_amdgcn_mfma_f32_32x32x16_bf16(pa3,PK(3),o[d0],0,0,0);
    #undef PK
  }
}

#ifndef ATTN_STORE16
#define ATTN_STORE16(p,v) (*(u32x4*)(p)=(v))
#endif
template<int THRL> __device__ __forceinline__ void attn_unit(const AttnJob&J,char*shm){
  const int tid=otid(),lane=tid&63,r32=lane&31,hi=lane>>5; const int wid=__builtin_amdgcn_readfirstlane(tid>>6);
  const int q0=J.q0;
  const bf16*Qw=J.Q+(long)(q0+wid*QBLK)*PQ;
  const bf16*Kh=J.K,*Vh=J.V;
  const unsigned lds0=(unsigned)(uintptr_t)shm;
  float*wsf=(float*)(shm+LDS_WS)+wid*64;
  const bf16*ksrc=Kh+(long)lane*PKV+wid*8;
  const bf16*vsrc=Vh+(long)(16*(wid&3)+(lane>>2))*PKV+(wid>>2)*32+(lane&3)*8;
  const unsigned kdst=lds0+LDS_K+wid*1024, vdst=lds0+LDS_V+wid*1024;
  #define TROW(t) (((t)<nA)?(rA+64*(t)):(rB+64*((t)-nA)))
  #define DMA_K(t,slot) glds16(ksrc+(long)TROW(t)*PKV,(unsigned)__builtin_amdgcn_readfirstlane(kdst+(slot)))
  #define DMA_V(t,slot) glds16(vsrc+(long)TROW(t)*PKV,(unsigned)__builtin_amdgcn_readfirstlane(vdst+(slot)))
  const int vb0=(int)(lds0+LDS_V)+((lane>>4)&1)*32+(lane&3)*8+(4*hi+((lane&15)>>2))*64;
  const char*Kbase=shm+LDS_K; bf16x8 kf[8];
  const lds_cptr shm3=(lds_cptr)shm; const lds_cptr kp0=shm3+LDS_K+hi*1024+r32*16; const lds_cptr vp0=shm3+LDS_V+((lane>>4)&1)*32+(lane&3)*8+(4*hi+((lane&15)>>2))*64;
  const int NT=J.NT,nA=J.nA,rA=J.rA,rB=J.rB; const bool msk=(J.masked!=0);
  DMA_K(0,0);DMA_V(0,0);DMA_K(1,SLOTB);
  bf16x8 qr[4];
  #pragma unroll
  for(int d0=0;d0<4;++d0)qr[d0]=*reinterpret_cast<const bf16x8*>(&Qw[(long)r32*PQ+d0*16+hi*8]);
  float mhat=0.f,l_reg=0.f;f32x16 o[2];o[0]=f32x16{};o[1]=f32x16{};f32x16 negm=f32x16{};asm volatile("":"+v"(negm));
  const int qpos=q0+wid*QBLK+r32;
  #define CMASK(P0,P1,t) do{ if(msk&&(t)>=nA)wmask(P0,P1,TROW(t)+4*hi-qpos); }while(0)
  bool resc=false;
  const bool nomax=(J.mfix>0.f);
  #define START(P0,P1) do{ const float rm=nomax?J.mfix:rowmax(P0,P1); resc=false; \
    { const float dl=rm; mhat=fadd_s(mhat,dl); \
      _Pragma("unroll") for(int r=0;r<16;++r){P0[r]=fsub_s(P0[r],dl);P1[r]=fsub_s(P1[r],dl);} \
      _Pragma("unroll") for(int r=0;r<16;++r)negm[r]=-mhat; asm volatile("":"+v"(negm)); } \
    _Pragma("unroll") for(int r=0;r<16;++r)P0[r]=__builtin_amdgcn_exp2f(P0[r]); }while(0)
  #define RESC() do{ if(resc){ asm volatile("s_waitcnt lgkmcnt(0)":::"memory"); \
      _Pragma("unroll") for(int d_=0;d_<2;++d_) _Pragma("unroll") for(int r=0;r<16;++r)o[d_][r]*=wsf[crow(r,hi)]; } }while(0)
  f32x16 pA0,pA1,pB0,pB1;
  int sl_prev=0,sl_cur=0,sl_next=SLOTB;
  #define ROT() do{sl_prev=sl_cur;sl_cur=sl_next;sl_next=(sl_next==(NSLOT-1)*SLOTB)?0:sl_next+SLOTB;}while(0)
  DMA_K(2,2*SLOTB);
  WAIT_BAR(3);
  qkt(pA0,pA1,Kbase,qr,negm,r32,hi);asm volatile("s_nop 15\n\ts_nop 7":"+v"(pA0),"+v"(pA1));CMASK(pA0,pA1,0);
  START(pA0,pA1);
  _Pragma("unroll") for(int r=0;r<16;++r)pA1[r]=__builtin_amdgcn_exp2f(pA1[r]);
  WAIT_BAR(0);
  DMA_K(3,0);DMA_V(1,SLOTB);
  ROT();
  kload8(kf,kp0+sl_cur);
  WAIT_BAR(2);
  s16x4 vlo[8],vhi[8]; u32x4 pw0,pw1,pw2,pw3;
  #define PKW(P,B) cvtpk_s(P[B],P[B+1])
  #define PAF(k) __builtin_bit_cast(bf16x8,pw##k)
  #define VFR(i) (bf16x8){vlo[i][0],vlo[i][1],vlo[i][2],vlo[i][3],vhi[i][0],vhi[i][1],vhi[i][2],vhi[i][3]}
  #define PIN(x) asm volatile("":"+v"(x))
  #define MX3(a,b,c) __builtin_fmaxf(__builtin_fmaxf((a),(b)),(c))
  #define GAPA(MF,A0,A1,A2,A3,W0,W1,PW) do{ MF; sacc+=A0; sacc+=A1; sacc+=A2; sacc+=A3; PIN(sacc); W0; W1; PIN(PW); SBAR(); }while(0)
  #define EX(v) __builtin_amdgcn_exp2f(v)
  #define GAPB(MF,X,B) do{ MF; X[B]=EX(X[B]); X[B+1]=EX(X[B+1]); X[B+2]=EX(X[B+2]); X[B+3]=EX(X[B+3]); PIN(X); SBAR(); }while(0)
  #define VRD(i) do{ vlo[i]=vtr(vp_+(((i)>>2)*4096+((i)&3)*1024)); vhi[i]=vtr(vp_+(((i)>>2)*4096+((i)&3)*1024+512)); }while(0)
  #define KRD(G,j) do{ if(G){ kload2(kf,kp0+sl_next,j); SBAR(); } }while(0)
  #define STEP(C0,C1,P0,P1,t,GK,GV,GL) do{ SBAR(); \
    const lds_cptr vp_=vp0+sl_prev; \
    VRD(0); SBAR(); float sacc=(P0[0]+P0[1]); \
    GAPA(C0=__builtin_amdgcn_mfma_f32_32x32x16_bf16(kf[0],qr[0],negm,0,0,0), P0[2],P0[3],P0[4],P0[5],     pw0[0]=PKW(P0,0), pw0[1]=PKW(P0,2), pw0); \
    VRD(4); SBAR(); GAPA(C1=__builtin_amdgcn_mfma_f32_32x32x16_bf16(kf[1],qr[0],negm,0,0,0), P0[6],P0[7],P0[8],P0[9],     pw0[2]=PKW(P0,4), pw0[3]=PKW(P0,6), pw0); \
    VRD(1); SBAR(); GAPA(C0=__builtin_amdgcn_mfma_f32_32x32x16_bf16(kf[2],qr[1],C0,0,0,0),   P0[10],P0[11],P0[12],P0[13], pw1[0]=PKW(P0,8), pw1[1]=PKW(P0,10), pw1); \
    VRD(5); SBAR(); GAPA(C1=__builtin_amdgcn_mfma_f32_32x32x16_bf16(kf[3],qr[1],C1,0,0,0),   P0[14],P0[15],P1[0],P1[1],   pw1[2]=PKW(P0,12),pw1[3]=PKW(P0,14), pw1); \
    VRD(2); SBAR(); GAPA(C0=__builtin_amdgcn_mfma_f32_32x32x16_bf16(kf[4],qr[2],C0,0,0,0),   P1[2],P1[3],P1[4],P1[5],     pw2[0]=PKW(P1,0), pw2[1]=PKW(P1,2), pw2); \
    VRD(6); SBAR(); GAPA(C1=__builtin_amdgcn_mfma_f32_32x32x16_bf16(kf[5],qr[2],C1,0,0,0),   P1[6],P1[7],P1[8],P1[9],     pw2[2]=PKW(P1,4), pw2[3]=PKW(P1,6), pw2); \
    VRD(3); SBAR(); GAPA(C0=__builtin_amdgcn_mfma_f32_32x32x16_bf16(kf[6],qr[3],C0,0,0,0),   P1[10],P1[11],P1[12],P1[13], pw3[0]=PKW(P1,8), pw3[1]=PKW(P1,10), pw3); \
    VRD(7); SBAR(); GAPA(C1=__builtin_amdgcn_mfma_f32_32x32x16_bf16(kf[7],qr[3],C1,0,0,0),   P1[14],P1[15],0.f,0.f,       pw3[2]=PKW(P1,12),pw3[3]=PKW(P1,14), pw3); \
    l_reg+=sacc; \
    if(GK){DMA_K((t)+3,sl_cur);} if(GV){DMA_V((t)+1,sl_next);} \
    CMASK(C0,C1,t); \
    resc=false; if(!nomax){ float a=MX3(C0[0],C0[1],C1[0]),b=MX3(C0[2],C0[3],C1[1]); a=MX3(a,C1[2],C1[3]); \
      _Pragma("unroll") for(int r=4;r<16;r+=4){a=MX3(a,C0[r],C0[r+1]);b=MX3(b,C0[r+2],C0[r+3]);a=MX3(a,C1[r],C1[r+1]);b=MX3(b,C1[r+2],C1[r+3]);} \
      float rm=__builtin_fmaxf(a,b); { auto rr=__builtin_amdgcn_permlane32_swap(__float_as_uint(rm),__float_as_uint(rm),false,false); rm=__builtin_fmaxf(__uint_as_float(rr[0]),__uint_as_float(rr[1])); } \
      resc=false; \
      if(__builtin_expect(__any(rm>(float)THRL),0)){ const float dl=__builtin_fmaxf(rm,0.f); mhat+=dl; \
        _Pragma("unroll") for(int r=0;r<16;++r){C0[r]-=dl;C1[r]-=dl;} \
        _Pragma("unroll") for(int r=0;r<16;++r)negm[r]=-mhat; asm volatile("":"+v"(negm)); \
        const float f=__builtin_amdgcn_exp2f(-dl); l_reg*=f; if(hi==0)wsf[r32]=f; resc=true; } } \
    SBAR(); \
    GAPB(o[0]=__builtin_amdgcn_mfma_f32_32x32x16_bf16(PAF(0),VFR(0),o[0],0,0,0), C0,0); \
    GAPB(o[1]=__builtin_amdgcn_mfma_f32_32x32x16_bf16(PAF(0),VFR(4),o[1],0,0,0), C0,4); \
    KRD(GL,0); GAPB(o[0]=__builtin_amdgcn_mfma_f32_32x32x16_bf16(PAF(1),VFR(1),o[0],0,0,0), C0,8); \
    KRD(GL,1); GAPB(o[1]=__builtin_amdgcn_mfma_f32_32x32x16_bf16(PAF(1),VFR(5),o[1],0,0,0), C0,12); \
    KRD(GL,2); GAPB(o[0]=__builtin_amdgcn_mfma_f32_32x32x16_bf16(PAF(2),VFR(2),o[0],0,0,0), C1,0); \
    KRD(GL,3); GAPB(o[1]=__builtin_amdgcn_mfma_f32_32x32x16_bf16(PAF(2),VFR(6),o[1],0,0,0), C1,4); \
    GAPB(o[0]=__builtin_amdgcn_mfma_f32_32x32x16_bf16(PAF(3),VFR(3),o[0],0,0,0), C1,8); \
    GAPB(o[1]=__builtin_amdgcn_mfma_f32_32x32x16_bf16(PAF(3),VFR(7),o[1],0,0,0), C1,12); \
    }while(0)
  int t=1;
  #undef CMASK
  #define CMASK(P0,P1,t) do{}while(0)
  for(;(!msk)&&t+5<NT;t+=2){
    STEP(pB0,pB1,pA0,pA1,t,true,true,true);     WAIT_BAR(2); RESC(); ROT();
    STEP(pA0,pA1,pB0,pB1,t+1,true,true,true);   WAIT_BAR(2); RESC(); ROT();
  }
  #undef CMASK
  #define CMASK(P0,P1,t) do{ if(msk&&(t)>=nA)wmask(P0,P1,TROW(t)+4*hi-qpos); }while(0)
  #define ENDW(tt) do{ if((tt)+3<NT){WAIT_BAR(2);} else if((tt)+2<NT){WAIT_BAR(1);} else {WAIT_BAR(0);} }while(0)
  for(;t+1<NT;t+=2){
    STEP(pB0,pB1,pA0,pA1,t,(t+3<NT),(t+1<NT),(t+1<NT));       ENDW(t);   RESC(); ROT();
    STEP(pA0,pA1,pB0,pB1,t+1,(t+4<NT),(t+2<NT),(t+2<NT));     ENDW(t+1); RESC(); ROT();
  }
  STEP(pB0,pB1,pA0,pA1,NT-1,false,false,false); RESC();
  { float sacc=pB0[0]+pB0[1]; _Pragma("unroll") for(int r=2;r<16;++r)sacc+=pB0[r]; _Pragma("unroll") for(int r=0;r<16;++r)sacc+=pB1[r]; l_reg+=sacc;
    pw0=(u32x4){PKW(pB0,0),PKW(pB0,2),PKW(pB0,4),PKW(pB0,6)};pw1=(u32x4){PKW(pB0,8),PKW(pB0,10),PKW(pB0,12),PKW(pB0,14)};pw2=(u32x4){PKW(pB1,0),PKW(pB1,2),PKW(pB1,4),PKW(pB1,6)};pw3=(u32x4){PKW(pB1,8),PKW(pB1,10),PKW(pB1,12),PKW(pB1,14)};
    SBAR(); pv(o,vb0+sl_cur,PAF(0),PAF(1),PAF(2),PAF(3)); }
  #undef PKW
  #undef PAF
  #undef VFR
  #undef PIN
  #undef MX3
  #undef GAPA
  #undef GAPB
  #undef EX
  #undef VRD
  #undef KRD
  #undef STEP
  #undef ENDW
  if(hi==0)l_reg+=__builtin_amdgcn_exp2f(J.sink_l2-mhat);
  {auto rr=__builtin_amdgcn_permlane32_swap(__float_as_uint(l_reg),__float_as_uint(l_reg),false,false);l_reg=__uint_as_float(rr[0])+__uint_as_float(rr[1]);}
  if(hi==0)wsf[32+r32]=l_reg;asm volatile("s_waitcnt lgkmcnt(0)":::"memory");
  float rli[16];
  #pragma unroll
  for(int r=0;r<16;++r)rli[r]=__builtin_amdgcn_rcpf(wsf[32+crow(r,hi)]);
  bf16*Ow=J.O+(long)(q0+wid*QBLK)*PO;
  { bf16*stg=(bf16*)(shm+LDS_OST)+wid*2048;
    #pragma unroll
    for(int r=0;r<16;++r){const int orow=crow(r,hi);
      #pragma unroll
      for(int d0=0;d0<2;++d0)stg[orow*64+d0*32+r32]=__float2bfloat16(o[d0][r]*rli[r]);}
    asm volatile("s_waitcnt lgkmcnt(0)":::"memory");
    #pragma unroll
    for(int i=0;i<4;++i){const int row=i*8+(lane>>3),ch=lane&7; const u32x4 v=*(const u32x4*)(stg+row*64+ch*8); ATTN_STORE16(Ow+(long)row*PO+ch*8,v);} }
  asm volatile("s_waitcnt lgkmcnt(0)\n\ts_barrier":::"memory");
  #undef DMA_K
  #undef TROW
  #undef DMA_V
  #undef CMASK
  #undef START
  #undef RESC
  #undef ROT
}
constexpr int ATTN_LDS_BYTES=LDS_BYTES;
#undef SBAR
#undef WAIT_BAR
}

#define DPPF(v, ctrl) __builtin_bit_cast(float, __builtin_amdgcn_update_dpp(0, __builtin_bit_cast(int, (v)), (ctrl), 0xF, 0xF, false))
struct Args { const float* in[34]; float* out; unsigned char* ws; int ph_lo, ph_hi; };
enum { I_X = 0, I_C, I_CTX, I_CCTX, I_WADA, I_BADA, I_NMIX, I_NFFN, I_WIN, I_BIN, I_CONVW, I_CONVB, I_FW1, I_FB1, I_FW2, I_FB2, I_FW3, I_FB3, I_FFREQ, I_FOUT, I_SKIP,
       I_QNORM, I_KNORM, I_SINK, I_BNORM, I_WOUT, I_BOUT, I_WR, I_BR, I_W1, I_B1, I_W2, I_B2, I_NFINAL };

#define KARG_PTRS ((const void* const __attribute__((address_space(4)))*)__builtin_amdgcn_kernarg_segment_ptr())
__device__ __forceinline__ unsigned char* ws_ptr(const Args&) { int i = 35; asm volatile("" : "+s"(i)); return (unsigned char*)KARG_PTRS[i]; }
__device__ __forceinline__ bool in_range(const Args&, int k) { int i = 72; asm volatile("" : "+s"(i)); const int __attribute__((address_space(4)))* p = (const int __attribute__((address_space(4)))*)__builtin_amdgcn_kernarg_segment_ptr(); const int lo = p[i], hi = p[i + 1]; return lo <= k && k < hi; }
#define WSP(T, off) ((T*)(ws_ptr(A) + (off)))
__device__ __forceinline__ const float* inp_ptr(const Args&, int i) { asm volatile("" : "+s"(i)); return (const float*)KARG_PTRS[i]; }
#define INP(i) inp_ptr(A, (i))
__device__ __forceinline__ int lat_row(int i) { return (i >> 12) * TPB + (i & 4095); }
__device__ __forceinline__ int lat_tile(int i) { return (i >> 4) * 17 + (i & 15); }

struct SchedProj {
    const char* Ab; const char* Bb; int l, G, c;
    __device__ __forceinline__ bool next(int i, pg8::Unit& u) const {
        const int L = i * G + c;
        u.idx = i; if (l == 0) { if (L >= 136 * 8) return false; u.pm = L >> 3; u.pn = L & 7; return true; }
        if (L < 1024) { u.pm = lat_tile(L >> 3); u.pn = L & 7; return true; }
        const int j = L - 1024; if (j >= 24) return false;
        const int b = j / 3, q = j - 3 * b; u.pm = b * 17 + 16; u.pn = q == 0 ? 4 : (q == 1 ? 5 : 7); return true;
    }
    __device__ __forceinline__ const char* abase(const pg8::Unit& u) const { return Ab + (size_t)u.pm * (256 * 1024 * 2); }
    __device__ __forceinline__ const char* bbase(const pg8::Unit& u) const { return Bb + (size_t)u.pn * (256 * 1024 * 2); }
    __device__ __forceinline__ int arow_idx(int, int) const { return 0; }
};
struct EpiProj {
    static constexpr bool PERM = true; static constexpr int NDMA = 1;
    bf16* P; const float* bias; bf16* VC;
    __device__ __forceinline__ const float* bias_src(const pg8::Unit& u, int lane, int) const { return bias + u.pn * 256 + 4 * lane; }
    __device__ __forceinline__ void operator()(const f32x4 (&acc)[2][2][4][2], const pg8::Unit& u, int wr, int wc, int fr, int fq, const LAS unsigned char* bl) const {
        const int row0 = u.pm * 256 + wr * 64 + fr, col0 = u.pn * 256 + wc * 32 + 8 * fq;
        f32x4 bv[2][2];
#pragma unroll
        for (int bj = 0; bj < 2; ++bj)
#pragma unroll
            for (int n = 0; n < 2; ++n) bv[bj][n] = *(const LAS f32x4*)(bl + (wc * 32 + 8 * fq + bj * 128 + 4 * n) * 4);
#pragma unroll
        for (int ai = 0; ai < 2; ++ai)
#pragma unroll
            for (int m = 0; m < 4; ++m) { bf16* rowp = P + (size_t)(row0 + ai * 128 + m * 16) * INW + col0;
#pragma unroll
                for (int bj = 0; bj < 2; ++bj) { const f32x4 v0 = acc[ai][bj][m][0] + bv[bj][0], v1 = acc[ai][bj][m][1] + bv[bj][1];
                    v4u w; w.x = pg8::cvt_pk_bf16(v0[0], v0[1]); w.y = pg8::cvt_pk_bf16(v0[2], v0[3]); w.z = pg8::cvt_pk_bf16(v1[0], v1[1]); w.w = pg8::cvt_pk_bf16(v1[2], v1[3]);
                    const bool isv = (bj == 0) ? (u.pn == 5) : (u.pn == 7);
                    if (isv) { const int r = row0 + ai * 128 + m * 16, b = r / TPB, t = r - b * TPB, c = wc * 32 + 8 * fq;
                        *(v4u*)(VC + ((size_t)(((bj * 8 + b) * 2 + (c >> 6))) * TPB + t) * 64 + (c & 63)) = w; }
                    else *(v4u*)(rowp + bj * 128) = w; } }
    }
};
struct SchedOut {
    const char* Ab; const char* Bb; int l, G, c;
    __device__ __forceinline__ bool next(int i, pg8::Unit& u) const {
        const int L = i * G + c;
        u.idx = i; if (l == 0) { if (L >= 136 * 4) return false; u.pm = L >> 2; u.pn = L & 3; return true; }
        if (L >= 128 * 4) return false; u.pm = lat_tile(L >> 2); u.pn = L & 3; return true;
    }
    __device__ __forceinline__ const char* abase(const pg8::Unit& u) const { return Ab + (size_t)u.pm * (256 * 1024 * 2); }
    __device__ __forceinline__ const char* bbase(const pg8::Unit& u) const { return Bb + (size_t)u.pn * (256 * 1024 * 2); }
    __device__ __forceinline__ int arow_idx(int, int) const { return 0; }
};
struct EpiOut {
    static constexpr bool PERM = true; static constexpr int NDMA = 2;
    bf16* X; const float* bias; const float* g1;
    const float* xin; const float* cin;
    __device__ __forceinline__ const float* bias_src(const pg8::Unit& u, int lane, int j) const {
        const int tb = u.pm / 17, tt = u.pm - 17 * tb, mi = (tt == 16) ? 8 : tb;
        return (j == 0 ? bias : g1 + mi * 6144) + u.pn * 256 + 4 * lane; }
    __device__ __forceinline__ void operator()(const f32x4 (&acc)[2][2][4][2], const pg8::Unit& u, int wr, int wc, int fr, int fq, const LAS unsigned char* bl) const {
        const int col0 = u.pn * 256 + wc * 32 + 8 * fq;
        const int tb = u.pm / 17, tt = u.pm - 17 * tb;
        bf16* db = X + (size_t)u.pm * 256 * DM;
        const float* sb = (tt == 16) ? cin + (size_t)tb * CTXL * DM : xin + ((size_t)tb * SEQ + tt * 256) * DM;
        if (!xin) {
            f32x4 bv[2][2], gv[2][2];
#pragma unroll
            for (int bj = 0; bj < 2; ++bj)
#pragma unroll
                for (int n = 0; n < 2; ++n) { bv[bj][n] = *(const LAS f32x4*)(bl + (wc * 32 + 8 * fq + bj * 128 + 4 * n) * 4); gv[bj][n] = *(const LAS f32x4*)(bl + 1024 + (wc * 32 + 8 * fq + bj * 128 + 4 * n) * 4); }
#pragma unroll
            for (int ai = 0; ai < 2; ++ai) { v4u w_[4][2];
#pragma unroll
                for (int m = 0; m < 4; ++m)
#pragma unroll
                    for (int bj = 0; bj < 2; ++bj) w_[m][bj] = *(const v4u*)(db + (wr * 64 + fr + ai * 128 + m * 16) * DM + col0 + bj * 128);
#pragma unroll
                for (int m = 0; m < 4; ++m)
#pragma unroll
                    for (int bj = 0; bj < 2; ++bj) { const v4u w = w_[m][bj]; const int off = (wr * 64 + fr + ai * 128 + m * 16) * DM + col0 + bj * 128;
                        const f32x4 y0 = (f32x4){bflo(w.x), bfhi(w.x), bflo(w.y), bfhi(w.y)} + gv[bj][0] * (acc[ai][bj][m][0] + bv[bj][0]), y1 = (f32x4){bflo(w.z), bfhi(w.z), bflo(w.w), bfhi(w.w)} + gv[bj][1] * (acc[ai][bj][m][1] + bv[bj][1]);
                        v4u o; o.x = pg8::cvt_pk_bf16(y0[0], y0[1]); o.y = pg8::cvt_pk_bf16(y0[2], y0[3]); o.z = pg8::cvt_pk_bf16(y1[0], y1[1]); o.w = pg8::cvt_pk_bf16(y1[2], y1[3]);
                        *(v4u*)(db + off) = o; } }
            return; }
#pragma unroll
        for (int ai = 0; ai < 2; ++ai) { f32x4 x0[4][2], x1[4][2];
#pragma unroll
            for (int m = 0; m < 4; ++m)
#pragma unroll
                for (int bj = 0; bj < 2; ++bj) { const int off = (wr * 64 + fr + ai * 128 + m * 16) * DM + col0 + bj * 128; x0[m][bj] = *(const f32x4*)(sb + off); x1[m][bj] = *(const f32x4*)(sb + off + 4); }
#pragma unroll
            for (int m = 0; m < 4; ++m)
#pragma unroll
                for (int bj = 0; bj < 2; ++bj) { const int off = (wr * 64 + fr + ai * 128 + m * 16) * DM + col0 + bj * 128;
                    asm volatile("" ::: "memory");
                    const LAS unsigned char* bp = bl + (wc * 32 + 8 * fq + bj * 128) * 4;
                    v4u o;
                    { const f32x4 b0 = *(const LAS f32x4*)bp, g0 = *(const LAS f32x4*)(bp + 1024); const f32x4 y0 = x0[m][bj] + g0 * (acc[ai][bj][m][0] + b0); o.x = pg8::cvt_pk_bf16(y0[0], y0[1]); o.y = pg8::cvt_pk_bf16(y0[2], y0[3]); }
                    { const f32x4 b1 = *(const LAS f32x4*)(bp + 16), g1_ = *(const LAS f32x4*)(bp + 1040); const f32x4 y1 = x1[m][bj] + g1_ * (acc[ai][bj][m][1] + b1); o.z = pg8::cvt_pk_bf16(y1[0], y1[1]); o.w = pg8::cvt_pk_bf16(y1[2], y1[3]); }
                    *(v4u*)(db + off) = o; } }
    }
};
struct SchedMoe {
    const char* Ab; const char* Bb; const LAS int* rows; const LAS unsigned char* blkexp; int nblk, npn_shift, G, c; size_t bexp_stride;
    __device__ __forceinline__ bool next(int i, pg8::Unit& u) const {
        const int L = i * G + c; const int blk = L >> npn_shift; if (blk >= nblk) return false;
        u.pm = blk; u.pn = L & ((1 << npn_shift) - 1); u.idx = i; return true;
    }
    __device__ __forceinline__ int expert(const pg8::Unit& u) const { return __builtin_amdgcn_readfirstlane((int)blkexp[u.pm]); }
    __device__ __forceinline__ const char* abase(const pg8::Unit& u) const { return rows ? Ab : Ab + (size_t)u.pm * (256 * 1024); }
    __device__ __forceinline__ const char* bbase(const pg8::Unit& u) const { return Bb + (size_t)expert(u) * bexp_stride + (size_t)u.pn * (256 * 1024); }
    __device__ __forceinline__ int arow_idx(int idx, int r) const { return rows[idx * 256 + r]; }
};
__device__ __forceinline__ v4u pair16(v2u wm, v2u wn) {
    unsigned ax = wm.x, bx = wn.x, ay = wm.y, by = wn.y;
    asm volatile("s_nop 1\n\tv_permlane16_swap_b32 %0, %1" : "+v"(ax), "+v"(bx));
    asm volatile("s_nop 1\n\tv_permlane16_swap_b32 %0, %1" : "+v"(ay), "+v"(by));
    return (v4u){ax, ay, bx, by};
}
struct EpiGlu {
    static constexpr bool PERM = true; static constexpr int NDMA = 1;
    unsigned char* ACT; const float* b1; const SchedMoe* S; int dry;
    __device__ __forceinline__ const float* bias_src(const pg8::Unit& u, int lane, int) const {
        return b1 + S->expert(u) * 2048 + ((lane >> 5) << 10) + u.pn * 128 + 4 * (lane & 31); }
    __device__ __forceinline__ void operator()(const f32x4 (&acc)[2][2][4][2], const pg8::Unit& u, int wr, int wc, int fr, int fq, const LAS unsigned char* bls) const {
        if (dry) return;
        const int row0 = u.pm * 256 + wr * 64 + fr, j0 = u.pn * 128 + wc * 32 + 8 * fq;
        f32x4 bg[2], bl[2];
#pragma unroll
        for (int n = 0; n < 2; ++n) { bg[n] = *(const LAS f32x4*)(bls + (wc * 32 + 8 * fq + 4 * n) * 4); bl[n] = *(const LAS f32x4*)(bls + 512 + (wc * 32 + 8 * fq + 4 * n) * 4); }
#pragma unroll
        for (int ai = 0; ai < 2; ++ai)
#pragma unroll
            for (int mp = 0; mp < 2; ++mp) { v2u wv[2];
#pragma unroll
              for (int mm = 0; mm < 2; ++mm) { const int m = 2 * mp + mm;
                float o[8];
#pragma unroll
                for (int n = 0; n < 2; ++n) { const f32x4 g = acc[ai][0][m][n] + bg[n], li = acc[ai][1][m][n] + bl[n];
#pragma unroll
                    for (int q = 0; q < 4; q += 2) {
                        const f32x2 gl = (f32x2){fminf(g[q], 7.0f), fminf(g[q + 1], 7.0f)};
                        const f32x2 ln1 = (f32x2){__builtin_amdgcn_fmed3f(li[q], -7.0f, 7.0f), __builtin_amdgcn_fmed3f(li[q + 1], -7.0f, 7.0f)} + 1.0f;
                        const f32x2 ea = gl * (-1.702f * LOG2E);
                        const f32x2 den = (f32x2){__builtin_amdgcn_exp2f(ea.x), __builtin_amdgcn_exp2f(ea.y)} + 1.0f;
                        const f32x2 sg = (f32x2){__builtin_amdgcn_rcpf(den.x), __builtin_amdgcn_rcpf(den.y)};
                        const f32x2 r = (gl * sg) * ln1;
                        o[4 * n + q] = r.x; o[4 * n + q + 1] = r.y; } }
                wv[mm].x = cvt4_fp8(o[0], o[1], o[2], o[3]); wv[mm].y = cvt4_fp8(o[4], o[5], o[6], o[7]); }
              const v4u w16 = pair16(wv[0], wv[1]);
              const unsigned off = (unsigned)(row0 + ai * 128 + (2 * mp + (fq & 1)) * 16) * (unsigned)DM + (unsigned)(j0 - 8 * (fq & 1));
              *(v4u*)(ACT + off) = w16; }
    }
};
struct EpiOuts {
    static constexpr bool PERM = true; static constexpr int NDMA = 1;
    unsigned char* O; const float* b2; const SchedMoe* S; int dry;
    __device__ __forceinline__ const float* bias_src(const pg8::Unit& u, int lane, int) const { return b2 + S->expert(u) * 1024 + u.pn * 256 + 4 * lane; }
    __device__ __forceinline__ void operator()(const f32x4 (&acc)[2][2][4][2], const pg8::Unit& u, int wr, int wc, int fr, int fq, const LAS unsigned char* bl) const {
        if (dry) return;
        const int row0 = u.pm * 256 + wr * 64 + fr, col0 = u.pn * 256 + wc * 32 + 8 * fq;
        f32x4 bv[2][2];
#pragma unroll
        for (int bj = 0; bj < 2; ++bj)
#pragma unroll
            for (int n = 0; n < 2; ++n) bv[bj][n] = *(const LAS f32x4*)(bl + (wc * 32 + 8 * fq + bj * 128 + 4 * n) * 4);
#pragma unroll
        for (int ai = 0; ai < 2; ++ai)
#pragma unroll
            for (int mp = 0; mp < 2; ++mp)
#pragma unroll
                for (int bj = 0; bj < 2; ++bj) { v2u wv[2];
#pragma unroll
                    for (int mm = 0; mm < 2; ++mm) { const int m = 2 * mp + mm; const f32x4 v0 = acc[ai][bj][m][0] + bv[bj][0], v1 = acc[ai][bj][m][1] + bv[bj][1];
                        wv[mm].x = cvt4_fp8(v0[0], v0[1], v0[2], v0[3]); wv[mm].y = cvt4_fp8(v1[0], v1[1], v1[2], v1[3]); }
                    const v4u w16 = pair16(wv[0], wv[1]);
                    const unsigned off = (unsigned)(row0 + ai * 128 + (2 * mp + (fq & 1)) * 16) * (unsigned)DM + (unsigned)(col0 + bj * 128 - 8 * (fq & 1));
                    *(v4u*)(O + off) = w16; }
    }
};

constexpr int CV_SMALL = 1536, CV_MOE_L = 24576;
struct CvItem { const float* W; bf16* WT; int N, row0, k0, n0, f8; };
__device__ __forceinline__ CvItem cv_decode(const Args& A, int it) {
    CvItem c; int r = it;
    if (r < 1024) { const int l = r >> 9, q = r & 511, kb = q >> 5, nb = q & 31; c.f8 = 0; c.W = INP(I_WIN) + (size_t)l * 1024 * 2048; c.WT = WSP(bf16, WS_WINT) + (size_t)l * 2048 * 1024; c.N = 2048; c.row0 = 64 * nb; c.k0 = 64 * kb; c.n0 = 64 * nb; return c; }
    r -= 1024;
    if (r < 512) { const int l = r >> 8, q = r & 255, kb = q >> 4, nb = q & 15; c.f8 = 0; c.W = INP(I_WOUT) + (size_t)l * 1024 * 1024; c.WT = WSP(bf16, WS_WOUTT) + (size_t)l * 1024 * 1024; c.N = 1024; c.row0 = 64 * nb; c.k0 = 64 * kb; c.n0 = 64 * nb; return c; }
    r -= 512;
    const int l = r / CV_MOE_L; r -= l * CV_MOE_L;
    if (r < 16384) { const int le = l * 32 + (r >> 9), q = r & 511, kb = q >> 5, nb = q & 31, n0 = 64 * nb;
        c.f8 = 1; c.W = INP(I_W1) + (size_t)le * 1024 * 2048; c.WT = (bf16*)(WSP(unsigned char, WS_W1T) + (size_t)le * 2048 * 1024); c.N = 2048; c.k0 = 64 * kb; c.n0 = n0;
        c.row0 = (n0 < 1024) ? ((n0 >> 7) * 256 + (n0 & 127)) : ((((n0 - 1024) >> 7) * 256) + 128 + ((n0 - 1024) & 127)); return c; }
    r -= 16384;
    { const int le = l * 32 + (r >> 8), q = r & 255, kb = q >> 4, nb = q & 15; c.f8 = 1; c.W = INP(I_W2) + (size_t)le * 1024 * 1024; c.WT = (bf16*)(WSP(unsigned char, WS_W2T) + (size_t)le * 1024 * 1024); c.N = 1024; c.row0 = 64 * nb; c.k0 = 64 * kb; c.n0 = 64 * nb; return c; }
}
__device__ __forceinline__ void cv_load(const CvItem& c, float (&tv)[64], int lane) {
#pragma unroll
    for (int i = 0; i < 64; ++i) tv[i] = __builtin_nontemporal_load(c.W + (size_t)(c.k0 + i) * c.N + c.n0 + lane);
}
__device__ __forceinline__ void cv_store(const CvItem& c, const float (&tv)[64], LAS float*, int lane) {
    if (c.f8) { unsigned char* dst = (unsigned char*)c.WT + (size_t)(c.row0 + lane) * 1024 + c.k0;
#pragma unroll
        for (int j = 0; j < 4; ++j) { v4u o;
            o.x = cvt4_fp8(64.f * tv[16 * j + 0], 64.f * tv[16 * j + 1], 64.f * tv[16 * j + 2], 64.f * tv[16 * j + 3]);
            o.y = cvt4_fp8(64.f * tv[16 * j + 4], 64.f * tv[16 * j + 5], 64.f * tv[16 * j + 6], 64.f * tv[16 * j + 7]);
            o.z = cvt4_fp8(64.f * tv[16 * j + 8], 64.f * tv[16 * j + 9], 64.f * tv[16 * j + 10], 64.f * tv[16 * j + 11]);
            o.w = cvt4_fp8(64.f * tv[16 * j + 12], 64.f * tv[16 * j + 13], 64.f * tv[16 * j + 14], 64.f * tv[16 * j + 15]);
            *(v4u*)(dst + 16 * j) = o; }
    } else { bf16* dst = c.WT + (size_t)(c.row0 + lane) * 1024 + c.k0;
#pragma unroll
        for (int j = 0; j < 8; ++j) { v4u o; o.x = pk2(tv[8 * j + 0], tv[8 * j + 1]); o.y = pk2(tv[8 * j + 2], tv[8 * j + 3]); o.z = pk2(tv[8 * j + 4], tv[8 * j + 5]); o.w = pk2(tv[8 * j + 6], tv[8 * j + 7]);
            *(v4u*)(dst + 8 * j) = o; }
    }
}
__device__ __forceinline__ void cv_range(const Args& A, LAS unsigned char* lds, int lo, int hi, int wl, int nw) {
    const int tid = otid(), lane = tid & 63, wave = tid >> 6;
    LAS float* scr = (LAS float*)(lds + wave * 17408);
    int it = lo + wl;
    if (it >= hi) return;
    CvItem c0 = cv_decode(A, it), c1 = c0; float t0[64], t1[64];
    cv_load(c0, t0, lane);
    for (;;) {
        const int it1 = it + nw; const bool has1 = it1 < hi;
        if (has1) { c1 = cv_decode(A, it1); cv_load(c1, t1, lane); }
        cv_store(c0, t0, scr, lane);
        if (!has1) break;
        const int it2 = it1 + nw; const bool has2 = it2 < hi;
        if (has2) { c0 = cv_decode(A, it2); cv_load(c0, t0, lane); }
        cv_store(c1, t1, scr, lane);
        if (!has2) break;
        it = it2;
    }
}
constexpr int CVB_L = 3072;
struct CvBlk { const float* W; unsigned char* WT; int N, k0, n0, w1; };
__device__ __forceinline__ CvBlk cvb_decode(const Args& A, int b) {
    CvBlk c; const int l = b / CVB_L; int r = b - l * CVB_L;
    if (r < 2048) { const int le = l * 32 + (r >> 6), q = r & 63; c.w1 = 1; c.N = 2048; c.k0 = 128 * (q >> 3); c.n0 = 256 * (q & 7); c.W = INP(I_W1) + (size_t)le * 1024 * 2048; c.WT = WSP(unsigned char, WS_W1T) + (size_t)le * 2048 * 1024; }
    else { r -= 2048; const int le = l * 32 + (r >> 5), q = r & 31; c.w1 = 0; c.N = 1024; c.k0 = 128 * (q >> 2); c.n0 = 256 * (q & 3); c.W = INP(I_W2) + (size_t)le * 1024 * 1024; c.WT = WSP(unsigned char, WS_W2T) + (size_t)le * 1024 * 1024; }
    return c;
}
__device__ __forceinline__ void cvb_load(const CvBlk& c, f32x4 (&v)[16], int wave, int lane) {
    const float* p = c.W + (size_t)(c.k0 + 16 * wave) * c.N + c.n0 + 4 * lane;
#pragma unroll
    for (int i = 0; i < 16; ++i) v[i] = __builtin_nontemporal_load((const f32x4*)(p + (size_t)i * c.N));
}
__device__ __forceinline__ void cvb_stage(const f32x4 (&v)[16], LAS unsigned char* buf, int wave, int lane) {
#pragma unroll
    for (int j = 0; j < 4; ++j) { v4u o;
        o.x = cvt4_fp8(64.f * v[0][j], 64.f * v[1][j], 64.f * v[2][j], 64.f * v[3][j]); o.y = cvt4_fp8(64.f * v[4][j], 64.f * v[5][j], 64.f * v[6][j], 64.f * v[7][j]);
        o.z = cvt4_fp8(64.f * v[8][j], 64.f * v[9][j], 64.f * v[10][j], 64.f * v[11][j]); o.w = cvt4_fp8(64.f * v[12][j], 64.f * v[13][j], 64.f * v[14][j], 64.f * v[15][j]);
        *(LAS v4u*)(buf + (4 * lane + j) * 128 + ((wave ^ (lane & 7)) << 4)) = o; }
}
__device__ __forceinline__ void cvb_store(const CvBlk& c, const LAS unsigned char* buf, int tid) {
#pragma unroll
    for (int q = 0; q < 4; ++q) { const int p = tid + 512 * q, row = p >> 3, pc = p & 7; const v4u o = *(const LAS v4u*)(buf + row * 128 + ((pc ^ ((row >> 2) & 7)) << 4));
        const int n = c.n0 + row; const int orow = c.w1 ? ((n < 1024) ? ((n >> 7) * 256 + (n & 127)) : (((n - 1024) >> 7) * 256 + 128 + ((n - 1024) & 127))) : n;
        *(v4u*)(c.WT + (size_t)orow * 1024 + c.k0 + 16 * pc) = o; }
}
__device__ __forceinline__ void cv_blocks(const Args& A, LAS unsigned char* lds, int lo, int hi, int wgi, int nwg) {
    const int tid = otid(), lane = tid & 63, wave = tid >> 6;
    int b = lo + wgi;
    if (b >= hi) return;
    CvBlk c0 = cvb_decode(A, b), c1 = c0; f32x4 va[16], vb[16]; int par = 0;
    cvb_load(c0, va, wave, lane);
    for (;;) {
        const int b1 = b + nwg; const bool has1 = b1 < hi;
        if (has1) { c1 = cvb_decode(A, b1); cvb_load(c1, vb, wave, lane); }
        cvb_stage(va, lds + par * 32768, wave, lane); __syncthreads(); cvb_store(c0, lds + par * 32768, tid); par ^= 1;
        if (!has1) break;
        const int b2 = b1 + nwg; const bool has2 = b2 < hi;
        if (has2) { c0 = cvb_decode(A, b2); cvb_load(c0, va, wave, lane); }
        cvb_stage(vb, lds + par * 32768, wave, lane); __syncthreads(); cvb_store(c1, lds + par * 32768, tid); par ^= 1;
        if (!has2) break;
        b = b2;
    }
    __syncthreads();
}
__device__ __forceinline__ void filter_item(const Args& A, LAS unsigned char* lds, int item) {
    const int tid = otid();
        int l, n, chunk;
        if (item < 128) { l = 0; n = 4096; chunk = item; } else if (item < 256) { l = 1; n = 4096; chunk = item - 128; } else { l = 0; n = 256; chunk = item - 256; }
        const int i0 = chunk * 32;
        const float* w1 = INP(I_FW1) + l * 33 * 64; const float* b1 = INP(I_FB1) + l * 64; const float* w2 = INP(I_FW2) + l * 4096; const float* b2 = INP(I_FB2) + l * 64;
        const float* w3 = INP(I_FW3) + l * 4096; const float* b3 = INP(I_FB3) + l * 64; const float* fr = INP(I_FFREQ) + l * 64; const float* wo = INP(I_FOUT) + l * 64 * 512;
        LAS float* zf = (LAS float*)lds; LAS float* ha = zf + 1056; LAS float* hb = ha + 2048; LAS float* outs = hb + 2048;
        LAS float* w1s = outs + 32 * 512; LAS float* w2s = w1s + 33 * 64; LAS float* w3s = w2s + 4096; LAS float* bfs = w3s + 4096;
        { float a_[5], b_[8], c_[8];
#pragma unroll
          for (int q = 0; q < 5; ++q) a_[q] = (tid + 512 * q < 33 * 64) ? w1[tid + 512 * q] : 0.f;
#pragma unroll
          for (int q = 0; q < 8; ++q) { b_[q] = w2[tid + 512 * q]; c_[q] = w3[tid + 512 * q]; }
#pragma unroll
          for (int q = 0; q < 5; ++q) if (tid + 512 * q < 33 * 64) w1s[tid + 512 * q] = a_[q];
#pragma unroll
          for (int q = 0; q < 8; ++q) { w2s[tid + 512 * q] = b_[q]; w3s[tid + 512 * q] = c_[q]; } }
        if (tid < 64) { bfs[tid] = b1[tid]; bfs[64 + tid] = b2[tid]; bfs[128 + tid] = b3[tid]; bfs[192 + tid] = fr[tid]; }
        for (int idx = tid; idx < 32 * 33; idx += 512) { const int p = idx / 33, f = idx - 33 * p, i = i0 + p;
            const float tt = (float)i / (float)(n - 1), wpos = (6.283185307179586f / (float)n) * (float)i;
            float v;
            if (f == 0) v = tt; else { const int jb = (f - 1) & 15; const float band = 1e-4f + (float)jb * ((15.0f - 1e-4f) / 15.0f); const float a = wpos * band; v = (f <= 16) ? cosf(a) : -sinf(a); }
            zf[idx] = v; }
        __syncthreads();
        { const int j = tid & 63, pq = tid >> 6;
          { float wc[33];
#pragma unroll
            for (int f = 0; f < 33; ++f) wc[f] = w1s[f * 64 + j];
#pragma unroll
            for (int q = 0; q < 4; ++q) { const int p = pq + 8 * q; float s = bfs[j];
#pragma unroll
                for (int f = 0; f < 33; ++f) s += zf[p * 33 + f] * wc[f];
                ha[p * 64 + j] = sinf(bfs[192 + j] * s); } }
          __syncthreads();
#pragma unroll 1
          for (int ly = 0; ly < 2; ++ly) { const LAS float* ws_ = ly ? w3s : w2s; const LAS float* hi_ = ly ? hb : ha; LAS float* ho_ = ly ? ha : hb;
            float wc[64];
#pragma unroll
            for (int f = 0; f < 64; ++f) wc[f] = ws_[f * 64 + j];
#pragma unroll
            for (int q = 0; q < 4; ++q) { const int p = pq + 8 * q; float s0 = bfs[64 + 64 * ly + j], s1 = 0.f;
#pragma unroll
                for (int f = 0; f < 64; f += 4) { const f32x4 h4 = *(const LAS f32x4*)(hi_ + p * 64 + f); s0 += h4.x * wc[f]; s1 += h4.y * wc[f + 1]; s0 += h4.z * wc[f + 2]; s1 += h4.w * wc[f + 3]; }
                ho_[p * 64 + j] = sinf(bfs[192 + j] * (s0 + s1)); }
            __syncthreads(); }
        }
        {   const int o = tid, c = o & 255, kind = o >> 8;
            const float delta = 3.0701134573253945f + (float)c * ((15.350567286626973f - 3.0701134573253945f) / 255.0f);
            float wv[64];
#pragma unroll
            for (int j = 0; j < 64; ++j) wv[j] = wo[j * 512 + o];
            bf16* gb = WSP(bf16, WS_GB) + (size_t)(l * 256 + c) * 8192;
            float* gc = WSP(float, WS_GC) + c * 512;
#pragma unroll 1
            for (int k = 0; k < 4; ++k) {
                float ov[8];
#pragma unroll
                for (int m = 0; m < 8; ++m) { const int p = kind == 0 ? 8 * k + m : 31 - 8 * k - m; float a0 = 0.f, a1 = 0.f;
#pragma unroll
                    for (int j = 0; j < 64; j += 4) { const f32x4 h4 = *(const LAS f32x4*)(ha + p * 64 + j); a0 += h4.x * wv[j]; a1 += h4.y * wv[j + 1]; a0 += h4.z * wv[j + 2]; a1 += h4.w * wv[j + 3]; }
                    const float tt = (float)(i0 + p) / (float)(n - 1); ov[m] = (a0 + a1) * __expf(-tt * delta);
                    if (n != 4096) { const int i = i0 + p; gc[kind == 0 ? 256 + i : 255 - i] = ov[m]; }
                    __builtin_amdgcn_sched_barrier(0); }
                if (n == 4096) ((v4u*)(gb + (kind == 0 ? 4096 + i0 : 4064 - i0)))[k] = (v4u){pk2(ov[0], ov[1]), pk2(ov[2], ov[3]), pk2(ov[4], ov[5]), pk2(ov[6], ov[7])};
            }
            if (n == 4096) { if (chunk == 127 && kind == 1) gb[0] = 0; }
            else if (chunk == 7 && kind == 1) gc[0] = 0.f;
        }
        __syncthreads();
    }
__device__ __forceinline__ void ph_prologue(const Args& A, LAS unsigned char* lds, int G, int n_blocks) {
    const int tid = otid(), lane = tid & 63, wave = __builtin_amdgcn_readfirstlane(tid >> 6);
    for (int item = blockIdx.x; item < 192; item += G) {
        const int l = item / 96, jc = item % 96;
        LAS float* S = (LAS float*)lds;
        LAS float* R = S + 9 * 1024;
        for (int idx = tid; idx < 9 * 1024; idx += 512) { const int i = idx >> 10, k = idx & 1023; const float v = (i < 8) ? INP(I_C)[i * 1024 + k] : INP(I_CCTX)[k]; S[idx] = v / (1.0f + __expf(-v)); }
        __syncthreads();
        const int c4 = tid & 15, kg = tid >> 4;
        float acc[9][4];
#pragma unroll
        for (int i = 0; i < 9; ++i) { acc[i][0] = 0.f; acc[i][1] = 0.f; acc[i][2] = 0.f; acc[i][3] = 0.f; }
        const float* w = INP(I_WADA) + (size_t)l * 1024 * 6144 + jc * 64 + 4 * c4;
#pragma unroll 16
        for (int kk = 0; kk < 32; ++kk) { const int k = kg + 32 * kk; const f32x4 wv = *(const f32x4*)(w + (size_t)k * 6144);
#pragma unroll
            for (int i = 0; i < 9; ++i) { const float sv = S[i * 1024 + k]; acc[i][0] += sv * wv.x; acc[i][1] += sv * wv.y; acc[i][2] += sv * wv.z; acc[i][3] += sv * wv.w; } }
#pragma unroll
        for (int i = 0; i < 9; ++i) *(LAS f32x4*)(R + (kg * 9 + i) * 64 + 4 * c4) = (f32x4){acc[i][0], acc[i][1], acc[i][2], acc[i][3]};
        __syncthreads();
        for (int idx = tid; idx < 9 * 64; idx += 512) { const int i = idx >> 6, cc = idx & 63; float s = INP(I_BADA)[l * 6144 + jc * 64 + cc];
#pragma unroll
            for (int q = 0; q < 32; ++q) s += R[(q * 9 + i) * 64 + cc];
            WSP(float, WS_MOD)[(l * 9 + i) * 6144 + jc * 64 + cc] = s; }
        __syncthreads();
    }
    for (int gi = (int)blockIdx.x * 512 + tid; gi < 2 * 32768; gi += G * 512) { const int l = gi >> 15, r = gi & 32767, k = r >> 5, e = r & 31;
        WSP(float, WS_WRT)[l * 32768 + e * 1024 + k] = INP(I_WR)[(size_t)l * 32768 + r]; }
    if (blockIdx.x == G - 1) {
        for (int idx = tid; idx < 1024; idx += 512) { const int pos = idx >> 4, f = idx & 15; const float inv = powf(10000.0f, -(float)f / 16.0f); const float ang = (float)pos * inv;
            WSP(float, WS_ROPE)[idx * 2] = cosf(ang); WSP(float, WS_ROPE)[idx * 2 + 1] = sinf(ang); }
    }
    __syncthreads();
    cv_range(A, lds, 0, CV_SMALL, (int)blockIdx.x * 8 + wave, G * 8);
    __syncthreads();
    cv_blocks(A, lds, 0, n_blocks, (int)blockIdx.x, G);
}

__device__ __forceinline__ float swap32_sum(float a, float b) { asm volatile("s_nop 1\n\tv_permlane32_swap_b32 %0, %1" : "+v"(a), "+v"(b)); return a + b; }
__device__ __forceinline__ float swap32_max(float a, float b) { asm volatile("s_nop 1\n\tv_permlane32_swap_b32 %0, %1" : "+v"(a), "+v"(b)); return fmaxf(a, b); }
__device__ __forceinline__ float wave_max_all(float x) {
    x = fmaxf(x, DPPF(x, 0xB1)); x = fmaxf(x, DPPF(x, 0x4E)); x = fmaxf(x, DPPF(x, 0x141)); x = fmaxf(x, DPPF(x, 0x140));
    x = fmaxf(x, shflx(x, 16));
    return swap32_max(x, x);
}
__device__ __forceinline__ float wave_sum_all(float x) {
    x += DPPF(x, 0xB1); x += DPPF(x, 0x4E); x += DPPF(x, 0x141); x += DPPF(x, 0x140);
    x += shflx(x, 16);
    return swap32_sum(x, x);
}
struct RowV { f32x4 v[4]; };
__device__ __forceinline__ float row_ssq(const RowV& r) { float s = 0.f;
#pragma unroll
    for (int j = 0; j < 4; ++j) s += (r.v[j].x * r.v[j].x + r.v[j].y * r.v[j].y) + (r.v[j].z * r.v[j].z + r.v[j].w * r.v[j].w);
    return wave_sum_all(s); }
__device__ __forceinline__ void row_modulate(const RowV& x, float rs, const float* nw, const float* sh, const float* sc, int lane, RowV& h) {
#pragma unroll
    for (int j = 0; j < 4; ++j) { const f32x4 w = ((const f32x4*)nw)[lane + 64 * j], s = ((const f32x4*)sc)[lane + 64 * j], t = ((const f32x4*)sh)[lane + 64 * j];
        h.v[j] = (x.v[j] * rs * w) * (s + 1.0f) + t; }
}
__device__ __forceinline__ void row_load_bf16(RowV& x, const bf16* src, int lane) {
#pragma unroll
    for (int j = 0; j < 4; ++j) { const v2u w = ((const v2u*)src)[lane + 64 * j]; x.v[j] = (f32x4){bflo(w.x), bfhi(w.x), bflo(w.y), bfhi(w.y)}; }
}
#define DPPU(v, ctrl) ((unsigned)__builtin_amdgcn_update_dpp(0, (int)(v), (ctrl), 0xF, 0xF, false))
__device__ __forceinline__ void row_store_bf16(const RowV& h, bf16* dst, int lane) {
    const bool odd = (lane & 1) != 0;
#pragma unroll
    for (int jp = 0; jp < 2; ++jp) { const int j0 = 2 * jp, j1 = j0 + 1;
        const unsigned a0 = pk2(h.v[j0].x, h.v[j0].y), a1 = pk2(h.v[j0].z, h.v[j0].w), b0 = pk2(h.v[j1].x, h.v[j1].y), b1 = pk2(h.v[j1].z, h.v[j1].w);
        const unsigned r0 = DPPU(odd ? a0 : b0, 0xB1), r1 = DPPU(odd ? a1 : b1, 0xB1);
        const v4u o = odd ? (v4u){r0, r1, b0, b1} : (v4u){a0, a1, r0, r1};
        *(v4u*)(dst + (odd ? 256 * j1 + 4 * (lane - 1) : 256 * j0 + 4 * lane)) = o; }
}
__device__ __forceinline__ void row_unpack(RowV& x, v4u w0, v4u w1) {
    x.v[0] = (f32x4){bflo(w0.x), bfhi(w0.x), bflo(w0.y), bfhi(w0.y)}; x.v[1] = (f32x4){bflo(w0.z), bfhi(w0.z), bflo(w0.w), bfhi(w0.w)};
    x.v[2] = (f32x4){bflo(w1.x), bfhi(w1.x), bflo(w1.y), bfhi(w1.y)}; x.v[3] = (f32x4){bflo(w1.z), bfhi(w1.z), bflo(w1.w), bfhi(w1.w)};
}
__device__ __forceinline__ void mod_to_lds(const Args& A, LAS unsigned char* lds, int l, int lg, int sh_off, int sc_off) {
    const int tid = otid(); LAS f32x4* d = (LAS f32x4*)lds; const float* mod = WSP(float, WS_MOD) + (size_t)l * 9 * 6144; const float* modg = WSP(float, WS_MOD) + (size_t)lg * 9 * 6144;
    __syncthreads();
    f32x4 t_[14];
#pragma unroll
    for (int q = 0; q < 14; ++q) { const int idx = tid + 512 * q, part = idx / 2304, r = idx - part * 2304, mi = r >> 8, c = r & 255;
        const int off = (part == 0) ? sh_off : (part == 1) ? sc_off : 5120;
        t_[q] = (idx < 6912) ? ((const f32x4*)((part == 2 ? modg : mod) + mi * 6144 + off))[c] : (f32x4){0.f, 0.f, 0.f, 0.f}; }
#pragma unroll
    for (int q = 0; q < 14; ++q) { const int idx = tid + 512 * q; if (idx < 6912) d[idx] = t_[q]; }
    __syncthreads();
}
__device__ __forceinline__ void row_modulate_l(const RowV& x, float rs, const f32x4 (&nw)[4], const LAS float* sh, const LAS float* sc, int lane, RowV& h) {
#pragma unroll
    for (int j = 0; j < 4; ++j) { const f32x4 s_ = ((const LAS f32x4*)sc)[lane + 64 * j], t_ = ((const LAS f32x4*)sh)[lane + 64 * j]; h.v[j] = (x.v[j] * rs * nw[j]) * (s_ + 1.0f) + t_; }
}
template <int NR>
__device__ __forceinline__ void row_sel(const Args& A, const int (&r)[NR], int (&slot)[NR][4], float (&g)[NR][4]) {
#pragma unroll
    for (int q = 0; q < NR; ++q) { const int* ts = WSP(int, WS_TOKSLOT) + r[q] * 4; const float* tg = WSP(float, WS_TOPG) + r[q] * 4;
#pragma unroll
        for (int k = 0; k < 4; ++k) { slot[q][k] = ts[k]; g[q][k] = tg[k]; } }
}
template <int NR>
__device__ __forceinline__ void row_combine_sel(RowV (&x)[NR], const Args& A, const LAS float* g2l, const int (&slot)[NR][4], const float (&g)[NR][4], const int (&mi)[NR], int lane);
template <int NR>
__device__ __forceinline__ void row_combine(RowV (&x)[NR], const Args& A, int l, const int (&r)[NR], const int (&mi)[NR], int lane) {
    int slot[NR][4]; float g[NR][4]; row_sel<NR>(A, r, slot, g); row_combine_sel<NR>(x, A, (const LAS float*)nullptr, slot, g, mi, lane);
}
template <int NR>
__device__ __forceinline__ void row_combine_sel(RowV (&x)[NR], const Args& A, const LAS float* g2l, const int (&slot)[NR][4], const float (&g)[NR][4], const int (&mi)[NR], int lane) {
    int w[NR][4][4];
#pragma unroll
    for (int q = 0; q < NR; ++q)
#pragma unroll
        for (int k = 0; k < 4; ++k) { const int* src = (const int*)(WSP(unsigned char, WS_OUTS) + (size_t)slot[q][k] * DM);
#pragma unroll
            for (int j = 0; j < 4; ++j) w[q][k][j] = src[lane + 64 * j]; }
#pragma unroll
    for (int q = 0; q < NR; ++q) { const LAS float* g2 = g2l + 18432 + mi[q] * 1024;
#pragma unroll
        for (int j = 0; j < 4; ++j) { f32x4 y = (f32x4){0.f, 0.f, 0.f, 0.f};
#pragma unroll
            for (int k = 0; k < 4; ++k) { const int ww = w[q][k][j]; const float gg = g[q][k];
                y.x += gg * __builtin_amdgcn_cvt_f32_fp8(ww, 0); y.y += gg * __builtin_amdgcn_cvt_f32_fp8(ww, 1); y.z += gg * __builtin_amdgcn_cvt_f32_fp8(ww, 2); y.w += gg * __builtin_amdgcn_cvt_f32_fp8(ww, 3); }
            x[q].v[j] = x[q].v[j] + ((const LAS f32x4*)g2)[lane + 64 * j] * y; } }
}
__device__ __forceinline__ void ph_filters(const Args& A, LAS unsigned char* lds, int G) {
    const int bx = (int)blockIdx.x; const bool role = (G == 256);
    const int f_lo = role ? 2 * bx : bx, f_hi = role ? (bx < 132 ? 2 * bx + 2 : 0) : 264, f_st = role ? 1 : G;
#pragma unroll 1
    for (int item = f_lo; item < f_hi; item += f_st) { __syncthreads(); filter_item(A, lds, item); }
}
__device__ __forceinline__ void ph_rowpass_a(const Args& A, LAS unsigned char* lds, int l, int G) {
    const int tid = otid(), lane = tid & 63, wave = tid >> 6, gw = blockIdx.x * 8 + wave, NGW = G * 8;
    for (int i = blockIdx.x * 512 + tid; i < NSLOT_MAX; i += G * 512) WSP(int, WS_SLOTTOK)[i] = MROWS;
    if (blockIdx.x == 0) { for (int i = tid; i < 512; i += 512) ((unsigned*)(WSP(bf16, WS_H) + (size_t)MROWS * DM))[i] = 0u; }
    bf16* X = WSP(bf16, WS_X); bf16* H = WSP(bf16, WS_H);
    mod_to_lds(A, lds, l, l ? l - 1 : 0, 0, 1024);
    const LAS float* ml = (const LAS float*)lds; f32x4 nwr[4];
#pragma unroll
    for (int j = 0; j < 4; ++j) nwr[j] = ((const f32x4*)(INP(I_NMIX) + l * DM))[lane + 64 * j];
    constexpr int NR = 2;
    constexpr int NPAIR = MROWS / NR, NF = 132, FA = 32, FB = 107;
    const bool role = (l == 0) && (G == 256);
    const int bx = (int)blockIdx.x;
    const int p_lo = role ? (bx < NF ? bx * FA : NF * FA + (bx - NF) * FB) : 0, p_n = role ? (bx < NF ? FA : FB) : NPAIR, p_st = role ? 8 : NGW, p_0 = role ? wave : gw;
    int slot[NR][4]; float gsel[NR][4];
    if (l != 0) { int r[NR];
#pragma unroll
        for (int q = 0; q < NR; ++q) { const int rr = (p_lo + p_0) * NR + q; r[q] = rr < MROWS ? rr : q; }
        row_sel<NR>(A, r, slot, gsel); }
    for (int pi = p_0; pi < p_n; pi += p_st) { const int r0 = (p_lo + pi) * NR; if (r0 >= MROWS) break;
        int r[NR], mi[NR]; RowV x[NR];
#pragma unroll
        for (int q = 0; q < NR; ++q) { r[q] = r0 + q; const int b = r[q] / TPB, t = r[q] - b * TPB; mi[q] = (t < SEQ) ? b : 8;
            if (l == 0) { const float* src = (t < SEQ) ? INP(I_X) + ((size_t)b * SEQ + t) * DM : INP(I_CTX) + ((size_t)b * CTXL + (t - SEQ)) * DM;
#pragma unroll
                for (int j = 0; j < 4; ++j) x[q].v[j] = ((const f32x4*)src)[lane + 64 * j];
            } else row_load_bf16(x[q], X + (size_t)r[q] * DM, lane); }
        if (l != 0) { int slotn[NR][4]; float gn[NR][4];
            { const int rn0 = (p_lo + pi + p_st) * NR; const bool hn = (pi + p_st < p_n) && (rn0 < MROWS); int rn[NR];
#pragma unroll
              for (int q = 0; q < NR; ++q) rn[q] = (hn ? rn0 : r0) + q;
              row_sel<NR>(A, rn, slotn, gn); }
            row_combine_sel<NR>(x, A, ml, slot, gsel, mi, lane);
#pragma unroll
            for (int q = 0; q < NR; ++q)
#pragma unroll
                for (int k = 0; k < 4; ++k) { slot[q][k] = slotn[q][k]; gsel[q][k] = gn[q][k]; }
#pragma unroll
            for (int q = 0; q < NR; ++q) row_store_bf16(x[q], X + (size_t)r[q] * DM, lane); }
#pragma unroll
        for (int q = 0; q < NR; ++q) {
            const float rs = rsqrtf(row_ssq(x[q]) * (1.0f / DM) + EPSN);
            RowV h; row_modulate_l(x[q], rs, nwr, ml + mi[q] * 1024, ml + 9216 + mi[q] * 1024, lane, h);
            row_store_bf16(h, H + (size_t)r[q] * DM, lane); }
    }
}
__device__ __forceinline__ void ph_final(const Args& A, LAS unsigned char* lds, int G) {
    const int tid = otid(), lane = tid & 63, wave = tid >> 6, gw = blockIdx.x * 8 + wave, NGW = G * 8;
    const bf16* X = WSP(bf16, WS_X);
    constexpr int NR = 4;
    f32x4 nf[4];
#pragma unroll
    for (int j = 0; j < 4; ++j) nf[j] = ((const f32x4*)INP(I_NFINAL))[lane + 64 * j];
    mod_to_lds(A, lds, 1, 1, 0, 1024);
    int slot[NR][4]; float gsel[NR][4];
    { int r[NR];
#pragma unroll
      for (int q = 0; q < NR; ++q) r[q] = lat_row((gw * NR < NB * SEQ ? gw * NR : 0) + q);
      row_sel<NR>(A, r, slot, gsel); }
    for (int i0 = gw * NR; i0 < NB * SEQ; i0 += NGW * NR) {
        int r[NR], mi[NR]; RowV x[NR];
#pragma unroll
        for (int q = 0; q < NR; ++q) { r[q] = lat_row(i0 + q); mi[q] = (i0 + q) >> 12; row_load_bf16(x[q], X + (size_t)r[q] * DM, lane); }
        int slotn[NR][4]; float gn[NR][4];
        { const int in_ = (i0 + NGW * NR < NB * SEQ) ? i0 + NGW * NR : i0; int rn[NR];
#pragma unroll
          for (int q = 0; q < NR; ++q) rn[q] = lat_row(in_ + q);
          row_sel<NR>(A, rn, slotn, gn); }
        row_combine_sel<NR>(x, A, (const LAS float*)lds, slot, gsel, mi, lane);
#pragma unroll
        for (int q = 0; q < NR; ++q)
#pragma unroll
            for (int k = 0; k < 4; ++k) { slot[q][k] = slotn[q][k]; gsel[q][k] = gn[q][k]; }
#pragma unroll
        for (int q = 0; q < NR; ++q) {
            const float rs = rsqrtf(row_ssq(x[q]) * (1.0f / DM) + EPSN);
            float* dst = (float*)inp_ptr(A, 34) + (size_t)(i0 + q) * DM;
#pragma unroll
            for (int j = 0; j < 4; ++j) ((f32x4*)dst)[lane + 64 * j] = x[q].v[j] * rs * nf[j]; }
    }
}
constexpr int RG = 2, RGS = 1;
__device__ __forceinline__ void g_tiles(int l, int G, int& t_lo, int& tcnt) {
    const int ntiles = ((l == 0) ? MROWS : NB * SEQ) >> 4, tq = ntiles / G, trem = ntiles - tq * G, bx = (int)blockIdx.x;
    t_lo = bx * tq + (bx < trem ? bx : trem); tcnt = tq + (bx < trem ? 1 : 0);
}
__device__ __forceinline__ void split_bf(float x, unsigned& hi, unsigned& lo) { hi = f2bf(x); lo = f2bf(x - __builtin_bit_cast(float, hi << 16)); }
__device__ __forceinline__ void split_bf2(float x0, float x1, unsigned& hw, unsigned& lw) { hw = pk2(x0, x1); lw = pk2(x0 - bflo(hw), x1 - bfhi(hw)); }
__device__ __forceinline__ void ph_rowpass_g(const Args& A, LAS unsigned char* lds, int l, int G) {
    const int tid = otid(), lane = tid & 63, wave = __builtin_amdgcn_readfirstlane(tid >> 6);
    constexpr int ROWP = 2048 + 16, LO_OFF = 16 * ROWP, P_OFF = 2 * LO_OFF;
    LAS int* hist = (LAS int*)(lds + LDSX_OFF);
    __syncthreads();
    if (tid < 32) hist[tid] = 0;
    const bf16* X = WSP(bf16, WS_X);
    int t_lo, tcnt; g_tiles(l, G, t_lo, tcnt);
    int mi_cur = -1; f32x4 am[4], shv[4]; v4u w_[2][2];
    int pend_r = -1; v4u pend_e = (v4u){0u, 0u, 0u, 0u}; f32x4 pend_g = (f32x4){0.f, 0.f, 0.f, 0.f};
    if (tcnt > 0) { const int i0 = t_lo * 16 + 2 * wave, r0 = (l == 0) ? i0 : lat_row(i0); const v4u* xp = (const v4u*)(X + (size_t)r0 * DM) + 2 * lane;
#pragma unroll
        for (int q = 0; q < 2; ++q) { w_[q][0] = xp[128 * q]; w_[q][1] = xp[128 * q + 1]; } }
    bf16x8 bh[4][2], bl[4][2];
    { const float* wt = WSP(float, WS_WRT) + l * 32768;
#pragma unroll
      for (int s_ = 0; s_ < 4; ++s_)
#pragma unroll
          for (int t_ = 0; t_ < 2; ++t_) { const float* wp = wt + (16 * t_ + (lane & 15)) * 1024 + 128 * wave + 32 * s_ + 8 * (lane >> 4);
              const f32x4 w0 = ((const f32x4*)wp)[0], w1 = ((const f32x4*)wp)[1]; unsigned h_[8], l_[8];
              split_bf2(w0.x, w0.y, h_[0], l_[0]); split_bf2(w0.z, w0.w, h_[1], l_[1]); split_bf2(w1.x, w1.y, h_[2], l_[2]); split_bf2(w1.z, w1.w, h_[3], l_[3]);
              bh[s_][t_] = __builtin_bit_cast(bf16x8, (v4u){h_[0], h_[1], h_[2], h_[3]});
              bl[s_][t_] = __builtin_bit_cast(bf16x8, (v4u){l_[0], l_[1], l_[2], l_[3]}); } }
    __syncthreads();
    unsigned char* H8 = WSP(unsigned char, WS_H8);
    if (blockIdx.x == 0 && tid < 256) ((unsigned*)(H8 + (size_t)MROWS * DM))[tid] = 0u;
    const float brl = INP(I_BR)[l * 32 + (lane >> 1)];
    const float* nffn = INP(I_NFFN) + l * DM;
#pragma unroll 1
    for (int it = 0; it < tcnt; ++it) {
        const int tile = t_lo + it;
        const int i0 = tile * 16 + 2 * wave;
        const int r0 = (l == 0) ? i0 : lat_row(i0);
        const int b = r0 / TPB, t = r0 - b * TPB, mi = (t < SEQ) ? b : 8;
        if (mi != mi_cur) { mi_cur = mi; const float* mod = WSP(float, WS_MOD) + (l * 9 + mi) * 6144;
#pragma unroll
            for (int j = 0; j < 4; ++j) { const f32x4 wv = ((const f32x4*)nffn)[4 * lane + j], sc = ((const f32x4*)(mod + 4096))[4 * lane + j]; shv[j] = ((const f32x4*)(mod + 3072))[4 * lane + j]; am[j] = wv * (sc + 1.0f); } }
        RowV h[2];
#pragma unroll
        for (int q = 0; q < 2; ++q) row_unpack(h[q], w_[q][0], w_[q][1]);
        if (it + 1 < tcnt) { const int i1 = (tile + 1) * 16 + 2 * wave, r1 = (l == 0) ? i1 : lat_row(i1); const v4u* xp = (const v4u*)(X + (size_t)r1 * DM) + 2 * lane;
#pragma unroll
            for (int q = 0; q < 2; ++q) { w_[q][0] = xp[128 * q]; w_[q][1] = xp[128 * q + 1]; } }
        float rs[2];
#pragma unroll
        for (int q = 0; q < 2; ++q) { float s = 0.f;
#pragma unroll
            for (int j = 0; j < 4; ++j) s += (h[q].v[j].x * h[q].v[j].x + h[q].v[j].y * h[q].v[j].y) + (h[q].v[j].z * h[q].v[j].z + h[q].v[j].w * h[q].v[j].w);
            rs[q] = rsqrtf(wave_sum_all(s) * (1.0f / DM) + EPSN); }
#pragma unroll
        for (int j = 0; j < 4; ++j)
#pragma unroll
            for (int q = 0; q < 2; ++q) h[q].v[j] = (h[q].v[j] * rs[q]) * am[j] + shv[j];
#pragma unroll
        for (int q = 0; q < 2; ++q) {
            ((v4u*)(H8 + (size_t)(r0 + q) * DM))[lane] = (v4u){cvt4_fp8(h[q].v[0].x, h[q].v[0].y, h[q].v[0].z, h[q].v[0].w), cvt4_fp8(h[q].v[1].x, h[q].v[1].y, h[q].v[1].z, h[q].v[1].w),
                                                            cvt4_fp8(h[q].v[2].x, h[q].v[2].y, h[q].v[2].z, h[q].v[2].w), cvt4_fp8(h[q].v[3].x, h[q].v[3].y, h[q].v[3].z, h[q].v[3].w)};
            LAS unsigned char* th = lds + (2 * wave + q) * ROWP + 32 * lane; unsigned hw[8], lw[8];
#pragma unroll
            for (int j = 0; j < 4; ++j) { split_bf2(h[q].v[j].x, h[q].v[j].y, hw[2 * j], lw[2 * j]); split_bf2(h[q].v[j].z, h[q].v[j].w, hw[2 * j + 1], lw[2 * j + 1]); }
            *(LAS v4u*)th = (v4u){hw[0], hw[1], hw[2], hw[3]}; *(LAS v4u*)(th + 16) = (v4u){hw[4], hw[5], hw[6], hw[7]};
            *(LAS v4u*)(th + LO_OFF) = (v4u){lw[0], lw[1], lw[2], lw[3]}; *(LAS v4u*)(th + LO_OFF + 16) = (v4u){lw[4], lw[5], lw[6], lw[7]}; }
        if (pend_r >= 0) { *(v4u*)(WSP(int, WS_TOPI) + pend_r * 4) = pend_e; *(f32x4*)(WSP(float, WS_TOPG) + pend_r * 4) = pend_g; pend_r = -1; }
        __syncthreads();
        {   f32x4 acc[2] = {(f32x4){0.f, 0.f, 0.f, 0.f}, (f32x4){0.f, 0.f, 0.f, 0.f}};
            const LAS unsigned char* ap = lds + (lane & 15) * ROWP + (128 * wave + 8 * (lane >> 4)) * 2;
#pragma unroll
            for (int s_ = 0; s_ < 4; ++s_) { const bf16x8 ah = *(const LAS bf16x8*)(ap + 64 * s_), al = *(const LAS bf16x8*)(ap + LO_OFF + 64 * s_);
#pragma unroll
                for (int t_ = 0; t_ < 2; ++t_) { acc[t_] = __builtin_amdgcn_mfma_f32_16x16x32_bf16(ah, bh[s_][t_], acc[t_], 0, 0, 0); acc[t_] = __builtin_amdgcn_mfma_f32_16x16x32_bf16(ah, bl[s_][t_], acc[t_], 0, 0, 0);
                    acc[t_] = __builtin_amdgcn_mfma_f32_16x16x32_bf16(al, bh[s_][t_], acc[t_], 0, 0, 0); } }
#pragma unroll
            for (int t_ = 0; t_ < 2; ++t_)
#pragma unroll
                for (int i_ = 0; i_ < 4; ++i_) *(LAS float*)(lds + P_OFF + ((wave * 16 + 4 * (lane >> 4) + i_) * 32 + 16 * t_ + (lane & 15)) * 4) = acc[t_][i_];
        }
        __syncthreads();
        int bi[2][4]; float gv[2][4];
#pragma unroll
        for (int q = 0; q < 2; ++q) {
            float lg = brl;
#pragma unroll
            for (int w_ = 0; w_ < 8; ++w_) lg += *(const LAS float*)(lds + P_OFF + ((w_ * 16 + 2 * wave + q) * 32 + (lane >> 1)) * 4);
            float bv[4];
#pragma unroll
            for (int k = 0; k < 4; ++k) { const float m = wave_max_all(lg); const unsigned long long bal = __ballot(lg == m); const int fl = (int)__builtin_ctzll(bal);
                bi[q][k] = fl >> 1; bv[k] = m; if ((lane >> 1) == (fl >> 1)) lg = -INFINITY; }
            const float e1 = __expf(bv[1] - bv[0]), e2 = __expf(bv[2] - bv[0]), e3 = __expf(bv[3] - bv[0]); const float inv = 1.0f / (1.0f + e1 + e2 + e3);
            gv[q][0] = inv; gv[q][1] = e1 * inv; gv[q][2] = e2 * inv; gv[q][3] = e3 * inv;
        }
        if (lane < 2) {
            const bool s1 = lane == 1;
            const int e0 = s1 ? bi[1][0] : bi[0][0], e1_ = s1 ? bi[1][1] : bi[0][1], e2_ = s1 ? bi[1][2] : bi[0][2], e3_ = s1 ? bi[1][3] : bi[0][3];
            pend_r = r0 + lane; pend_e = (v4u){(unsigned)e0, (unsigned)e1_, (unsigned)e2_, (unsigned)e3_};
            pend_g = s1 ? (f32x4){gv[1][0], gv[1][1], gv[1][2], gv[1][3]} : (f32x4){gv[0][0], gv[0][1], gv[0][2], gv[0][3]};
            atomicAdd((int*)&hist[e0], 1); atomicAdd((int*)&hist[e1_], 1); atomicAdd((int*)&hist[e2_], 1); atomicAdd((int*)&hist[e3_], 1); }
    }
    if (pend_r >= 0) { *(v4u*)(WSP(int, WS_TOPI) + pend_r * 4) = pend_e; *(f32x4*)(WSP(float, WS_TOPG) + pend_r * 4) = pend_g; }
    __syncthreads();
    if (tid < 32) WSP(int, WS_HIST)[(l * 256 + blockIdx.x) * 32 + tid] = hist[tid];
    __syncthreads();
}
__device__ __forceinline__ void ph_route(const Args& A, LAS unsigned char* lds, int l, int G) {
    const int tid = otid(), lane = tid & 63, wave = tid >> 6, gw = blockIdx.x * 8 + wave, NGW = G * 8;
    LAS int* tot = (LAS int*)(lds + LDSX_OFF); LAS int* off = tot + 32; LAS int* pst = off + 32; LAS int* cur = pst + 40;
    {
        LAS int* hb = (LAS int*)lds; const int* hs = WSP(int, WS_HIST) + l * 256 * 32;
        __syncthreads();
        { int t_[16];
#pragma unroll
          for (int q = 0; q < 16; ++q) t_[q] = (tid + 512 * q < G * 32) ? hs[tid + 512 * q] : 0;
#pragma unroll
          for (int q = 0; q < 16; ++q) if (tid + 512 * q < G * 32) hb[tid + 512 * q] = t_[q]; }
        __syncthreads();
        if (tid < 32) { int s = 0, my = 0;
            for (int w = 0; w < G; ++w) { if (w == (int)blockIdx.x) my = s; s += hb[w * 32 + tid]; }
            tot[tid] = s; off[tid] = my; cur[tid] = 0; }
    }
    __syncthreads();
    if (tid == 0) { int p = 0; for (int e = 0; e < 32; ++e) { pst[e] = p; p += ((tot[e] + 255) >> 8) << 8; } pst[32] = p; }
    __syncthreads();
    if (blockIdx.x == 0 && tid < 34) WSP(int, WS_EXPST)[l * 64 + tid] = (tid < 33) ? pst[tid] : (pst[32] >> 8);
    int t_lo, tcnt; g_tiles(l, G, t_lo, tcnt);
    for (int p = tid; p < tcnt * 64; p += 512) { const int i = t_lo * 16 + (p >> 2), k = p & 3, r = (l == 0) ? i : lat_row(i);
        const int e = WSP(int, WS_TOPI)[r * 4 + k]; const int pos = atomicAdd((int*)&cur[e], 1); const int slot = pst[e] + off[e] + pos;
        WSP(int, WS_SLOTTOK)[slot] = r; WSP(int, WS_TOKSLOT)[r * 4 + k] = slot; }
    __syncthreads();
}
__device__ __forceinline__ int moe_table(const Args& A, LAS unsigned char* lds, int l) {
    const int tid = otid(); LAS int* pst = (LAS int*)(lds + LDSX_OFF); LAS unsigned char* be = (LAS unsigned char*)(lds + LDSX_OFF + 1024);
    if (tid < 34) pst[tid] = WSP(int, WS_EXPST)[l * 64 + tid];
    __syncthreads();
    const int nblk = pst[33];
    for (int bk = tid; bk < nblk; bk += 512) { int e = 0; for (int q = 1; q < 32; ++q) e += (pst[q] <= bk * 256) ? 1 : 0; be[bk] = (unsigned char)e; }
    __syncthreads();
    return __builtin_amdgcn_readfirstlane(nblk);
}

__device__ __forceinline__ void ph_post(const Args& A, LAS unsigned char* lds, int l, int G) {
    const int tid = otid(), lane = tid & 63, wave = tid >> 6, gw = blockIdx.x * 8 + wave, NGW = G * 8;
    bf16* P = WSP(bf16, WS_P);
    {
        const int hd = lane >> 2, part = lane & 3;
        const int cb = (hd < 6) ? COL_GAQ + 64 * hd : (hd < 8) ? COL_GAK + 64 * (hd - 6) : (hd < 14) ? COL_WAQ + 64 * (hd - 8) : COL_WAK + 64 * (hd - 14);
        const bool isq = (hd < 6) || (hd >= 8 && hd < 14), donorm = hd < 8;
        const float* nw = (hd < 6) ? INP(I_QNORM) + l * 64 : INP(I_KNORM) + l * 64;
        float nwv[16];
#pragma unroll
        for (int k = 0; k < 4; ++k) { const f32x4 t4 = ((const f32x4*)(nw + 16 * part))[k]; nwv[4 * k] = t4.x; nwv[4 * k + 1] = t4.y; nwv[4 * k + 2] = t4.z; nwv[4 * k + 3] = t4.w; }
        __syncthreads();
        ((LAS f32x4*)lds)[tid] = ((const f32x4*)WSP(float, WS_ROPE))[tid];
        __syncthreads();
        const LAS float* rope = (const LAS float*)lds;
        constexpr int NR = 2;
        for (int r0 = gw * NR; r0 < MROWS; r0 += NGW * NR) {
            v4u w0[NR], w1[NR]; bf16* p[NR]; int bq[NR], tq[NR];
#pragma unroll
            for (int q = 0; q < NR; ++q) { const int r = r0 + q; bq[q] = r / TPB; tq[q] = r - bq[q] * TPB; p[q] = P + (size_t)r * INW + cb + 16 * part;
                w0[q] = ((const v4u*)p[q])[0]; w1[q] = ((const v4u*)p[q])[1]; }
#pragma unroll
            for (int q = 0; q < NR; ++q) { const int b = bq[q], t = tq[q];
                float v[16];
                v[0] = bflo(w0[q].x); v[1] = bfhi(w0[q].x); v[2] = bflo(w0[q].y); v[3] = bfhi(w0[q].y); v[4] = bflo(w0[q].z); v[5] = bfhi(w0[q].z); v[6] = bflo(w0[q].w); v[7] = bfhi(w0[q].w);
                v[8] = bflo(w1[q].x); v[9] = bfhi(w1[q].x); v[10] = bflo(w1[q].y); v[11] = bfhi(w1[q].y); v[12] = bflo(w1[q].z); v[13] = bfhi(w1[q].z); v[14] = bflo(w1[q].w); v[15] = bfhi(w1[q].w);
                if (donorm) { float ss = 0.f;
#pragma unroll
                    for (int i = 0; i < 16; ++i) ss += v[i] * v[i];
                    ss += DPPF(ss, 0xB1); ss += DPPF(ss, 0x4E);
                    const float rs = rsqrtf(ss * (1.0f / 64.0f) + EPSN);
#pragma unroll
                    for (int i = 0; i < 16; ++i) v[i] = v[i] * rs * nwv[i]; }
                if (t < SEQ) {
                    const int pos = (part < 2) ? (t >> 6) : (t & 63); const LAS f32x4* cs4 = (const LAS f32x4*)(rope + pos * 32);
#pragma unroll
                    for (int k = 0; k < 8; ++k) { const f32x4 cs = cs4[k];
                        const float o0_ = DPPF(v[2 * k], 0xB1), o1_ = DPPF(v[2 * k + 1], 0xB1);
                        v[2 * k] = (part & 1) ? (v[2 * k] * cs.x + o0_ * cs.y) : (v[2 * k] * cs.x - o0_ * cs.y);
                        v[2 * k + 1] = (part & 1) ? (v[2 * k + 1] * cs.z + o1_ * cs.w) : (v[2 * k + 1] * cs.z - o1_ * cs.w); }
                }
                if (isq) {
#pragma unroll
                    for (int i = 0; i < 16; ++i) v[i] *= C2Q; }
                v4u o0, o1;
                o0.x = pk2(v[0], v[1]); o0.y = pk2(v[2], v[3]); o0.z = pk2(v[4], v[5]); o0.w = pk2(v[6], v[7]);
                o1.x = pk2(v[8], v[9]); o1.y = pk2(v[10], v[11]); o1.z = pk2(v[12], v[13]); o1.w = pk2(v[14], v[15]);
                {   const int wsel = (hd >= 14) ? 1 : 0, kvh = (hd - 6) & 1;
                    bf16* kc = WSP(bf16, WS_KC) + ((size_t)(((wsel * 8 + b) * 2 + kvh)) * TPB + t) * 64 + 16 * part;
                    bf16* dq = isq ? p[q] : kc;
                    ((v4u*)dq)[0] = o0; ((v4u*)dq)[1] = o1; }
            }
        }
    }
    {
        constexpr int UST = 1536 + 16;
        const float* cw = INP(I_CONVW) + l * 3 * 768; const float* cbv = INP(I_CONVB) + l * 768;
        const int c = tid & 255, half = tid >> 8;
        float w0[3], w1[3], w2[3], wb[3];
#pragma unroll
        for (int g = 0; g < 3; ++g) { w0[g] = cw[g * 256 + c]; w1[g] = cw[768 + g * 256 + c]; w2[g] = cw[1536 + g * 256 + c]; wb[g] = cbv[g * 256 + c]; }
        const int nunits = (l == 0) ? NB * 68 : NB * 64;
        for (int u = blockIdx.x; u < nunits; u += G) {
            int b, n, t0, rowbase; bf16 *zt, *xt;
            if (u < NB * 64) { b = u >> 6; n = SEQ; t0 = (u & 63) * 64; rowbase = b * TPB; zt = WSP(bf16, WS_ZT) + (size_t)b * 256 * SEQ; xt = WSP(bf16, WS_X0T) + (size_t)b * 256 * SEQ; }
            else { const int q = u - NB * 64; b = q >> 2; n = CTXL; t0 = (q & 3) * 64; rowbase = b * TPB + SEQ; zt = WSP(bf16, WS_ZTC) + (size_t)b * 256 * CTXL; xt = WSP(bf16, WS_X0TC) + (size_t)b * 256 * CTXL; }
            __syncthreads();
            { v4u t_[13];
#pragma unroll
              for (int q = 0; q < 13; ++q) { const int idx = tid + 512 * q, rr = idx / 96, ch = idx - 96 * rr, t = t0 - 1 + rr;
                  t_[q] = (v4u){0u, 0u, 0u, 0u};
                  if (idx < 66 * 96 && t >= 0 && t < n) t_[q] = *(const v4u*)(P + (size_t)(rowbase + t) * INW + ch * 8); }
#pragma unroll
              for (int q = 0; q < 13; ++q) { const int idx = tid + 512 * q, rr = idx / 96, ch = idx - 96 * rr;
                  if (idx < 66 * 96) *(LAS v4u*)(lds + rr * UST + ch * 16) = t_[q]; } }
            __syncthreads();
            const LAS unsigned short* up = (const LAS unsigned short*)(lds + (32 * half) * UST) + c;
            float pm[3], pc[3];
#pragma unroll
            for (int g = 0; g < 3; ++g) { pm[g] = bf2f(up[g * 256]); pc[g] = bf2f(up[(UST / 2) + g * 256]); }
            unsigned zo[16], xo[16]; float zpv = 0.f, xpv = 0.f;
#pragma unroll
            for (int i = 0; i < 32; ++i) {
                float uc[3];
#pragma unroll
                for (int g = 0; g < 3; ++g) { const float pn = bf2f(up[(i + 2) * (UST / 2) + g * 256]); uc[g] = w0[g] * pm[g] + w1[g] * pc[g] + w2[g] * pn + wb[g]; pm[g] = pc[g]; pc[g] = pn; }
                const float zc = uc[2] * uc[1], xc = uc[0];
                if (i & 1) { zo[i >> 1] = pk2(zpv, zc); xo[i >> 1] = pk2(xpv, xc); } else { zpv = zc; xpv = xc; }
            }
            bf16* zp = zt + (size_t)c * n + t0 + 32 * half; bf16* xp = xt + (size_t)c * n + t0 + 32 * half;
#pragma unroll
            for (int k = 0; k < 4; ++k) { v4u a, d; a.x = zo[4 * k]; a.y = zo[4 * k + 1]; a.z = zo[4 * k + 2]; a.w = zo[4 * k + 3]; d.x = xo[4 * k]; d.y = xo[4 * k + 1]; d.z = xo[4 * k + 2]; d.w = xo[4 * k + 3];
                ((v4u*)zp)[k] = a; ((v4u*)xp)[k] = d; }
        }
        __syncthreads();
    }
}

__device__ __forceinline__ void hyena_latent_unit(const Args& A, LAS unsigned char* lds, int l, int c) {
    const int tid = otid();
    LAS float* Gf = (LAS float*)lds; LAS float* Zf = Gf + 8192;
    const bf16* g = WSP(bf16, WS_GB) + (size_t)(l * 256 + c) * 8192;
    for (int i = tid; i < 8192; i += 512) Gf[i] = bf2f(g[i]);
    const float skip = INP(I_SKIP)[l * 256 + c];
    bf16* Y = WSP(bf16, WS_Y);
    for (int bg = 0; bg < 2; ++bg) {
        __syncthreads();
        for (int i = tid; i < 4 * 4096; i += 512) { const int bb = i >> 12, s = i & 4095; Zf[i] = bf2f(WSP(bf16, WS_ZT)[((size_t)((bg * 4 + bb) * 256 + c)) * SEQ + s]); }
        __syncthreads();
        float acc[4][8];
#pragma unroll
        for (int bb = 0; bb < 4; ++bb)
#pragma unroll
            for (int i = 0; i < 8; ++i) acc[bb][i] = 0.f;
        const LAS float* gp = Gf + tid + 4096;
#pragma unroll 2
        for (int s = 0; s < 4096; ++s) {
            const float z0 = Zf[s], z1 = Zf[4096 + s], z2 = Zf[8192 + s], z3 = Zf[12288 + s];
#pragma unroll
            for (int i = 0; i < 8; ++i) { const float gg = gp[512 * i - s]; acc[0][i] += gg * z0; acc[1][i] += gg * z1; acc[2][i] += gg * z2; acc[3][i] += gg * z3; }
        }
#pragma unroll
        for (int bb = 0; bb < 4; ++bb)
#pragma unroll
            for (int i = 0; i < 8; ++i) { const int t = tid + 512 * i, b = bg * 4 + bb;
                const float x0 = bf2f(WSP(bf16, WS_X0T)[((size_t)(b * 256 + c)) * SEQ + t]);
                Y[((size_t)(b * TPB + t)) * DM + c] = (bf16)f2bf(x0 * (acc[bb][i] + Zf[bb * 4096 + t] * skip)); }
    }
    __syncthreads();
}
__device__ __forceinline__ void hyena_mfma_unit(const Args& A, LAS unsigned char* lds, int l, int c) {
    const int tid = otid(), lane = tid & 63, w = __builtin_amdgcn_readfirstlane(tid >> 6);
    constexpr int RCOPY = 16384 + 64, ZOFF = 4 * RCOPY, ZS = 8192 + 32, ZERO_OFF = ZOFF + 8 * ZS;
    const bf16* gsrc = WSP(bf16, WS_GB) + (size_t)(l * 256 + c) * 8192;
    __syncthreads();
    { v4u g_[2], t_[8];
#pragma unroll
      for (int q = 0; q < 2; ++q) g_[q] = *(const v4u*)(gsrc + 8184 - 8 * (tid + 512 * q));
#pragma unroll
      for (int b = 0; b < 8; ++b) t_[b] = *(const v4u*)(WSP(bf16, WS_ZT) + ((size_t)(b * 256 + c)) * SEQ + tid * 8);
#pragma unroll
      for (int q = 0; q < 2; ++q) { const v4u g4 = g_[q];
        v4u o; o.x = __builtin_amdgcn_alignbit(g4.w, g4.w, 16); o.y = __builtin_amdgcn_alignbit(g4.z, g4.z, 16); o.z = __builtin_amdgcn_alignbit(g4.y, g4.y, 16); o.w = __builtin_amdgcn_alignbit(g4.x, g4.x, 16);
        *(LAS v4u*)(lds + (tid + 512 * q) * 16) = o; }
#pragma unroll
      for (int b = 0; b < 8; ++b) *(LAS v4u*)(lds + ZOFF + b * ZS + tid * 16) = t_[b]; }
    if (tid < 32) *(LAS unsigned*)(lds + ZERO_OFF + tid * 4) = 0u;
    __syncthreads();
    for (int idx = tid; idx < 3 * 4096; idx += 512) { const int k = 1 + (idx >> 12), wd = idx & 4095;
        const int e0 = 2 * wd + k; const unsigned d0 = *(const LAS unsigned*)(lds + (e0 >> 1) * 4), d1 = (e0 + 1 < 8192 && ((e0 + 1) >> 1) < 4096) ? *(const LAS unsigned*)(lds + ((e0 + 1) >> 1) * 4) : 0u;
        const unsigned v = (k & 1) ? __builtin_amdgcn_alignbit(d1, d0, 16) : d0;
        *(LAS unsigned*)(lds + k * RCOPY + wd * 4) = ((e0 >> 1) < 4096) ? v : 0u; }
    __syncthreads();
    const int r = lane & 15, g = lane >> 4, bcol = r >> 1, hcol = r & 1;
    const int Q = 4095 - r + 8 * g, kq = Q & 3;
    const int abase = kq * RCOPY + (Q - kq) * 2;
    const int zlane = ZOFF + bcol * ZS + 16 * g;
    const bf16* x0p = WSP(bf16, WS_X0T) + ((size_t)(bcol * 256 + c)) * SEQ;
    v2u xx[4][4];
#pragma unroll
    for (int cb = 0; cb < 4; ++cb)
#pragma unroll
        for (int rb = 0; rb < 4; ++rb) xx[cb][rb] = *(const v2u*)(x0p + 64 * (8 * w + 2 * cb + hcol) + 16 * rb + 4 * g);
    __builtin_amdgcn_sched_barrier(0);
    f32x4 acc[4][4];
#pragma unroll
    for (int i = 0; i < 4; ++i)
#pragma unroll
        for (int j = 0; j < 4; ++j) acc[i][j] = (f32x4){0.f, 0.f, 0.f, 0.f};
    const int dlo = 8 * w - 63, dhi = 8 * w + 7;
#define HY_LDA(e) ({ const int a_ = abase - 32 * (e); const v2u lo_ = *(const volatile LAS v2u*)(lds + a_), hi_ = *(const volatile LAS v2u*)(lds + a_ + 8);        v4u t_; t_.x = lo_.x; t_.y = lo_.y; t_.z = hi_.x; t_.w = hi_.y; __builtin_bit_cast(bf16x8, t_); })
    bf16x8 F0 = HY_LDA(4 * dlo - 2), F1 = HY_LDA(4 * dlo - 1), F2 = HY_LDA(4 * dlo), F3 = HY_LDA(4 * dlo + 1), F4 = HY_LDA(4 * dlo + 2), F5 = HY_LDA(4 * dlo + 3);
    for (int d = dlo; d <= dhi; ++d) {
        const int dn = (d < dhi) ? d + 1 : d;
        const bf16x8 N2 = HY_LDA(4 * dn), N3 = HY_LDA(4 * dn + 1), N4 = HY_LDA(4 * dn + 2), N5 = HY_LDA(4 * dn + 3);
        bf16x8 Bv[4][2]; bool okc[4];
#pragma unroll
        for (int cb = 0; cb < 4; ++cb) {
            const int s1a = 8 * w + 2 * cb - d;
            okc[cb] = !(s1a > 63 || s1a + 1 < 0);
            if (okc[cb]) { const int s1 = s1a + hcol; const bool ok = (s1 >= 0) && (s1 < 64);
                const int za = ok ? zlane + s1 * 128 : ZERO_OFF;
                Bv[cb][0] = *(const LAS bf16x8*)(lds + za); Bv[cb][1] = *(const LAS bf16x8*)(lds + za + 64); }
        }
#pragma unroll
        for (int cb = 0; cb < 4; ++cb) {
            if (!okc[cb]) continue;
            const bf16x8 B0 = Bv[cb][0], B1 = Bv[cb][1];
            acc[0][cb] = __builtin_amdgcn_mfma_f32_16x16x32_bf16(F2, B0, acc[0][cb], 0, 0, 0);
            acc[1][cb] = __builtin_amdgcn_mfma_f32_16x16x32_bf16(F3, B0, acc[1][cb], 0, 0, 0);
            acc[2][cb] = __builtin_amdgcn_mfma_f32_16x16x32_bf16(F4, B0, acc[2][cb], 0, 0, 0);
            acc[3][cb] = __builtin_amdgcn_mfma_f32_16x16x32_bf16(F5, B0, acc[3][cb], 0, 0, 0);
            acc[0][cb] = __builtin_amdgcn_mfma_f32_16x16x32_bf16(F0, B1, acc[0][cb], 0, 0, 0);
            acc[1][cb] = __builtin_amdgcn_mfma_f32_16x16x32_bf16(F1, B1, acc[1][cb], 0, 0, 0);
            acc[2][cb] = __builtin_amdgcn_mfma_f32_16x16x32_bf16(F2, B1, acc[2][cb], 0, 0, 0);
            acc[3][cb] = __builtin_amdgcn_mfma_f32_16x16x32_bf16(F3, B1, acc[3][cb], 0, 0, 0);
        }
        F0 = F4; F1 = F5; F2 = N2; F3 = N3; F4 = N4; F5 = N5;
    }
#undef HY_LDA
    const float skip = INP(I_SKIP)[l * 256 + c];
    bf16* yt = WSP(bf16, WS_ZT) + ((size_t)(bcol * 256 + c)) * SEQ;
#pragma unroll
    for (int cb = 0; cb < 4; ++cb)
#pragma unroll
        for (int rp = 0; rp < 2; ++rp) { v2u o[2];
#pragma unroll
            for (int rr = 0; rr < 2; ++rr) { const int rb = 2 * rp + rr, t = 64 * (8 * w + 2 * cb + hcol) + 16 * rb + 4 * g;
                const v2u zz = *(const LAS v2u*)(lds + ZOFF + bcol * ZS + t * 2);
                const f32x4 a = acc[rb][cb]; const v2u x4 = xx[cb][rb];
                o[rr].x = pk2(bflo(x4.x) * (a[0] + bflo(zz.x) * skip), bfhi(x4.x) * (a[1] + bfhi(zz.x) * skip)); o[rr].y = pk2(bflo(x4.y) * (a[2] + bflo(zz.y) * skip), bfhi(x4.y) * (a[3] + bfhi(zz.y) * skip)); }
            const v4u w16 = pair16(o[0], o[1]);
            *(v4u*)(yt + 64 * (8 * w + 2 * cb + hcol) + 16 * (2 * rp + (g & 1)) + 4 * (g - (g & 1))) = w16; }
    __syncthreads();
}
__device__ __forceinline__ void hyena_ctx_unit(const Args& A, LAS unsigned char* lds, int l, int b, int cg) {
    const int tid = otid(), ch = tid >> 5, tg = tid & 31;
    LAS float* Gf = (LAS float*)lds; LAS float* Zf = Gf + 16 * 512;
    bf16* Y = WSP(bf16, WS_Y);
    __syncthreads();
    { float g_[16]; unsigned short z_[8];
#pragma unroll
      for (int q = 0; q < 16; ++q) g_[q] = WSP(float, WS_GC)[(cg * 16) * 512 + tid + 512 * q];
#pragma unroll
      for (int q = 0; q < 8; ++q) z_[q] = WSP(bf16, WS_ZTC)[((size_t)(b * 256 + cg * 16)) * CTXL + tid + 512 * q];
#pragma unroll
      for (int q = 0; q < 16; ++q) Gf[tid + 512 * q] = g_[q];
#pragma unroll
      for (int q = 0; q < 8; ++q) Zf[tid + 512 * q] = bf2f(z_[q]); }
    __syncthreads();
    float acc[8];
#pragma unroll
    for (int i = 0; i < 8; ++i) acc[i] = 0.f;
    const LAS float* gp = Gf + ch * 512 + 256 + tg; const LAS float* zp = Zf + ch * 256;
    for (int s = 0; s < 256; ++s) { const float z = zp[s];
#pragma unroll
        for (int i = 0; i < 8; ++i) acc[i] += gp[32 * i - s] * z; }
    const int c = cg * 16 + ch; const float skip = INP(I_SKIP)[l * 256 + c];
    unsigned short x0v[8];
#pragma unroll
    for (int i = 0; i < 8; ++i) x0v[i] = WSP(bf16, WS_X0TC)[((size_t)(b * 256 + c)) * CTXL + tg + 32 * i];
#pragma unroll
    for (int i = 0; i < 8; ++i) { const int t = tg + 32 * i;
        Y[((size_t)(b * TPB + SEQ + t)) * DM + c] = (bf16)f2bf(bf2f(x0v[i]) * (acc[i] + zp[t] * skip)); }
    __syncthreads();
}
__device__ __forceinline__ void ph_mixers(const Args& A, unsigned char* lds_generic, LAS unsigned char* lds, int l, int G, int vcu, int cv_lo, int cv_hi) {
#ifndef NO_HY
#ifdef HY_VALU
    for (int u = blockIdx.x; u < 256; u += G) hyena_latent_unit(A, lds, l, u);
#else
#ifndef HY_REPS
#define HY_REPS 1
#endif
    for (int hr = 0; hr < HY_REPS; ++hr)
    for (int u = blockIdx.x; u < 256; u += G) hyena_mfma_unit(A, lds, l, ((u & 7) << 5) | (u >> 3));
#endif
    if (l == 0) { for (int u = G - 1 - (int)blockIdx.x; u < 128; u += G) hyena_ctx_unit(A, lds, l, u >> 4, u & 15); }
#endif
    __syncthreads();
    const attn_body::bf16* P = (const attn_body::bf16*)WSP(bf16, WS_P); attn_body::bf16* Y = (attn_body::bf16*)WSP(bf16, WS_Y);
    const int nunits = (l == 0) ? 1632 : 1536;
    float mfix_ga; { float gq = 0.f, gk = 0.f; const float* qn = INP(I_QNORM) + l * 64; const float* kn = INP(I_KNORM) + l * 64;
        for (int i = 0; i < 64; ++i) { gq = fmaxf(gq, fabsf(qn[i])); gk = fmaxf(gk, fabsf(kn[i])); }
        mfix_ga = 8.0f * LOG2E * gq * gk * 1.02f; }
#ifndef NO_ATT
    int aj = 0;
    for (int u = vcu; u < nunits; u += G, ++aj) {
        if (cv_hi > cv_lo && aj == (vcu & 3)) { __syncthreads(); cv_blocks(A, lds, cv_lo, cv_hi, 0, 1); }
        attn_body::AttnJob J; int b, h, win;
        if (u < 1536) { win = (u >= 768) ? 1 : 0; const int q = win ? u - 768 : u; b = q / 96; const int r = q - 96 * b; h = r >> 4; const int qb = r & 15; J.q0 = 256 * qb;
            if (!win) { J.NT = 68; J.nA = 68; J.rA = 0; J.rB = 0; J.masked = 0; }
            else { const int klo = (J.q0 >= 128) ? J.q0 - 128 : 0, khi = (J.q0 + 384 <= SEQ) ? J.q0 + 384 : SEQ; J.nA = 4; J.rA = SEQ; J.rB = klo; J.NT = 4 + (khi - klo) / 64; J.masked = 1; } }
        else { const int q = u - 1536; win = q / 48; const int r = q - 48 * win; b = r / 6; h = r - 6 * b; J.q0 = SEQ; J.NT = 4; J.nA = 4; J.rA = SEQ; J.rB = 0; J.masked = 0; }
        const int kvh = h / 3;
        const size_t rb = (size_t)b * TPB;
        J.Q = P + rb * INW + (win ? COL_WAQ : COL_GAQ) + 64 * h;
        { const size_t kvo = (size_t)(((win * 8 + b) * 2 + kvh)) * TPB * 64; J.K = (const attn_body::bf16*)WSP(bf16, WS_KC) + kvo; J.V = (const attn_body::bf16*)WSP(bf16, WS_VC) + kvo; }
        J.O = Y + rb * DM + (win ? 640 : 256) + 64 * h;
        J.sink_l2 = win ? INP(I_SINK)[l * 6 + h] * LOG2E : -INFINITY;
        J.mfix = (!win && mfix_ga <= 60.f) ? mfix_ga : 0.f;
        attn_body::attn_unit<8>(J, (char*)lds_generic);
    }
#endif
    __syncthreads();
}
__device__ __forceinline__ void bn_row(v4u w0, v4u w1, bf16* p, int lane, const float (&bw)[16]) {
    float v[16];
    v[0] = bflo(w0.x); v[1] = bfhi(w0.x); v[2] = bflo(w0.y); v[3] = bfhi(w0.y); v[4] = bflo(w0.z); v[5] = bfhi(w0.z); v[6] = bflo(w0.w); v[7] = bfhi(w0.w);
    v[8] = bflo(w1.x); v[9] = bfhi(w1.x); v[10] = bflo(w1.y); v[11] = bfhi(w1.y); v[12] = bflo(w1.z); v[13] = bfhi(w1.z); v[14] = bflo(w1.w); v[15] = bfhi(w1.w);
    float ss = 0.f;
#pragma unroll
    for (int k = 0; k < 16; ++k) ss += v[k] * v[k];
    ss += DPPF(ss, 0xB1); ss += DPPF(ss, 0x4E); ss += DPPF(ss, 0x141);
    float gs[8];
#pragma unroll
    for (int k = 0; k < 8; ++k) gs[k] = __builtin_bit_cast(float, __builtin_amdgcn_readlane(__builtin_bit_cast(int, ss), 8 * k));
    const float s0 = gs[0] + gs[1], s1 = (gs[2] + gs[3]) + gs[4], s2 = (gs[5] + gs[6]) + gs[7];
    const float rs = (lane < 16) ? rsqrtf(s0 * (1.0f / 256.0f) + EPSN) : (lane < 40) ? rsqrtf(s1 * (1.0f / 384.0f) + EPSN) : rsqrtf(s2 * (1.0f / 384.0f) + EPSN);
#pragma unroll
    for (int k = 0; k < 16; ++k) v[k] = v[k] * rs * bw[k];
    v4u o0, o1;
    o0.x = pk2(v[0], v[1]); o0.y = pk2(v[2], v[3]); o0.z = pk2(v[4], v[5]); o0.w = pk2(v[6], v[7]);
    o1.x = pk2(v[8], v[9]); o1.y = pk2(v[10], v[11]); o1.z = pk2(v[12], v[13]); o1.w = pk2(v[14], v[15]);
    ((v4u*)p)[0] = o0; ((v4u*)p)[1] = o1;
}
__device__ __forceinline__ void ph_branchnorm(const Args& A, LAS unsigned char* lds, int l, int G) {
    const int tid = otid(), lane = tid & 63, wave = tid >> 6, gw = blockIdx.x * 8 + wave, NGW = G * 8;
    bf16* Y = WSP(bf16, WS_Y); const float* bn = INP(I_BNORM) + l * DM; const bf16* YT = WSP(bf16, WS_ZT);
    constexpr int NR = 4, TP = 128  , TBUF = 256 * TP + 256;
    float bw[16];
#pragma unroll
    for (int k = 0; k < 4; ++k) { const f32x4 t = ((const f32x4*)(bn + 16 * lane))[k]; bw[4 * k] = t.x; bw[4 * k + 1] = t.y; bw[4 * k + 2] = t.z; bw[4 * k + 3] = t.w; }
    v4u st[4];
    __syncthreads();
    int tx = blockIdx.x, par = 0;
    if (tx < 512) {
#pragma unroll
        for (int j = 0; j < 4; ++j) { const int pz = tid + 512 * j; st[j] = *(const v4u*)(YT + ((size_t)((tx >> 6) * 256 + (pz >> 3))) * SEQ + 64 * (tx & 63) + 8 * (pz & 7)); } }
    for (; tx < 512; tx += G, par ^= 1) {
        LAS unsigned char* buf = lds + par * TBUF;
#pragma unroll
        for (int j = 0; j < 4; ++j) { const int pz = tid + 512 * j; *(LAS v4u*)(buf + (pz >> 3) * TP + ((pz >> 7) << 4) + (pz & 7) * 16) = st[j]; }
        __syncthreads();
        if (tx + G < 512) { const int tn = tx + G;
#pragma unroll
            for (int j = 0; j < 4; ++j) { const int pz = tid + 512 * j; st[j] = *(const v4u*)(YT + ((size_t)((tn >> 6) * 256 + (pz >> 3))) * SEQ + 64 * (tn & 63) + 8 * (pz & 7)); } }
        const int r0 = (tx >> 6) * TPB + 64 * (tx & 63) + 8 * wave;
#pragma unroll 1
        for (int it = 0; it < 2; ++it) {
            v4u w0[NR], w1[NR]; bf16* p[NR];
#pragma unroll
            for (int q = 0; q < NR; ++q) { p[q] = Y + (size_t)(r0 + 4 * it + q) * DM + 16 * lane;
                if (lane >= 16) { w0[q] = ((const v4u*)p[q])[0]; w1[q] = ((const v4u*)p[q])[1]; }
                else { const LAS unsigned char* cp = buf + (16 * lane) * TP + 16 * lane + 2 * (8 * wave + 4 * it + q); unsigned h[16];
#pragma unroll
                    for (int k = 0; k < 16; ++k) h[k] = *(const LAS unsigned short*)(cp + k * TP);
                    w0[q].x = h[0] | (h[1] << 16); w0[q].y = h[2] | (h[3] << 16); w0[q].z = h[4] | (h[5] << 16); w0[q].w = h[6] | (h[7] << 16);
                    w1[q].x = h[8] | (h[9] << 16); w1[q].y = h[10] | (h[11] << 16); w1[q].z = h[12] | (h[13] << 16); w1[q].w = h[14] | (h[15] << 16); } }
#pragma unroll
            for (int q = 0; q < NR; ++q) bn_row(w0[q], w1[q], p[q], lane, bw);
        }
    }
    if (l == 0) {
        for (int i0 = gw * NR; i0 < NB * CTXL; i0 += NGW * NR) {
            v4u w0[NR], w1[NR]; bf16* p[NR];
#pragma unroll
            for (int q = 0; q < NR; ++q) { const int i = i0 + q, r = (i >> 8) * TPB + SEQ + (i & 255); p[q] = Y + (size_t)r * DM + 16 * lane; w0[q] = ((const v4u*)p[q])[0]; w1[q] = ((const v4u*)p[q])[1]; }
#pragma unroll
            for (int q = 0; q < NR; ++q) bn_row(w0[q], w1[q], p[q], lane, bw);
        }
    }
    __syncthreads();
}

constexpr int NPHASE = 22;
__global__ void __launch_bounds__(512, 2) hh_fwd(Args A) {
    extern __shared__ __attribute__((aligned(16))) unsigned char lds_raw[];
    LAS unsigned char* lds = (LAS unsigned char*)lds_raw;
    const int G = gridDim.x;
    volatile LAS unsigned* MISC = (volatile LAS unsigned*)(lds + MISC_OFF);
    if (threadIdx.x < 64) MISC[threadIdx.x] = 0u;
    if ((threadIdx.x & 63) == 0) *(volatile LAS int*)(lds + WTAB_OFF + 4 * hw_slot()) = (int)(threadIdx.x >> 6);
    __syncthreads();
    const bool OVL = (G == 256);
#define SPARE_SPLIT(k_) const int kk_ = OVL ? (k_) : 0, xl_ = vcu & 31, xc_ = vcu >> 5; const bool is_cv = OVL && xl_ >= 32 - kk_; \
    const int Gg = OVL ? 8 * (32 - kk_) : G, cg = OVL ? xc_ * (32 - kk_) + xl_ : vcu, cvw = xc_ * kk_ + (xl_ - (32 - kk_)), cvn = 8 * kk_
    constexpr int CV_A = 650, CV_B = 1947, CV_C = 800, CV_D = 800, CV_E = 2 * CVB_L - CV_A - CV_B - CV_C - CV_D;
    static_assert(CV_A + CV_B + CV_C >= CVB_L && CV_E >= 0, "layer 0's blocks must be done before its MoE GEMMs");
    const int vcu = (G % 8 == 0) ? ((int)blockIdx.x % 8) * (G / 8) + (int)blockIdx.x / 8 : (int)blockIdx.x;
    { const int __attribute__((address_space(4)))* kp = (const int __attribute__((address_space(4)))*)__builtin_amdgcn_kernarg_segment_ptr();
      if (kp[73] - kp[72] > 1) (void)xcd_barrier_post((unsigned*)ws_ptr(A) + CW_BAR, MISC + 8); }
#define IN(k) in_range(A, (k))
#define SEAM(k) do { if (IN(k) && IN((k) + 1)) { XcdBarrier b_; b_.bar = (unsigned*)ws_ptr(A) + CW_BAR; b_.x = xb_xcc_id(); b_.st = (volatile LAS unsigned*)(lds + MISC_OFF) + 8; xcd_barrier(b_); } } while (0)

#ifndef PH_MASK
#define PH_MASK 0xFFF
#endif
#define PHON(k) ((PH_MASK >> (k)) & 1)
#ifndef HH_REPEAT
#define HH_REPEAT -1
#endif
#ifndef HH_DRY
#define HH_DRY 0
#endif
#define REPS(k) ((HH_REPEAT == (k)) ? 2 : 1)
#define REPBAR(k) do { if (HH_REPEAT == (k)) { XcdBarrier b_; b_.bar = (unsigned*)ws_ptr(A) + CW_BAR; b_.x = xb_xcc_id(); b_.st = (volatile LAS unsigned*)(lds + MISC_OFF) + 8; xcd_barrier(b_); } } while (0)
    if (PHON(0) && IN(0)) { for (int rep_ = 0; rep_ < REPS(0); ++rep_) { if (rep_) REPBAR(0); ph_prologue(A, lds, G, OVL ? 0 : 2 * CVB_L);   } SEAM(0); }
    if (PHON(1) && IN(1)) ph_filters(A, lds, G);
    #pragma unroll 1
    for (int l = 0; l < NLAYER; ++l) {
        const int pb = 1 + 10 * l;
        if (PHON(1) && IN(pb + 0)) { ph_rowpass_a(A, lds, l, G); SEAM(pb + 0); }
        if (PHON(2) && IN(pb + 1)) {
            SPARE_SPLIT(l == 0 ? 4 : 5);
            SchedProj S{(const char*)WSP(bf16, WS_H), (const char*)(WSP(bf16, WS_WINT) + (size_t)l * 2048 * 1024), l, Gg, cg};
            EpiProj E{WSP(bf16, WS_P), INP(I_BIN) + l * INW, WSP(bf16, WS_VC)};
            if (is_cv) { if (l == 0) cv_blocks(A, lds, 0, CV_A, cvw, cvn); else cv_blocks(A, lds, CV_A + CV_B + CV_C, CV_A + CV_B + CV_C + CV_D, cvw, cvn); }
            else for (int rep_ = 0; rep_ < REPS(2); ++rep_) { if (rep_) REPBAR(2); pg8::gemm_phase<EpiProj, SchedProj, false, true>(lds, S, E); }
            SEAM(pb + 1);
        }
        if (PHON(3) && IN(pb + 2)) { ph_post(A, lds, l, G); SEAM(pb + 2); }
        const int cvm_0 = (l == 0) ? CV_A : CV_A + CV_B + CV_C + CV_D, cvm_n = (l == 0) ? CV_B : CV_E, cvm_q = cvm_n / G, cvm_r = cvm_n - cvm_q * G;
        const int cvm_lo = OVL ? cvm_0 + vcu * cvm_q + (vcu < cvm_r ? vcu : cvm_r) : 0, cvm_hi = OVL ? cvm_lo + cvm_q + (vcu < cvm_r ? 1 : 0) : 0;
        if (PHON(4) && IN(pb + 3)) { for (int rep_ = 0; rep_ < REPS(4); ++rep_) { if (rep_) REPBAR(4); ph_mixers(A, lds_raw, lds, l, G, vcu, cvm_lo, cvm_hi); } SEAM(pb + 3); }
        if (PHON(5) && IN(pb + 4)) { ph_branchnorm(A, lds, l, G); SEAM(pb + 4); }
        if (PHON(6) && IN(pb + 5)) {
            SPARE_SPLIT(l == 0 ? 9 : 0);
            SchedOut S{(const char*)WSP(bf16, WS_Y), (const char*)(WSP(bf16, WS_WOUTT) + (size_t)l * 1024 * 1024), l, Gg, cg};
            EpiOut E{WSP(bf16, WS_X), INP(I_BOUT) + l * DM, WSP(float, WS_MOD) + l * 9 * 6144 + 2048, (l == 0) ? INP(I_X) : nullptr, (l == 0) ? INP(I_CTX) : nullptr};
            if (is_cv) cv_blocks(A, lds, CV_A + CV_B, CV_A + CV_B + CV_C, cvw, cvn);
            else pg8::gemm_phase<EpiOut, SchedOut, false, true>(lds, S, E);
            SEAM(pb + 5);
        }
        if (PHON(7) && IN(pb + 6)) { for (int rep_ = 0; rep_ < REPS(7); ++rep_) { if (rep_) REPBAR(7); ph_rowpass_g(A, lds, l, G); } SEAM(pb + 6); }
        if (PHON(8) && IN(pb + 7)) { ph_route(A, lds, l, G); SEAM(pb + 7); }
        if (PHON(9) && IN(pb + 8)) {
            const int t_ = otid(), th_ = t_ >> 8, tl_ = t_ & 255;
            int rv_[9];
            { const int* st = WSP(int, WS_SLOTTOK);
#pragma unroll
              for (int j = 0; j < 9; ++j) { const int pm_ = ((2 * j + th_) * G + vcu) >> 3; rv_[j] = (pm_ < NBLK_MAX) ? st[pm_ * 256 + tl_] : MROWS; } }
            const int nblk = moe_table(A, lds, l);
            SchedMoe S{(const char*)WSP(unsigned char, WS_H8), (const char*)(WSP(unsigned char, WS_W1T) + (size_t)l * 32 * 2048 * 1024), (const LAS int*)(lds + ROWS_OFF), (const LAS unsigned char*)(lds + LDSX_OFF + 1024), nblk, 3, G, vcu, (size_t)2048 * 1024};
            {
#pragma unroll
                for (int j = 0; j < 9; ++j) ((LAS int*)(lds + ROWS_OFF))[(2 * j + th_) * 256 + tl_] = rv_[j];
                __syncthreads();
            }
            EpiGlu E{WSP(unsigned char, WS_ACT), INP(I_B1) + (size_t)l * 32 * 2048, &S, 0};
            #ifndef G1_REPS
#define G1_REPS 1
#endif
#pragma unroll 1
            for (int rep_ = 0; rep_ < G1_REPS; ++rep_) { if (rep_) E.dry = HH_DRY; pg8::gemm_phase<EpiGlu, SchedMoe, true, true, true>(lds, S, E); }
            SEAM(pb + 8);
        }
        if (PHON(10) && IN(pb + 9)) {
            const int nblk = IN(pb + 8) ? __builtin_amdgcn_readfirstlane(((const volatile LAS int*)(lds + LDSX_OFF))[33]) : moe_table(A, lds, l);
            SchedMoe S{(const char*)WSP(unsigned char, WS_ACT), (const char*)(WSP(unsigned char, WS_W2T) + (size_t)l * 32 * 1024 * 1024), nullptr, (const LAS unsigned char*)(lds + LDSX_OFF + 1024), nblk, 2, G, vcu, (size_t)1024 * 1024};
            EpiOuts E{WSP(unsigned char, WS_OUTS), INP(I_B2) + (size_t)l * 32 * 1024, &S, 0};
            for (int rep_ = 0; rep_ < REPS(10); ++rep_) { if (rep_) { REPBAR(10); E.dry = HH_DRY; } pg8::gemm_phase<EpiOuts, SchedMoe, false, true, true>(lds, S, E); }
            SEAM(pb + 9);
        }
    }
    if (PHON(11) && IN(21)) { for (int rep_ = 0; rep_ < REPS(11); ++rep_) { if (rep_) REPBAR(11); ph_final(A, lds, G); } }
#undef IN
#undef SEAM
}

#ifndef HH_N_LAUNCHES
#define HH_N_LAUNCHES 1
#endif
extern "C" void kernel_launch(void* const* d_in, const int* in_sizes, int n_in, void* d_out, int out_size, void* d_ws, size_t ws_size, hipStream_t stream) {
    static int grid = 0;
    if (grid == 0) {
        if (n_in != 34 || out_size != NB * SEQ * DM || ws_size < WS_END) { fprintf(stderr, "kernel_launch: unexpected shapes (n_in %d, out %d, ws %zu)\n", n_in, out_size, ws_size); grid = -1; return; }
        int dev = 0, cus = 0, per_cu = 0;
        if (hipGetDevice(&dev) != hipSuccess || hipDeviceGetAttribute(&cus, hipDeviceAttributeMultiprocessorCount, dev) != hipSuccess) { grid = -1; return; }
        if (hipFuncSetAttribute((const void*)hh_fwd, hipFuncAttributeMaxDynamicSharedMemorySize, LDS_BYTES) != hipSuccess) { fprintf(stderr, "kernel_launch: hipFuncSetAttribute failed\n"); grid = -1; return; }
        if (hipOccupancyMaxActiveBlocksPerMultiprocessor(&per_cu, (const void*)hh_fwd, 512, LDS_BYTES) != hipSuccess || per_cu < 1) { fprintf(stderr, "kernel_launch: occupancy query says %d\n", per_cu); (void)hipGetLastError(); }
        grid = cus > 256 ? 256 : cus;
    }
    if (grid < 0) return;
    (void)hipMemsetAsync((char*)d_ws + WS_CTL, 0, CTL_ZERO_BYTES, stream);
    Args a{};
    for (int i = 0; i < 34; ++i) a.in[i] = (const float*)d_in[i];
    a.out = (float*)d_out; a.ws = (unsigned char*)d_ws;
    if (HH_N_LAUNCHES == 1) { a.ph_lo = 0; a.ph_hi = NPHASE; hipLaunchKernelGGL(hh_fwd, dim3(grid), dim3(512), LDS_BYTES, stream, a); }
    else { for (int p = 0; p < NPHASE; ++p) { a.ph_lo = p; a.ph_hi = p + 1; hipLaunchKernelGGL(hh_fwd, dim3(grid), dim3(512), LDS_BYTES, stream, a); } }
}
```
